# Optimizing an MI355X kernel written in HIP

```python
import math
import jax, jax.numpy as jnp
from jax import lax
import numpy as np

D_MODEL = 2048
BATCH = 2
SEQ = 16384
DEPTH = 1

ATTN_HEADS = 8
ATTN_HEAD_DIM = 128
ATTN_WIDTH = ATTN_HEADS * ATTN_HEAD_DIM
Q_BLOCK = 128
SSM_WIDTH = D_MODEL // 4
SSM_GROUP = 16
SSM_GROUPS = SSM_WIDTH // SSM_GROUP
SSM_STATE = 64
DT_MIN = 1e-3
DT_MAX = 1e-1
N_BRANCHES = 2
PEER_HEADS = 8
PEER_N_KEYS = 128
PEER_N_EXPERTS = PEER_N_KEYS * PEER_N_KEYS
PEER_QUERY_DIM = 256
PEER_HALF_DIM = PEER_QUERY_DIM // 2
PEER_TOPK = 16
PEER_CHUNK = 128
N_MOD = 6
RMS_EPS = 1e-6
NEG_INF = -1e30

IN_SIZES = (ATTN_WIDTH, ATTN_WIDTH, ATTN_WIDTH, ATTN_HEADS, SSM_WIDTH, D_MODEL, D_MODEL)
IN_WIDTH = sum(IN_SIZES)
IN_SPLIT_POINTS = tuple(int(v) for v in np.cumsum(IN_SIZES)[:-1])

kernel_name = "hybrid_s5_fox_peer_block"


def rms_norm(x, w):
    xf = x.astype(jnp.float32)
    xf = xf * lax.rsqrt(jnp.mean(xf * xf, axis=-1, keepdims=True) + RMS_EPS)
    return xf.astype(x.dtype) * w


def modulate(h, shift, scale):
    return h * (1.0 + scale[:, None, :]) + shift[:, None, :]


def _ssm_combine(e_i, e_j):
    ar_i, ai_i, br_i, bi_i = e_i
    ar_j, ai_j, br_j, bi_j = e_j
    ar = ar_j * ar_i - ai_j * ai_i
    ai = ar_j * ai_i + ai_j * ar_i
    br = ar_j * br_i - ai_j * bi_i + br_j
    bi = ar_j * bi_i + ai_j * br_i + bi_j
    return (ar, ai, br, bi)


def s5_mixer(u, A_re, A_im, log_dt, B_re, B_im, C_re, C_im, D_skip):
    bsz, seq, _ = u.shape
    f32 = jnp.float32
    uf = u.astype(f32).reshape(bsz, seq, SSM_GROUPS, SSM_GROUP)
    lam_re = A_re.astype(f32)
    lam_im = A_im.astype(f32)
    dt = jnp.exp(log_dt.astype(f32))[:, None]
    mag = jnp.exp(lam_re * dt)
    ab_re = mag * jnp.cos(lam_im * dt)
    ab_im = mag * jnp.sin(lam_im * dt)
    den = lam_re * lam_re + lam_im * lam_im
    nr = ab_re - 1.0
    coef_re = (nr * lam_re + ab_im * lam_im) / den
    coef_im = (ab_im * lam_re - nr * lam_im) / den
    b_re = B_re.astype(f32)
    b_im = B_im.astype(f32)
    bb_re = coef_re[..., None] * b_re - coef_im[..., None] * b_im
    bb_im = coef_re[..., None] * b_im + coef_im[..., None] * b_re
    bu_re = jnp.einsum('bsgc,gpc->bsgp', uf, bb_re)
    bu_im = jnp.einsum('bsgc,gpc->bsgp', uf, bb_im)
    a_re = jnp.broadcast_to(ab_re, (1, seq, SSM_GROUPS, SSM_STATE))
    a_im = jnp.broadcast_to(ab_im, (1, seq, SSM_GROUPS, SSM_STATE))
    _, _, st_re, st_im = lax.associative_scan(_ssm_combine, (a_re, a_im, bu_re, bu_im), axis=1)
    y = (jnp.einsum('gcp,bsgp->bsgc', C_re.astype(f32), st_re)
         - jnp.einsum('gcp,bsgp->bsgc', C_im.astype(f32), st_im)
         + D_skip.astype(f32) * uf)
    return y.reshape(bsz, seq, SSM_WIDTH).astype(u.dtype)


def half_glu(y, w_glu, b_glu):
    g = jax.nn.gelu(y, approximate=False)
    return g * jax.nn.sigmoid(g @ w_glu + b_glu)


def head_rms(t, w):
    tf = t.astype(jnp.float32)
    tf = tf * lax.rsqrt(jnp.mean(tf * tf, axis=-1, keepdims=True) + RMS_EPS)
    return tf.astype(t.dtype) * w


def fox_attention(q, k, v, f_logit, b_forget, q_norm_w, k_norm_w):
    bsz, seq, _ = q.shape
    q = head_rms(q.reshape(bsz, seq, ATTN_HEADS, ATTN_HEAD_DIM), q_norm_w) * (ATTN_HEAD_DIM ** -0.5)
    k = head_rms(k.reshape(bsz, seq, ATTN_HEADS, ATTN_HEAD_DIM), k_norm_w)
    v = v.reshape(bsz, seq, ATTN_HEADS, ATTN_HEAD_DIM)
    log_f = jax.nn.log_sigmoid((f_logit + b_forget).astype(jnp.float32))
    cum = jnp.cumsum(log_f, axis=1).transpose(0, 2, 1)
    nb = seq // Q_BLOCK
    q_blocks = q.reshape(bsz, nb, Q_BLOCK, ATTN_HEADS, ATTN_HEAD_DIM).transpose(1, 0, 2, 3, 4)
    cum_blocks = cum.reshape(bsz, ATTN_HEADS, nb, Q_BLOCK).transpose(2, 0, 1, 3)
    kpos = jnp.arange(seq)

    def block(args):
        qb, cq, bi = args
        s = (jnp.einsum('bqhd,bkhd->bhqk', qb, k).astype(jnp.float32)
             + cq[..., None] - cum[:, :, None, :])
        qpos = bi * Q_BLOCK + jnp.arange(Q_BLOCK)
        s = jnp.where(kpos[None, :] <= qpos[:, None], s, NEG_INF)
        p = jax.nn.softmax(s, axis=-1).astype(v.dtype)
        return jnp.einsum('bhqk,bkhd->bqhd', p, v)

    o = lax.map(block, (q_blocks, cum_blocks, jnp.arange(nb)))
    return o.transpose(1, 0, 2, 3, 4).reshape(bsz, seq, ATTN_WIDTH)


def peer_ffn(h, w_q, sub_keys, expert_u, expert_v):
    bsz, seq, d = h.shape
    q = (h @ w_q).reshape(bsz, seq, PEER_HEADS, 2, PEER_HALF_DIM)
    scores = jnp.einsum('bshpd,hpnd->bshpn', q, sub_keys).astype(jnp.float32)
    sv, si = lax.top_k(scores, PEER_TOPK)
    cand = (sv[..., 0, :, None] + sv[..., 1, None, :]).reshape(bsz, seq, PEER_HEADS, PEER_TOPK * PEER_TOPK)
    cidx = (si[..., 0, :, None] * PEER_N_KEYS + si[..., 1, None, :]).reshape(bsz, seq, PEER_HEADS, PEER_TOPK * PEER_TOPK)
    tv, tp = lax.top_k(cand, PEER_TOPK)
    eidx = jnp.take_along_axis(cidx, tp, axis=-1)
    gw = jax.nn.softmax(tv, axis=-1).astype(h.dtype)
    n_sel = PEER_HEADS * PEER_TOPK
    nc = (bsz * seq) // PEER_CHUNK
    xs = h.reshape(nc, PEER_CHUNK, d)
    ids = eidx.reshape(nc, PEER_CHUNK, n_sel)
    ws = gw.reshape(nc, PEER_CHUNK, n_sel)

    def chunk(args):
        xc, ic, wc = args
        a = jnp.einsum('td,ted->te', xc, expert_u[ic])
        a = jax.nn.gelu(a, approximate=False) * wc
        return jnp.einsum('te,ted->td', a, expert_v[ic])

    out = lax.map(chunk, (xs, ids, ws))
    return out.reshape(bsz, seq, d)


def setup_inputs(seed: int = 0) -> dict:
    key = jax.random.key(seed)
    ks = jax.random.split(key, 32)
    f32 = jnp.float32
    L = DEPTH
    nrm = lambda k, shape, s: (jax.random.normal(k, shape, f32) * s)
    n_idx = jnp.arange(SSM_STATE, dtype=f32)
    A_re = -0.5 * jnp.exp(nrm(ks[9], (L, SSM_GROUPS, SSM_STATE), 0.05))
    A_im = math.pi * n_idx[None, None, :] + nrm(ks[10], (L, SSM_GROUPS, SSM_STATE), 0.01)
    log_dt = jax.random.uniform(ks[11], (L, SSM_GROUPS), f32, math.log(DT_MIN), math.log(DT_MAX))
    return {
        "x": nrm(ks[0], (BATCH, SEQ, D_MODEL), 1.0),
        "c": nrm(ks[1], (BATCH, D_MODEL), 1.0),
        "w_ada": nrm(ks[2], (L, D_MODEL, N_MOD * D_MODEL), 0.02),
        "b_ada": nrm(ks[3], (L, N_MOD * D_MODEL), 0.01),
        "norm1_w": 1.0 + nrm(ks[4], (L, D_MODEL), 0.02),
        "w_in": nrm(ks[5], (L, D_MODEL, IN_WIDTH), D_MODEL ** -0.5),
        "b_forget": jax.random.uniform(ks[6], (L, ATTN_HEADS), f32, 1.0, 3.0),
        "q_norm_w": 1.0 + nrm(ks[7], (L, ATTN_HEAD_DIM), 0.02),
        "k_norm_w": 1.0 + nrm(ks[8], (L, ATTN_HEAD_DIM), 0.02),
        "ssm_A_re": A_re,
        "ssm_A_im": A_im,
        "ssm_log_dt": log_dt,
        "ssm_B_re": nrm(ks[12], (L, SSM_GROUPS, SSM_STATE, SSM_GROUP), (2.0 * SSM_GROUP) ** -0.5),
        "ssm_B_im": nrm(ks[13], (L, SSM_GROUPS, SSM_STATE, SSM_GROUP), (2.0 * SSM_GROUP) ** -0.5),
        "ssm_C_re": nrm(ks[14], (L, SSM_GROUPS, SSM_GROUP, SSM_STATE), (2.0 * SSM_STATE) ** -0.5),
        "ssm_C_im": nrm(ks[15], (L, SSM_GROUPS, SSM_GROUP, SSM_STATE), (2.0 * SSM_STATE) ** -0.5),
        "ssm_D": 1.0 + nrm(ks[16], (L, SSM_GROUPS, SSM_GROUP), 0.1),
        "w_glu": nrm(ks[17], (L, SSM_WIDTH, SSM_WIDTH), SSM_WIDTH ** -0.5),
        "b_glu": nrm(ks[18], (L, SSM_WIDTH), 0.01),
        "w_ssm_up": nrm(ks[19], (L, SSM_WIDTH, D_MODEL), SSM_WIDTH ** -0.5),
        "w_attn_up": nrm(ks[20], (L, ATTN_WIDTH, D_MODEL), ATTN_WIDTH ** -0.5),
        "w_out": nrm(ks[21], (L, D_MODEL, D_MODEL), D_MODEL ** -0.5),
        "norm2_w": 1.0 + nrm(ks[22], (L, D_MODEL), 0.02),
        "w_peer_q": nrm(ks[23], (L, D_MODEL, PEER_HEADS * PEER_QUERY_DIM), D_MODEL ** -0.5),
        "peer_sub_keys": nrm(ks[24], (L, PEER_HEADS, 2, PEER_N_KEYS, PEER_HALF_DIM), PEER_HALF_DIM ** -0.5),
        "peer_u": nrm(ks[25], (L, PEER_N_EXPERTS, D_MODEL), D_MODEL ** -0.5),
        "peer_v": nrm(ks[26], (L, PEER_N_EXPERTS, D_MODEL), 0.25),
    }


def reference(x, c, w_ada, b_ada, norm1_w, w_in, b_forget, q_norm_w, k_norm_w,
              ssm_A_re, ssm_A_im, ssm_log_dt, ssm_B_re, ssm_B_im, ssm_C_re, ssm_C_im, ssm_D,
              w_glu, b_glu, w_ssm_up, w_attn_up, w_out, norm2_w, w_peer_q, peer_sub_keys,
              peer_u, peer_v):
    cond = jax.nn.silu(c)
    for l in range(DEPTH):
        mod = cond @ w_ada[l] + b_ada[l]
        sh1, sc1, g1, sh2, sc2, g2 = jnp.split(mod, N_MOD, axis=-1)
        h = modulate(rms_norm(x, norm1_w[l]), sh1, sc1)
        proj = h @ w_in[l]
        q, k, v, f_logit, u, gate_s, gate_a = jnp.split(proj, IN_SPLIT_POINTS, axis=-1)
        y_ssm = s5_mixer(u, ssm_A_re[l], ssm_A_im[l], ssm_log_dt[l], ssm_B_re[l], ssm_B_im[l],
                         ssm_C_re[l], ssm_C_im[l], ssm_D[l])
        y_ssm = half_glu(y_ssm, w_glu[l], b_glu[l])
        y_attn = fox_attention(q, k, v, f_logit, b_forget[l], q_norm_w[l], k_norm_w[l])
        merged = (jax.nn.sigmoid(gate_s) * (y_ssm @ w_ssm_up[l])
                  + jax.nn.sigmoid(gate_a) * (y_attn @ w_attn_up[l]))
        x = x + g1[:, None, :] * (merged @ w_out[l])
        h2 = modulate(rms_norm(x, norm2_w[l]), sh2, sc2)
        x = x + g2[:, None, :] * peer_ffn(h2, w_peer_q[l], peer_sub_keys[l], peer_u[l], peer_v[l])
    return x
```

```cpp
#include <hip/hip_runtime.h>
#include <hip/hip_cooperative_groups.h>
#include <cstdio>
#include <cstdint>
namespace cg = cooperative_groups;

#ifndef DBG
#define DBG 0
#endif
#define DBG_MAG 13
#ifndef DBG_LO
#define DBG_LO 10
#endif
#ifndef DBG_STOP
#define DBG_STOP 99
#endif

#define DI __device__ __forceinline__
#define GAS __attribute__((address_space(1)))
#define LAS __attribute__((address_space(3)))
typedef unsigned short bf16_t;
typedef short bf16x8 __attribute__((ext_vector_type(8)));
typedef float f32x4 __attribute__((ext_vector_type(4)));
typedef float f32x16 __attribute__((ext_vector_type(16)));
typedef unsigned u32x4 __attribute__((ext_vector_type(4)));
typedef unsigned u32x2 __attribute__((ext_vector_type(2)));
typedef __bf16 bf16x2_t __attribute__((ext_vector_type(2)));

constexpr int NTHREADS = 512, NWAVES = 8;
constexpr int LDS_BYTES = 147456;
constexpr int NB = 2, SEQ = 16384, T = NB * SEQ, D = 2048;
constexpr int AH = 8, HD = 128, AW = 1024;
constexpr int SW = 512, SGRP = 32, SCH = 16, SST = 64;
constexpr int INW = 7688, NPROJ = 7680;
constexpr int NMOD = 6 * D;
constexpr int PH = 8, NKEYS = 128, NEXP = 16384, TOPK = 16, NSEL = PH * TOPK;
constexpr float RMS_EPS = 1e-6f;
constexpr float LOG2E = 1.4426950408889634f;

constexpr size_t MiB = 1u << 20;
constexpr size_t WS_CTL = 0, CTL_ZERO_BYTES = 1 * MiB;
constexpr size_t WS_LF = 1 * MiB;
constexpr size_t WS_F = 2 * MiB;
constexpr size_t WS_WF = 3 * MiB;
constexpr size_t WS_KEYS = 3 * MiB + 512 * 1024;
constexpr size_t WS_WGLU = 4 * MiB, WS_WSSM = 5 * MiB, WS_WATTN = 7 * MiB, WS_WOUT = 11 * MiB, WS_WPQ = 19 * MiB, WS_WIN = 27 * MiB;
constexpr size_t WS_S5TAB = 57 * MiB;
constexpr size_t WS_PU = 64 * MiB, WS_PV = 128 * MiB;
constexpr size_t WS_HB = 192 * MiB;
constexpr size_t WS_QKV = 320 * MiB;
constexpr size_t WS_U = 512 * MiB;
constexpr size_t WS_YATT = 544 * MiB;
constexpr size_t WS_GY = 608 * MiB;
constexpr size_t WS_YG = 640 * MiB;
constexpr size_t WS_GATES = 672 * MiB;
constexpr size_t WS_END = 928 * MiB;
constexpr int CW_DBG = 64;
constexpr int CW_QUEUE = 256;
constexpr int CW_MOD = 16384;

struct Args {
    const float *x, *c, *w_ada, *b_ada, *norm1_w, *w_in, *b_forget, *q_norm_w, *k_norm_w;
    const float *A_re, *A_im, *log_dt, *B_re, *B_im, *C_re, *C_im, *Dskip;
    const float *w_glu, *b_glu, *w_ssm_up, *w_attn_up, *w_out, *norm2_w, *w_peer_q, *sub_keys, *peer_u, *peer_v;
    float* out; unsigned char* ws;
};

DI unsigned pk2(float lo, float hi) { bf16x2_t v; v.x = (__bf16)lo; v.y = (__bf16)hi; return __builtin_bit_cast(unsigned, v); }
DI float bf2f(unsigned h) { return __uint_as_float(h << 16); }
DI float bflo(unsigned w) { return __uint_as_float(w << 16); }
DI float bfhi(unsigned w) { return __uint_as_float(w & 0xffff0000u); }
DI float sigmoidf_(float z) { return 1.0f / (1.0f + __expf(-z)); }
DI float siluf_(float z) { return z / (1.0f + __expf(-z)); }
DI float geluf_(float z) { return 0.5f * z * (1.0f + erff(z * 0.70710678118654752f)); }
DI float wave_sum(float v) {
#pragma unroll
    for (int o = 1; o < 64; o <<= 1) v += __shfl_xor(v, o);
    return v;
}
DI int otid() { int t = threadIdx.x; asm volatile("" : "+v"(t)); return t; }
#define LDS_WAIT() asm volatile("s_waitcnt lgkmcnt(0)" ::: "memory")
DI void dbg_report(unsigned* ctl, int id, float err) {
    if (!(err == err)) err = 1e30f;
    atomicMax(ctl + CW_DBG + id, __float_as_uint(fabsf(err)));
}
DI float relerr(float got, float ref, float floor_) { return fabsf(got - ref) / (fabsf(ref) + floor_); }

namespace pg8 {
constexpr int BM = 256, BK = 64, HALF = 128, HTB = HALF * BK * 2, NXCD = 8, WGM = 8;
DI int lds_byte(int r, int c) { const int st = (r >> 4) * 2 + (c >> 5), rr = r & 15, cc = c & 31, ob = rr * 64 + cc * 2; return st * 1024 + (ob ^ (((ob >> 9) & 1) << 5)); }
DI void stage_rc(int b, int& R, int& C) { const int st = b / 1024, sb = b % 1024, swz = sb ^ (((sb >> 9) & 1) << 5); R = (st >> 1) * 16 + swz / 64; C = (st & 1) * 32 + (swz % 64) / 2; }
DI int perm32(int rho) { const int n = rho >> 4, i = rho & 15; return 8 * (i >> 2) + 4 * n + (i & 3); }
struct Unit { int pm, pn; };
struct Gemm { const bf16_t* A; const bf16_t* Bt; int M, N, K; };
struct StaticOrder {
    int nM, nN, nwg, G, c;
    DI void init(int M, int N, int G_, int c_) { nM = M / BM; nN = N / BM; nwg = nM * nN; G = G_; c = c_; }
    DI bool next(int i, Unit& u) const {
        const long L = (long)i * G + c; if (L >= nwg) return false;
        int wgid = (int)L; { const int q = nwg / NXCD, r = nwg % NXCD, xcd = wgid % NXCD, off = wgid / NXCD; wgid = (xcd < r ? xcd * (q + 1) : r * (q + 1) + (xcd - r) * q) + off; }
        const int nig = WGM * nN, gid = wgid / nig, fm = gid * WGM, gsz = (nM - fm) < WGM ? (nM - fm) : WGM;
        u.pm = fm + ((wgid % nig) % gsz); u.pn = (wgid % nig) / gsz; return true;
    }
    DI void a_ready(const Unit&) const {}
    DI void done(const Unit&) const {}
};
template <class Epi, class Sched, bool ALIGN_EPI = false, bool SP2 = false>
DI void gemm_phase(LAS unsigned char* lds, const Gemm g, const Sched& S, const Epi& E) {
    int tid = threadIdx.x; asm volatile("" : "+v"(tid));
    const int wid = __builtin_amdgcn_readfirstlane(tid >> 6), lane = tid & 63, wr = wid >> 2, wc = wid & 3, fr = lane & 15, fq = lane >> 4;
    const int K = g.K, nt = K / BK;
    unsigned voffA[2], voffB[2];
#pragma unroll
    for (int i = 0; i < 2; ++i) { int R, C; stage_rc(tid * 16 + i * 8192, R, C); const int Rb = Epi::PERM ? ((R & ~31) + perm32(R & 31)) : R;
        voffA[i] = (unsigned)(R * K + C) * 2u; voffB[i] = (unsigned)(Rb * K + C) * 2u; }
    const size_t kstep = (size_t)(BK * 2);
    const size_t hstep = (size_t)HALF * K * 2;
    const size_t tstep = 2 * hstep;
    const unsigned ldsw = (unsigned)wid * 1024u;
    const int aoff = lds_byte(wr * 64 + fr, fq * 8), boff = lds_byte(wc * 32 + fr, fq * 8);
#define PG8_SA(b, h) (((b) * 2 + (h)) * HTB)
#define PG8_SB(b, h) ((4 + (b) * 2 + (h)) * HTB)
#define PG8_STAGE(bufoff, gbase, voff) do { _Pragma("unroll") for (int _i = 0; _i < 2; ++_i) \
        __builtin_amdgcn_global_load_lds((const unsigned*)((const char*)(gbase) + (voff)[_i]), (LAS unsigned*)(lds + (bufoff) + ldsw + _i * 8192), 16, 0, 0); } while (0)
#define PG8_LDA(dst, b, h) do { _Pragma("unroll") for (int m = 0; m < 4; ++m) _Pragma("unroll") for (int k = 0; k < 2; ++k) dst[m][k] = *(const LAS bf16x8*)(lds + PG8_SA(b, h) + aoff + m * 2048 + k * 1024); } while (0)
#define PG8_LDB(dst, b, h) do { _Pragma("unroll") for (int n = 0; n < 2; ++n) _Pragma("unroll") for (int k = 0; k < 2; ++k) dst[n][k] = *(const LAS bf16x8*)(lds + PG8_SB(b, h) + boff + n * 2048 + k * 1024); } while (0)
#define PG8_MMA(ai, bj, At, Bt) do { __builtin_amdgcn_s_setprio(1); _Pragma("unroll") for (int m = 0; m < 4; ++m) _Pragma("unroll") for (int n = 0; n < 2; ++n) _Pragma("unroll") for (int k = 0; k < 2; ++k) \
        acc[ai][bj][m][n] = __builtin_amdgcn_mfma_f32_16x16x32_bf16(Bt[n][k], At[m][k], acc[ai][bj][m][n], 0, 0, 0); __builtin_amdgcn_s_setprio(0); } while (0)
#define PG8_WAIT_V(n) asm volatile("s_waitcnt vmcnt(" #n ")" ::: "memory")
#define PG8_WAIT_L(n) asm volatile("s_waitcnt lgkmcnt(" #n ")" ::: "memory")
#define PG8_BAR __builtin_amdgcn_s_barrier()
#define PG8_SCHED __builtin_amdgcn_sched_barrier(0)
    Unit cur, nxt; int ui = 0;
    if (!S.next(0, cur)) return;
    f32x4 acc[2][2][4][2];
#pragma unroll
    for (int a = 0; a < 2; ++a)
#pragma unroll
        for (int b = 0; b < 2; ++b)
#pragma unroll
            for (int m = 0; m < 4; ++m)
#pragma unroll
                for (int n = 0; n < 2; ++n) acc[a][b][m][n] = (f32x4){0.f, 0.f, 0.f, 0.f};
    bf16x8 At[4][2], B0[2][2], B1[2][2];
    const char* cA = (const char*)g.A + (size_t)cur.pm * tstep; const char* cB = (const char*)g.Bt + (size_t)cur.pn * tstep;
    S.a_ready(cur);
    if constexpr (SP2) {
        PG8_STAGE(PG8_SB(0, 0), cB, voffB); PG8_STAGE(PG8_SB(0, 1), cB + hstep, voffB); PG8_STAGE(PG8_SA(0, 0), cA, voffA); PG8_STAGE(PG8_SA(0, 1), cA + hstep, voffA);
        if (wr == 1) PG8_BAR;
        PG8_WAIT_V(2); PG8_BAR;
        PG8_STAGE(PG8_SB(1, 0), cB + kstep, voffB); PG8_STAGE(PG8_SA(1, 0), cA + kstep, voffA); PG8_STAGE(PG8_SB(1, 1), cB + hstep + kstep, voffB);
        PG8_WAIT_V(6); PG8_BAR;
    } else {
        PG8_STAGE(PG8_SB(0, 0), cB, voffB); PG8_STAGE(PG8_SA(0, 0), cA, voffA); PG8_STAGE(PG8_SB(0, 1), cB + hstep, voffB); PG8_STAGE(PG8_SA(0, 1), cA + hstep, voffA);
        if (wr == 1) PG8_BAR;
        PG8_WAIT_V(4); PG8_BAR;
        PG8_STAGE(PG8_SB(1, 0), cB + kstep, voffB); PG8_STAGE(PG8_SA(1, 0), cA + kstep, voffA); PG8_STAGE(PG8_SB(1, 1), cB + hstep + kstep, voffB);
        PG8_WAIT_V(6); PG8_BAR;
    }
    for (;;) {
        const bool has_next = S.next(ui + 1, nxt);
        const char* nA = has_next ? (const char*)g.A + (size_t)nxt.pm * tstep : cA; const char* nB = has_next ? (const char*)g.Bt + (size_t)nxt.pn * tstep : cB;
        for (int t = 0; t < nt; t += 2) {
            const bool last = (t == nt - 2);
            const char* a1 = cA + (size_t)(t + 1) * kstep;
            const char* a2 = last ? nA : cA + (size_t)(t + 2) * kstep; const char* b2 = last ? nB : cB + (size_t)(t + 2) * kstep;
            const char* a3 = a2 + kstep; const char* b3 = b2 + kstep;
            if (last && has_next) S.a_ready(nxt);
            if constexpr (SP2) {
            PG8_LDB(B0, 0, 0); PG8_LDB(B1, 0, 1); PG8_SCHED; PG8_LDA(At, 0, 0); PG8_STAGE(PG8_SA(1, 1), a1 + hstep, voffA);
            PG8_WAIT_V(8); PG8_WAIT_L(0); PG8_BAR; PG8_MMA(0, 0, At, B0); PG8_MMA(0, 1, At, B1); PG8_BAR; PG8_SCHED;
            PG8_LDA(At, 0, 1); PG8_STAGE(PG8_SB(0, 0), b2, voffB); PG8_STAGE(PG8_SB(0, 1), b2 + hstep, voffB); PG8_STAGE(PG8_SA(0, 0), a2, voffA);
            PG8_WAIT_V(8); PG8_WAIT_L(0); PG8_BAR; PG8_MMA(1, 0, At, B0); PG8_MMA(1, 1, At, B1); PG8_BAR; PG8_SCHED;
            PG8_LDB(B0, 1, 0); PG8_LDB(B1, 1, 1); PG8_SCHED; PG8_LDA(At, 1, 0); PG8_STAGE(PG8_SA(0, 1), a2 + hstep, voffA);
            PG8_WAIT_V(8); PG8_WAIT_L(0); PG8_BAR; PG8_MMA(0, 0, At, B0); PG8_MMA(0, 1, At, B1); PG8_BAR; PG8_SCHED;
            PG8_LDA(At, 1, 1); PG8_STAGE(PG8_SB(1, 0), b3, voffB); PG8_STAGE(PG8_SB(1, 1), b3 + hstep, voffB); PG8_STAGE(PG8_SA(1, 0), a3, voffA);
            PG8_WAIT_V(8); PG8_WAIT_L(0); PG8_BAR; PG8_MMA(1, 0, At, B0); PG8_MMA(1, 1, At, B1); PG8_BAR; PG8_SCHED;
            } else {
            PG8_LDB(B0, 0, 0); PG8_SCHED; PG8_LDA(At, 0, 0); PG8_STAGE(PG8_SA(1, 1), a1 + hstep, voffA);
            PG8_WAIT_L(8); PG8_BAR; PG8_WAIT_L(0); PG8_MMA(0, 0, At, B0); PG8_BAR; PG8_SCHED;
            PG8_LDB(B1, 0, 1); PG8_STAGE(PG8_SB(0, 0), b2, voffB);
            PG8_BAR; PG8_WAIT_L(0); PG8_MMA(0, 1, At, B1); PG8_BAR;
            PG8_LDA(At, 0, 1); PG8_STAGE(PG8_SA(0, 0), a2, voffA);
            PG8_BAR; PG8_WAIT_L(0); PG8_MMA(1, 0, At, B0); PG8_BAR; PG8_SCHED;
            PG8_STAGE(PG8_SB(0, 1), b2 + hstep, voffB);
            PG8_WAIT_V(6); PG8_BAR; PG8_MMA(1, 1, At, B1); PG8_BAR;
            PG8_LDB(B0, 1, 0); PG8_SCHED; PG8_LDA(At, 1, 0); PG8_STAGE(PG8_SA(0, 1), a2 + hstep, voffA);
            PG8_WAIT_L(8); PG8_BAR; PG8_WAIT_L(0); PG8_MMA(0, 0, At, B0); PG8_BAR; PG8_SCHED;
            PG8_LDB(B1, 1, 1); PG8_STAGE(PG8_SB(1, 0), b3, voffB);
            PG8_BAR; PG8_WAIT_L(0); PG8_MMA(0, 1, At, B1); PG8_BAR;
            PG8_LDA(At, 1, 1); PG8_STAGE(PG8_SA(1, 0), a3, voffA);
            PG8_BAR; PG8_WAIT_L(0); PG8_MMA(1, 0, At, B0); PG8_BAR; PG8_SCHED;
            PG8_STAGE(PG8_SB(1, 1), b3 + hstep, voffB);
            PG8_WAIT_V(6); PG8_BAR; PG8_MMA(1, 1, At, B1); PG8_BAR;
            }
        }
        if constexpr (ALIGN_EPI) { if (wr == 0) PG8_BAR; }
        E(acc, cur, wr, wc, fr, fq); S.done(cur);
        if (!has_next) break;
#pragma unroll
        for (int a = 0; a < 2; ++a)
#pragma unroll
            for (int b = 0; b < 2; ++b)
#pragma unroll
                for (int m = 0; m < 4; ++m)
#pragma unroll
                    for (int n = 0; n < 2; ++n) acc[a][b][m][n] = (f32x4){0.f, 0.f, 0.f, 0.f};
        cur = nxt; cA = nA; cB = nB; ++ui;
        if constexpr (ALIGN_EPI) { if (wr == 1) PG8_BAR; }
    }
    PG8_WAIT_V(0);
    if constexpr (!ALIGN_EPI) { if (wr == 0) PG8_BAR; }
    PG8_BAR;
#undef PG8_SA
#undef PG8_SB
#undef PG8_STAGE
#undef PG8_LDA
#undef PG8_LDB
#undef PG8_MMA
#undef PG8_WAIT_V
#undef PG8_WAIT_L
#undef PG8_BAR
#undef PG8_SCHED
}
}
constexpr bool G_ALIGN = true, G_SP2 = true;

template <class F>
DI void epi_foreach(const f32x4 (&acc)[2][2][4][2], const pg8::Unit& u, int wr, int wc, int fr, int fq, const F& f) {
#pragma unroll
    for (int ai = 0; ai < 2; ++ai)
#pragma unroll
        for (int m = 0; m < 4; ++m) {
            const int row = u.pm * 256 + ai * 128 + wr * 64 + m * 16 + fr;
#pragma unroll
            for (int bj = 0; bj < 2; ++bj) {
                const int col0 = u.pn * 256 + bj * 128 + wc * 32 + 8 * fq;
                float v[8];
#pragma unroll
                for (int k = 0; k < 4; ++k) { v[k] = acc[ai][bj][m][0][k]; v[4 + k] = acc[ai][bj][m][1][k]; }
                f(row, col0, v);
            }
        }
}
DI void store8_bf16(bf16_t* p, const float (&v)[8]) {
    u32x4 w; w.x = pk2(v[0], v[1]); w.y = pk2(v[2], v[3]); w.z = pk2(v[4], v[5]); w.w = pk2(v[6], v[7]);
    *(u32x4*)p = w;
}
DI void load8_bf16(const bf16_t* p, float (&v)[8]) {
    const u32x4 w = *(const u32x4*)p;
    v[0] = bflo(w.x); v[1] = bfhi(w.x); v[2] = bflo(w.y); v[3] = bfhi(w.y); v[4] = bflo(w.z); v[5] = bfhi(w.z); v[6] = bflo(w.w); v[7] = bfhi(w.w);
}
struct EpiProj {
    static constexpr bool PERM = true;
    bf16_t *qkv, *u, *gates;
    DI void operator()(const f32x4 (&acc)[2][2][4][2], const pg8::Unit& un, int wr, int wc, int fr, int fq) const {
        const int pn = un.pn;
        if (pn < 12) { bf16_t* o = qkv; epi_foreach(acc, un, wr, wc, fr, fq, [&](int row, int col0, float (&v)[8]) { store8_bf16(o + (size_t)row * 3072 + col0, v); }); }
        else if (pn < 14) { bf16_t* o = u; epi_foreach(acc, un, wr, wc, fr, fq, [&](int row, int col0, float (&v)[8]) { store8_bf16(o + (size_t)row * 512 + (col0 - 3072), v); }); }
        else { bf16_t* o = gates; epi_foreach(acc, un, wr, wc, fr, fq, [&](int row, int col0, float (&v)[8]) {
#pragma unroll
                for (int k = 0; k < 8; ++k) v[k] = sigmoidf_(v[k]);
                store8_bf16(o + (size_t)row * 4096 + (col0 - 3584), v); }); }
    }
};


constexpr size_t WS_MRG = WS_QKV;
struct EpiGlu {
    static constexpr bool PERM = true;
    const bf16_t* gy; const float* bglu; bf16_t* yg;
    DI void operator()(const f32x4 (&acc)[2][2][4][2], const pg8::Unit& un, int wr, int wc, int fr, int fq) const {
        epi_foreach(acc, un, wr, wc, fr, fq, [&](int row, int col0, float (&v)[8]) {
            float g[8]; load8_bf16(gy + (size_t)row * SW + col0, g);
#pragma unroll
            for (int k = 0; k < 8; ++k) v[k] = g[k] * sigmoidf_(v[k] + bglu[col0 + k]);
            store8_bf16(yg + (size_t)row * SW + col0, v); });
    }
};
struct EpiSsmUp {
    static constexpr bool PERM = true;
    const bf16_t* gates; bf16_t* mrg;
    DI void operator()(const f32x4 (&acc)[2][2][4][2], const pg8::Unit& un, int wr, int wc, int fr, int fq) const {
        epi_foreach(acc, un, wr, wc, fr, fq, [&](int row, int col0, float (&v)[8]) {
            float g[8]; load8_bf16(gates + (size_t)row * 4096 + col0, g);
#pragma unroll
            for (int k = 0; k < 8; ++k) v[k] *= g[k];
            store8_bf16(mrg + (size_t)row * D + col0, v); });
    }
};
struct EpiAttnUp {
    static constexpr bool PERM = true;
    const bf16_t* gates; bf16_t* mrg;
    DI void operator()(const f32x4 (&acc)[2][2][4][2], const pg8::Unit& un, int wr, int wc, int fr, int fq) const {
        epi_foreach(acc, un, wr, wc, fr, fq, [&](int row, int col0, float (&v)[8]) {
            float g[8], o[8]; load8_bf16(gates + (size_t)row * 4096 + 2048 + col0, g); load8_bf16(mrg + (size_t)row * D + col0, o);
#pragma unroll
            for (int k = 0; k < 8; ++k) v[k] = v[k] * g[k] + o[k];
            store8_bf16(mrg + (size_t)row * D + col0, v); });
    }
};
struct EpiOut {
    static constexpr bool PERM = true;
    const float* x; const float* mod; const float* bada; float* out;
    DI void operator()(const f32x4 (&acc)[2][2][4][2], const pg8::Unit& un, int wr, int wc, int fr, int fq) const {
        epi_foreach(acc, un, wr, wc, fr, fq, [&](int row, int col0, float (&v)[8]) {
            const int b = row >> 14;
            const float* gp = mod + b * NMOD + 2 * D + col0;
            const f32x4 g0 = *(const f32x4*)gp, g1 = *(const f32x4*)(gp + 4);
            const f32x4 x0 = *(const f32x4*)(x + (size_t)row * D + col0), x1 = *(const f32x4*)(x + (size_t)row * D + col0 + 4);
            f32x4 r0, r1;
#pragma unroll
            for (int k = 0; k < 4; ++k) { r0[k] = x0[k] + g0[k] * v[k]; r1[k] = x1[k] + g1[k] * v[4 + k]; }
            *(f32x4*)(out + (size_t)row * D + col0) = r0; *(f32x4*)(out + (size_t)row * D + col0 + 4) = r1; });
    }
};

DI void transpose_item(const float* W, int ldw, int src_n0, bf16_t* WT, int K, int dst_n0, int k0, LAS float* scr, int lane) {
#pragma unroll 8
    for (int i = 0; i < 32; ++i) { const int kk = 2 * i + (lane >> 5); scr[kk * 33 + (lane & 31)] = W[(size_t)(k0 + kk) * ldw + src_n0 + (lane & 31)]; }
    LDS_WAIT();
    const int c = lane & 7;
#pragma unroll
    for (int j = 0; j < 4; ++j) { const int n = (lane >> 3) + 8 * j; const LAS float* s = scr + (8 * c) * 33 + n;
        u32x4 o; o.x = pk2(s[0 * 33], s[1 * 33]); o.y = pk2(s[2 * 33], s[3 * 33]); o.z = pk2(s[4 * 33], s[5 * 33]); o.w = pk2(s[6 * 33], s[7 * 33]);
        *(u32x4*)(WT + (size_t)(dst_n0 + n) * K + k0 + 8 * c) = o; }
    LDS_WAIT();
}
DI void convert_stream(const float* src, bf16_t* dst, size_t n, size_t gthread, size_t nthreads) {
    for (size_t i = gthread * 8; i < n; i += nthreads * 8) {
        const f32x4 a = *(const f32x4*)(src + i), b = *(const f32x4*)(src + i + 4);
        u32x4 o; o.x = pk2(a.x, a.y); o.y = pk2(a.z, a.w); o.z = pk2(b.x, b.y); o.w = pk2(b.z, b.w);
        *(u32x4*)(dst + i) = o;
    }
}
DI void phase0(const Args& a, LAS unsigned char* lds) {
    const int tid = otid(), lane = tid & 63, wave = tid >> 6, G = gridDim.x, blk = blockIdx.x;
    unsigned char* ws = a.ws;
    {
        LAS float* sc = (LAS float*)lds;
        LAS float* red = (LAS float*)(lds + 16384);
        float* mod = (float*)(ws + WS_CTL) + CW_MOD;
        if (blk < 96) {
            for (int i = tid; i < 2 * D; i += NTHREADS) sc[i] = siluf_(a.c[i]);
            __syncthreads();
            for (int it = blk; it < 96; it += G) {
                const int col = it * 128 + (tid & 127), kq = tid >> 7;
                float a0 = 0.f, a1 = 0.f;
#pragma unroll 8
                for (int k = kq * 512; k < kq * 512 + 512; ++k) { const float w = a.w_ada[(size_t)k * NMOD + col]; a0 += sc[k] * w; a1 += sc[D + k] * w; }
                red[kq * 128 + (tid & 127)] = a0; red[512 + kq * 128 + (tid & 127)] = a1;
                __syncthreads();
                if (tid < 256) { const int b = tid >> 7, c = tid & 127; const LAS float* r = red + b * 512 + c;
                    mod[b * NMOD + it * 128 + c] = ((r[0] + r[128]) + (r[256] + r[384])) + a.b_ada[it * 128 + c]; }
                __syncthreads();
            }
        }
        __syncthreads();
    }
    LAS float* scr = (LAS float*)(lds + wave * 16384);
    const int gw = blk * NWAVES + wave, NGW = G * NWAVES;
    constexpr int I_IN = 32 * 240, I_GLU = 8 * 16, I_SSM = 8 * 64, I_ATT = 16 * 64, I_OUT = 32 * 64, I_PQ = 32 * 64;
    constexpr int NIT = I_IN + I_GLU + I_SSM + I_ATT + I_OUT + I_PQ;
    for (int it = gw; it < NIT; it += NGW) {
        int r = it;
        if (r < I_IN) { const int kb = r / 240, nb = r % 240, n0 = nb * 32; transpose_item(a.w_in, INW, n0 + (n0 >= 3072 ? 8 : 0), (bf16_t*)(ws + WS_WIN), D, n0, kb * 64, scr, lane); continue; } r -= I_IN;
        if (r < I_GLU) { const int kb = r / 16, nb = r % 16; transpose_item(a.w_glu, SW, nb * 32, (bf16_t*)(ws + WS_WGLU), SW, nb * 32, kb * 64, scr, lane); continue; } r -= I_GLU;
        if (r < I_SSM) { const int kb = r / 64, nb = r % 64; transpose_item(a.w_ssm_up, D, nb * 32, (bf16_t*)(ws + WS_WSSM), SW, nb * 32, kb * 64, scr, lane); continue; } r -= I_SSM;
        if (r < I_ATT) { const int kb = r / 64, nb = r % 64; transpose_item(a.w_attn_up, D, nb * 32, (bf16_t*)(ws + WS_WATTN), AW, nb * 32, kb * 64, scr, lane); continue; } r -= I_ATT;
        if (r < I_OUT) { const int kb = r / 64, nb = r % 64; transpose_item(a.w_out, D, nb * 32, (bf16_t*)(ws + WS_WOUT), D, nb * 32, kb * 64, scr, lane); continue; } r -= I_OUT;
        { const int kb = r / 64, nb = r % 64; transpose_item(a.w_peer_q, D, nb * 32, (bf16_t*)(ws + WS_WPQ), D, nb * 32, kb * 64, scr, lane); }
    }
    {
        float* wf = (float*)(ws + WS_WF);
        for (int i = blk * NTHREADS + tid; i < 8 * D; i += G * NTHREADS) { const int j = i >> 11, k = i & 2047; wf[i] = a.w_in[(size_t)k * INW + 3072 + j]; }
    }
    const size_t gt = (size_t)blk * NTHREADS + tid, nthr = (size_t)G * NTHREADS;
    convert_stream(a.sub_keys, (bf16_t*)(ws + WS_KEYS), (size_t)16 * 128 * 128, gt, nthr);
    convert_stream(a.peer_u, (bf16_t*)(ws + WS_PU), (size_t)NEXP * D, gt, nthr);
    convert_stream(a.peer_v, (bf16_t*)(ws + WS_PV), (size_t)NEXP * D, gt, nthr);
}

template <bool WITH_F>
DI void row_pass(const Args& a, LAS unsigned char* lds, const float* xin, const float* normw, int shift_idx, int scale_idx, bf16_t* hb) {
    const int tid = otid(), lane = tid & 63, wave = tid >> 6, G = gridDim.x, blk = blockIdx.x;
    const float* mod = (const float*)(a.ws + WS_CTL) + CW_MOD;
    LAS f32x4* wfl = (LAS f32x4*)lds;
    if (WITH_F) {
        const f32x4* wf = (const f32x4*)(a.ws + WS_WF);
        for (int i = tid; i < 8 * 512; i += NTHREADS) wfl[i] = wf[i];
        __syncthreads();
    }
    const int gw = blk * NWAVES + wave, NGW = G * NWAVES;
    int curb = -1;
    f32x4 gg[8], sh[8];
    for (int m = gw; m < T; m += NGW) {
        const int b = m >> 14;
        if (b != curb) {
            curb = b;
#pragma unroll
            for (int j = 0; j < 8; ++j) {
                const int e = 4 * (lane + 64 * j);
                const f32x4 nw = *(const f32x4*)(normw + e);
                const f32x4 sc = *(const f32x4*)(mod + b * NMOD + scale_idx * D + e);
                sh[j] = *(const f32x4*)(mod + b * NMOD + shift_idx * D + e);
                gg[j] = nw * (sc + 1.0f);
            }
        }
        const f32x4* xr = (const f32x4*)(xin + (size_t)m * D) + lane;
        f32x4 v[8]; float ss = 0.f;
#pragma unroll
        for (int j = 0; j < 8; ++j) { v[j] = xr[64 * j]; ss += (v[j].x * v[j].x + v[j].y * v[j].y) + (v[j].z * v[j].z + v[j].w * v[j].w); }
        const float r = rsqrtf(wave_sum(ss) * (1.0f / D) + RMS_EPS);
#pragma unroll
        for (int j = 0; j < 8; ++j) v[j] = v[j] * r * gg[j] + sh[j];
        u32x2* o = (u32x2*)(hb + (size_t)m * D) + lane;
#pragma unroll
        for (int j = 0; j < 8; ++j) { u32x2 w; w.x = pk2(v[j].x, v[j].y); w.y = pk2(v[j].z, v[j].w); o[64 * j] = w; }
        if (WITH_F) {
            float mine = 0.f;
#pragma unroll 1
            for (int q = 0; q < 8; ++q) {
                float s = 0.f;
#pragma unroll
                for (int j = 0; j < 8; ++j) { const f32x4 w = wfl[q * 512 + lane + 64 * j]; s += (v[j].x * w.x + v[j].y * w.y) + (v[j].z * w.z + v[j].w * w.w); }
                s = wave_sum(s);
                mine = (lane == q) ? s : mine;
            }
            if (lane < 8) {
                const float z = mine + a.b_forget[lane];
                const float ls = fminf(z, 0.f) - log1pf(__expf(-fabsf(z)));
                ((float*)(a.ws + WS_LF))[(size_t)m * 8 + lane] = ls;
            }
        }
    }
}


constexpr size_t WS_VT = WS_HB;
constexpr size_t WS_DBGS = 928 * MiB;
DI void phase2b(const Args& a, LAS unsigned char* lds) {
    const int tid = otid(), lane = tid & 63, wave = tid >> 6, G = gridDim.x, blk = blockIdx.x;
    const int gw = blk * NWAVES + wave, NGW = G * NWAVES;
    bf16_t* qkv = (bf16_t*)(a.ws + WS_QKV);
    if (gw < NB * AH) {
        const int b = gw >> 3, h = gw & 7;
        const float* lf = (const float*)(a.ws + WS_LF);
        float* F = (float*)(a.ws + WS_F) + (size_t)gw * SEQ;
        double carry = 0.0;
        for (int c = 0; c < SEQ / 64; ++c) {
            const int s = c * 64 + lane;
            double x = (double)lf[((size_t)b * SEQ + s) * 8 + h];
#pragma unroll
            for (int o = 1; o < 64; o <<= 1) { const double t = __shfl_up(x, o); if (lane >= o) x += t; }
            F[s] = (float)((carry + x) * 1.4426950408889634);
            carry += __shfl(x, 63);
        }
    }
    {
        const int head = lane >> 3, d0 = (lane & 7) * 16;
        float wq[16], wk[16];
        const float QS = 0.08838834764831845f * LOG2E;
#pragma unroll
        for (int i = 0; i < 16; ++i) { wq[i] = a.q_norm_w[d0 + i] * QS; wk[i] = a.k_norm_w[d0 + i]; }
        for (int m = gw; m < T; m += NGW) {
            bf16_t* row = qkv + (size_t)m * 3072 + head * 128 + d0;
#pragma unroll
            for (int qk = 0; qk < 2; ++qk) {
                bf16_t* p = row + qk * 1024;
                float v[16]; float va[8], vb[8];
                load8_bf16(p, va); load8_bf16(p + 8, vb);
#pragma unroll
                for (int i = 0; i < 8; ++i) { v[i] = va[i]; v[8 + i] = vb[i]; }
                float ss = 0.f;
#pragma unroll
                for (int i = 0; i < 16; ++i) ss += v[i] * v[i];
                ss += __shfl_xor(ss, 1); ss += __shfl_xor(ss, 2); ss += __shfl_xor(ss, 4);
                const float r = rsqrtf(ss * (1.0f / HD) + RMS_EPS);
#pragma unroll
                for (int i = 0; i < 8; ++i) { va[i] = v[i] * r * (qk ? wk[i] : wq[i]); vb[i] = v[8 + i] * r * (qk ? wk[8 + i] : wq[8 + i]); }
                store8_bf16(p, va); store8_bf16(p + 8, vb);
            }
        }
    }
    {
        LAS unsigned char* tile = lds + wave * 17408;
        bf16_t* vt = (bf16_t*)(a.ws + WS_VT);
        for (int it = gw; it < NB * AH * (SEQ / 64); it += NGW) {
            const int b = it / (AH * 256), h = (it / 256) % AH, c = it % 256;
            const size_t m0 = (size_t)b * SEQ + c * 64;
#pragma unroll 4
            for (int i = 0; i < 16; ++i) { const int row = 4 * i + (lane >> 4), ch = lane & 15;
                const u32x4 v = *(const u32x4*)(qkv + (m0 + row) * 3072 + 2048 + h * 128 + ch * 8);
                *(LAS u32x4*)(tile + row * 272 + ch * 16) = v; }
            LDS_WAIT();
#pragma unroll 1
            for (int dd = 0; dd < 2; ++dd) {
                const int d = lane + 64 * dd;
                bf16_t* dst = vt + (((size_t)(b * AH + h) * HD + d) * SEQ) + c * 64;
#pragma unroll
                for (int g4 = 0; g4 < 4; ++g4) {
                    unsigned w[8];
#pragma unroll
                    for (int pp = 0; pp < 8; ++pp) {
                        const int p0 = 2 * pp, p1 = 2 * pp + 1;
                        const int k0 = 8 * ((p0 >> 2) & 1) + 4 * (p0 >> 3) + (p0 & 3), k1 = 8 * ((p1 >> 2) & 1) + 4 * (p1 >> 3) + (p1 & 3);
                        const unsigned lo = *(const LAS unsigned short*)(tile + (g4 * 16 + k0) * 272 + d * 2);
                        const unsigned hi = *(const LAS unsigned short*)(tile + (g4 * 16 + k1) * 272 + d * 2);
                        w[pp] = lo | (hi << 16);
                    }
                    *(u32x4*)(dst + g4 * 16) = (u32x4){w[0], w[1], w[2], w[3]};
                    *(u32x4*)(dst + g4 * 16 + 8) = (u32x4){w[4], w[5], w[6], w[7]};
                }
            }
            LDS_WAIT();
        }
    }
}

DI void attn_item(const Args& a, LAS unsigned char* lds, int b, int h, int qb, float thr2) {
    const int tid = otid(), lane = tid & 63, wave = __builtin_amdgcn_readfirstlane(tid >> 6), q = lane & 31, hh = lane >> 5;
    const bf16_t* qkv = (const bf16_t*)(a.ws + WS_QKV);
    const bf16_t* vt = (const bf16_t*)(a.ws + WS_VT) + (size_t)(b * AH + h) * HD * SEQ;
    const float* F = (const float*)(a.ws + WS_F) + (size_t)(b * AH + h) * SEQ;
    const int t0 = qb * 256, tw0 = t0 + 32 * wave, t = tw0 + q;
    const size_t mrow = (size_t)b * SEQ;
    LAS unsigned char* Kl = lds; LAS unsigned char* Vl = lds + 16384; LAS float* Fl = (LAS float*)(lds + 32768);
    int j0;
    {
        const float Ft0 = F[t0]; const int jd = t0 / 64; int need = 0;
        for (int k = 0; k < 4; ++k) {
            const int jj = jd - 1 - (64 * k + lane);
            const bool nd = (jj >= 0) && (Ft0 - F[jj >= 0 ? 64 * jj + 63 : 0] > -thr2);
            const unsigned long long bal = __ballot(nd);
            need += __popcll(bal);
            if (bal != ~0ull) break;
        }
        j0 = jd - need;
    }
    const int jend = t0 / 64 + 3;
    bf16x8 qf[8];
#pragma unroll
    for (int ks = 0; ks < 8; ++ks) qf[ks] = *(const bf16x8*)(qkv + (mrow + t) * 3072 + h * 128 + ks * 16 + hh * 8);
    const float Fq = F[t];
    f32x16 o[4];
#pragma unroll
    for (int i = 0; i < 4; ++i)
#pragma unroll
        for (int r = 0; r < 16; ++r) o[i][r] = 0.f;
    float mrun = -1e30f, lrun = 0.f;
    u32x4 kreg[2], vreg[2]; float freg = 0.f;
    auto issue = [&](int j) {
#pragma unroll
        for (int i = 0; i < 2; ++i) { const int idx = tid + 512 * i;
            kreg[i] = *(const u32x4*)(qkv + (mrow + 64 * j + (idx >> 4)) * 3072 + 1024 + h * 128 + (idx & 15) * 8);
            vreg[i] = *(const u32x4*)(vt + (size_t)(idx >> 3) * SEQ + 64 * j + (idx & 7) * 8); }
        if (tid < 64) freg = F[64 * j + tid];
    };
    auto commit = [&]() {
#pragma unroll
        for (int i = 0; i < 2; ++i) { const int idx = tid + 512 * i;
            { const int r = idx >> 4, ch = idx & 15; *(LAS u32x4*)(Kl + r * 256 + ((ch ^ (r & 15)) << 4)) = kreg[i]; }
            { const int d = idx >> 3, ch = idx & 7; *(LAS u32x4*)(Vl + d * 128 + ((ch ^ ((d >> 1) & 7)) << 4)) = vreg[i]; } }
        if (tid < 64) Fl[tid] = freg;
    };
    issue(j0);
    for (int j = j0; j <= jend; ++j) {
        __syncthreads();
        commit();
        __syncthreads();
        if (j < jend) issue(j + 1);
        if (64 * j <= tw0 + 31) {
            f32x16 sacc[2];
#pragma unroll
            for (int rb = 0; rb < 2; ++rb) {
#pragma unroll
                for (int r = 0; r < 16; ++r) sacc[rb][r] = 0.f;
#pragma unroll
                for (int ks = 0; ks < 8; ++ks) {
                    const int r = rb * 32 + q, ch = ks * 2 + hh;
                    const bf16x8 kf = *(const LAS bf16x8*)(Kl + r * 256 + ((ch ^ (r & 15)) << 4));
                    sacc[rb] = __builtin_amdgcn_mfma_f32_32x32x16_bf16(kf, qf[ks], sacc[rb], 0, 0, 0);
                }
            }
            const bool diag = (64 * j + 63 > tw0);
            float mx = -1e30f;
#pragma unroll
            for (int rb = 0; rb < 2; ++rb)
#pragma unroll
                for (int g4 = 0; g4 < 4; ++g4) {
                    const f32x4 fs = *(const LAS f32x4*)(Fl + rb * 32 + 8 * g4 + 4 * hh);
#pragma unroll
                    for (int i = 0; i < 4; ++i) {
                        const int reg = 4 * g4 + i;
                        float s = sacc[rb][reg] + (Fq - fs[i]);
                        if (diag) { const int key = 64 * j + rb * 32 + 8 * g4 + 4 * hh + i; s = (key > t) ? -1e30f : s; }
                        sacc[rb][reg] = s; mx = fmaxf(mx, s);
                    }
                }
            mx = fmaxf(mx, __shfl_xor(mx, 32));
            const float mnew = fmaxf(mrun, mx);
            const float alpha = __builtin_amdgcn_exp2f(mrun - mnew);
            mrun = mnew;
            float ps = 0.f;
#pragma unroll
            for (int rb = 0; rb < 2; ++rb)
#pragma unroll
                for (int r = 0; r < 16; ++r) { const float p = __builtin_amdgcn_exp2f(sacc[rb][r] - mnew); sacc[rb][r] = p; ps += p; }
            lrun = lrun * alpha + ps;
#pragma unroll
            for (int i = 0; i < 4; ++i)
#pragma unroll
                for (int r = 0; r < 16; ++r) o[i][r] *= alpha;
#pragma unroll
            for (int rb = 0; rb < 2; ++rb)
#pragma unroll
                for (int s2 = 0; s2 < 2; ++s2) {
                    u32x4 pw; pw.x = pk2(sacc[rb][8 * s2 + 0], sacc[rb][8 * s2 + 1]); pw.y = pk2(sacc[rb][8 * s2 + 2], sacc[rb][8 * s2 + 3]);
                    pw.z = pk2(sacc[rb][8 * s2 + 4], sacc[rb][8 * s2 + 5]); pw.w = pk2(sacc[rb][8 * s2 + 6], sacc[rb][8 * s2 + 7]);
                    const bf16x8 pf = __builtin_bit_cast(bf16x8, pw);
                    const int ch = rb * 4 + s2 * 2 + hh;
#pragma unroll
                    for (int db = 0; db < 4; ++db) {
                        const int d = db * 32 + q;
                        const bf16x8 vf = *(const LAS bf16x8*)(Vl + d * 128 + ((ch ^ ((d >> 1) & 7)) << 4));
                        o[db] = __builtin_amdgcn_mfma_f32_32x32x16_bf16(vf, pf, o[db], 0, 0, 0);
                    }
                }
        }
    }
    const float ltot = lrun + __shfl_xor(lrun, 32);
    const float inv = 1.0f / ltot;
    bf16_t* yo = (bf16_t*)(a.ws + WS_YATT) + (mrow + t) * AW + h * 128;
#pragma unroll
    for (int db = 0; db < 4; ++db)
#pragma unroll
        for (int g4 = 0; g4 < 4; ++g4) {
            u32x2 w; w.x = pk2(o[db][4 * g4] * inv, o[db][4 * g4 + 1] * inv); w.y = pk2(o[db][4 * g4 + 2] * inv, o[db][4 * g4 + 3] * inv);
            *(u32x2*)(yo + db * 32 + 8 * g4 + 4 * hh) = w;
        }
    __syncthreads();
}

DI void s5_naive_item(const Args& a, int b, int g, int lane) {
    const int p = lane;
    const float lre = a.A_re[g * SST + p], lim = a.A_im[g * SST + p], dt = expf(a.log_dt[g]);
    const float mag = expf(lre * dt), abr = mag * cosf(lim * dt), abi = mag * sinf(lim * dt);
    const float den = lre * lre + lim * lim, nr = abr - 1.0f;
    const float cr = (nr * lre + abi * lim) / den, ci = (abi * lre - nr * lim) / den;
    float bbr[16], bbi[16], ccr[16], cci[16], dsk[16];
#pragma unroll
    for (int c = 0; c < 16; ++c) {
        const float br = a.B_re[(g * SST + p) * SCH + c], bi = a.B_im[(g * SST + p) * SCH + c];
        bbr[c] = cr * br - ci * bi; bbi[c] = cr * bi + ci * br;
        ccr[c] = a.C_re[(g * SCH + c) * SST + p]; cci[c] = a.C_im[(g * SCH + c) * SST + p];
        dsk[c] = a.Dskip[g * SCH + c];
    }
    const bf16_t* U = (const bf16_t*)(a.ws + WS_U);
    bf16_t* GY = (bf16_t*)(a.ws + WS_GY);
    float sr = 0.f, si = 0.f;
    for (int t = 0; t < SEQ; ++t) {
        const size_t m = (size_t)b * SEQ + t;
        float ua[8], ub[8], u[16];
        load8_bf16(U + m * SW + g * SCH, ua); load8_bf16(U + m * SW + g * SCH + 8, ub);
#pragma unroll
        for (int c = 0; c < 8; ++c) { u[c] = ua[c]; u[8 + c] = ub[c]; }
        float bur = 0.f, bui = 0.f;
#pragma unroll
        for (int c = 0; c < 16; ++c) { bur += bbr[c] * u[c]; bui += bbi[c] * u[c]; }
        const float nsr = abr * sr - abi * si + bur, nsi = abr * si + abi * sr + bui;
        sr = nsr; si = nsi;
        float y[16];
#pragma unroll
        for (int c = 0; c < 16; ++c) y[c] = ccr[c] * sr - cci[c] * si;
        float y8[8], y4[4], y2[2], y1;
        { const bool hi = lane & 32;
#pragma unroll
          for (int i = 0; i < 8; ++i) { const float snd = hi ? y[i] : y[i + 8], kp = hi ? y[i + 8] : y[i]; y8[i] = kp + __shfl_xor(snd, 32); } }
        { const bool hi = lane & 16;
#pragma unroll
          for (int i = 0; i < 4; ++i) { const float snd = hi ? y8[i] : y8[i + 4], kp = hi ? y8[i + 4] : y8[i]; y4[i] = kp + __shfl_xor(snd, 16); } }
        { const bool hi = lane & 8;
#pragma unroll
          for (int i = 0; i < 2; ++i) { const float snd = hi ? y4[i] : y4[i + 2], kp = hi ? y4[i + 2] : y4[i]; y2[i] = kp + __shfl_xor(snd, 8); } }
        { const bool hi = lane & 4; const float snd = hi ? y2[0] : y2[1], kp = hi ? y2[1] : y2[0]; y1 = kp + __shfl_xor(snd, 4); }
        y1 += __shfl_xor(y1, 1); y1 += __shfl_xor(y1, 2);
        const int c = ((lane >> 5) & 1) * 8 + ((lane >> 4) & 1) * 4 + ((lane >> 3) & 1) * 2 + ((lane >> 2) & 1);
        float uc = u[0], dc = dsk[0];
#pragma unroll
        for (int i = 1; i < 16; ++i) { uc = (c == i) ? u[i] : uc; dc = (c == i) ? dsk[i] : dc; }
        if ((lane & 3) == 0) { const float yy = y1 + dc * uc; GY[m * SW + g * SCH + c] = (bf16_t)(pk2(geluf_(yy), 0.f) & 0xffffu); }
    }
}

DI void phase3(const Args& a, LAS unsigned char* lds) {
    const int tid = otid(), lane = tid & 63, wave = tid >> 6, blk = blockIdx.x;
    unsigned* ctl = (unsigned*)(a.ws + WS_CTL);
    if (blk < NB * SGRP && wave == 0) s5_naive_item(a, blk >> 5, blk & 31, lane);
    float wqm = 0.f, wkm = 0.f;
    for (int i = lane; i < HD; i += 64) { wqm = fmaxf(wqm, fabsf(a.q_norm_w[i])); wkm = fmaxf(wkm, fabsf(a.k_norm_w[i])); }
#pragma unroll
    for (int o = 1; o < 64; o <<= 1) { wqm = fmaxf(wqm, __shfl_xor(wqm, o)); wkm = fmaxf(wkm, __shfl_xor(wkm, o)); }
    const float qkb2 = 11.313708499f * wqm * wkm * LOG2E * 1.02f;
    const float thr2 = 2.0f * qkb2 + 30.0f * LOG2E;
    LAS int* qi = (LAS int*)(lds + 40960);
    for (;;) {
        __syncthreads();
        if (tid == 0) *qi = (int)atomicAdd(ctl + CW_QUEUE, 1u);
        __syncthreads();
        const int it = *qi;
        if (it >= NB * AH * 64) break;
        attn_item(a, lds, it / (AH * 64), (it / 64) % AH, it % 64, thr2);
    }
}


constexpr size_t WS_H2B = WS_HB;
constexpr size_t WS_QP = WS_GATES;
constexpr size_t WS_IDS = WS_GATES + 128 * MiB;
constexpr size_t WS_GW = WS_GATES + 144 * MiB;
struct EpiPlain {
    static constexpr bool PERM = true;
    bf16_t* o; int ldc;
    DI void operator()(const f32x4 (&acc)[2][2][4][2], const pg8::Unit& un, int wr, int wc, int fr, int fq) const {
        epi_foreach(acc, un, wr, wc, fr, fq, [&](int row, int col0, float (&v)[8]) { store8_bf16(o + (size_t)row * ldc + col0, v); });
    }
};
DI unsigned enc_sortable(float f) { const unsigned u = __float_as_uint(f); return u ^ ((u >> 31) ? 0xffffffffu : 0x80000000u); }
DI float dec_sortable(unsigned s) { return __uint_as_float(s ^ ((s >> 31) ? 0x80000000u : 0xffffffffu)); }
#define TOPK_INSERT(L, x_) do { unsigned _x = (x_); _Pragma("unroll") for (int _k = 0; _k < 16; ++_k) { const unsigned _hi = max(L[_k], _x); _x = min(L[_k], _x); L[_k] = _hi; } } while (0)
DI void sort_bitonic16_desc(unsigned (&M)[16]) {
#pragma unroll
    for (int st = 8; st >= 1; st >>= 1)
#pragma unroll
        for (int i = 0; i < 16; ++i) if ((i & st) == 0) { const unsigned a_ = max(M[i], M[i + st]), b_ = min(M[i], M[i + st]); M[i] = a_; M[i + st] = b_; }
}
DI void peer_select_item(const Args& a, LAS unsigned char* lds, int h, int tile) {
    const int tid = otid(), lane = tid & 63, wave = tid >> 6, q = lane & 31, hh = lane >> 5;
    const bf16_t* keys = (const bf16_t*)(a.ws + WS_KEYS) + (size_t)h * 2 * NKEYS * 128;
    __syncthreads();
    for (int i = tid; i < 2 * NKEYS * 16; i += NTHREADS) {
        const int r = i >> 4, ch = i & 15;
        *(LAS u32x4*)(lds + r * 256 + ((ch ^ (r & 15)) << 4)) = *(const u32x4*)(keys + (size_t)r * 128 + ch * 8);
    }
    __syncthreads();
    const size_t m = (size_t)tile * 256 + wave * 32 + q;
    const bf16_t* qp = (const bf16_t*)(a.ws + WS_QP) + m * D + h * 256;
    unsigned S[2][16];
#pragma unroll
    for (int p = 0; p < 2; ++p) {
        bf16x8 qf[8];
#pragma unroll
        for (int ks = 0; ks < 8; ++ks) qf[ks] = *(const bf16x8*)(qp + p * 128 + ks * 16 + hh * 8);
        f32x16 acc[4];
#pragma unroll
        for (int rb = 0; rb < 4; ++rb) {
#pragma unroll
            for (int r = 0; r < 16; ++r) acc[rb][r] = 0.f;
#pragma unroll
            for (int ks = 0; ks < 8; ++ks) {
                const int r = p * 128 + rb * 32 + q, ch = ks * 2 + hh;
                const bf16x8 kf = *(const LAS bf16x8*)(lds + r * 256 + ((ch ^ (r & 15)) << 4));
                acc[rb] = __builtin_amdgcn_mfma_f32_32x32x16_bf16(kf, qf[ks], acc[rb], 0, 0, 0);
            }
        }
        unsigned L[16];
#pragma unroll
        for (int k = 0; k < 16; ++k) L[k] = 0u;
#pragma unroll
        for (int rb = 0; rb < 4; ++rb)
#pragma unroll
            for (int r = 0; r < 16; ++r) {
                const unsigned n = rb * 32 + (r & 3) + 8 * (r >> 2) + 4 * hh;
                TOPK_INSERT(L, (enc_sortable(acc[rb][r]) & ~0x7Fu) | n);
            }
        unsigned M[16];
#pragma unroll
        for (int k = 0; k < 16; ++k) { const unsigned pl = __shfl_xor(L[15 - k], 32); M[k] = max(L[k], pl); }
        sort_bitonic16_desc(M);
#pragma unroll
        for (int k = 0; k < 16; ++k) S[p][k] = M[k];
    }
    float f0[16], f1[16];
#pragma unroll
    for (int k = 0; k < 16; ++k) { f0[k] = dec_sortable(S[0][k] & ~0x7Fu); f1[k] = dec_sortable(S[1][k] & ~0x7Fu); }
    unsigned R[16];
#pragma unroll
    for (int k = 0; k < 16; ++k) R[k] = 0u;
#pragma unroll
    for (int p = 0; p < 16; ++p)
#pragma unroll
        for (int c = 0; c < 16; ++c) if ((p + 1) * (c + 1) <= 16) TOPK_INSERT(R, (enc_sortable(f0[p] + f1[c]) & ~0xFFu) | (unsigned)(p * 16 + c));
    unsigned pk0[4] = {0, 0, 0, 0}, pk1[4] = {0, 0, 0, 0};
#pragma unroll
    for (int k = 0; k < 16; ++k) { pk0[k >> 2] |= (S[0][k] & 0x7Fu) << (8 * (k & 3)); pk1[k >> 2] |= (S[1][k] & 0x7Fu) << (8 * (k & 3)); }
    int eid[16]; float ew[16]; float esum = 0.f;
    const float tv0 = dec_sortable(R[0] & ~0xFFu);
#pragma unroll
    for (int r = 0; r < 16; ++r) {
        const unsigned pq = R[r] & 0xFFu, p = pq >> 4, c = pq & 15u;
        unsigned w0 = pk0[0], w1 = pk1[0];
        w0 = (p >> 2) == 1 ? pk0[1] : w0; w0 = (p >> 2) == 2 ? pk0[2] : w0; w0 = (p >> 2) == 3 ? pk0[3] : w0;
        w1 = (c >> 2) == 1 ? pk1[1] : w1; w1 = (c >> 2) == 2 ? pk1[2] : w1; w1 = (c >> 2) == 3 ? pk1[3] : w1;
        const unsigned i0 = (w0 >> (8 * (p & 3))) & 0x7Fu, i1 = (w1 >> (8 * (c & 3))) & 0x7Fu;
        eid[r] = (int)(i0 * NKEYS + i1);
        ew[r] = __expf(dec_sortable(R[r] & ~0xFFu) - tv0); esum += ew[r];
    }
    const float inv = 1.0f / esum;
    if (hh == 0) {
        int* o = (int*)(a.ws + WS_IDS) + m * NSEL + h * 16;
#pragma unroll
        for (int r = 0; r < 16; r += 4) *(u32x4*)(o + r) = (u32x4){(unsigned)eid[r], (unsigned)eid[r + 1], (unsigned)eid[r + 2], (unsigned)eid[r + 3]};
    } else {
        float* o = (float*)(a.ws + WS_GW) + m * NSEL + h * 16;
#pragma unroll
        for (int r = 0; r < 16; r += 4) *(f32x4*)(o + r) = (f32x4){ew[r] * inv, ew[r + 1] * inv, ew[r + 2] * inv, ew[r + 3] * inv};
    }
}
DI void phase9(const Args& a, LAS unsigned char* lds) {
    for (int it = blockIdx.x; it < PH * (T / 256); it += gridDim.x) peer_select_item(a, lds, it / (T / 256), it % (T / 256));
}

DI float dot8(const u32x4 a_, const u32x4 b_, float acc) {
    const unsigned a0 = a_[0], a1 = a_[1], a2 = a_[2], a3 = a_[3], b0 = b_[0], b1 = b_[1], b2 = b_[2], b3 = b_[3];
    acc = __builtin_amdgcn_fdot2_f32_bf16(__builtin_bit_cast(bf16x2_t, a0), __builtin_bit_cast(bf16x2_t, b0), acc, false);
    acc = __builtin_amdgcn_fdot2_f32_bf16(__builtin_bit_cast(bf16x2_t, a1), __builtin_bit_cast(bf16x2_t, b1), acc, false);
    acc = __builtin_amdgcn_fdot2_f32_bf16(__builtin_bit_cast(bf16x2_t, a2), __builtin_bit_cast(bf16x2_t, b2), acc, false);
    acc = __builtin_amdgcn_fdot2_f32_bf16(__builtin_bit_cast(bf16x2_t, a3), __builtin_bit_cast(bf16x2_t, b3), acc, false);
    return acc;
}
DI void phase10(const Args& a) {
    const int tid = otid(), lane = tid & 63, wave = tid >> 6;
    const int gw = blockIdx.x * NWAVES + wave, NGW = gridDim.x * NWAVES;
    const bf16_t* PU = (const bf16_t*)(a.ws + WS_PU); const bf16_t* PV = (const bf16_t*)(a.ws + WS_PV);
    const float* mod = (const float*)(a.ws + WS_CTL) + CW_MOD;
    for (int m = gw; m < T; m += NGW) {
        const int b = m >> 14;
        const int* ids = (const int*)(a.ws + WS_IDS) + (size_t)m * NSEL; const float* gwp = (const float*)(a.ws + WS_GW) + (size_t)m * NSEL;
        const int idA = ids[lane], idB = ids[64 + lane]; const float gA = gwp[lane], gB = gwp[64 + lane];
        const bf16_t* hrow = (const bf16_t*)(a.ws + WS_H2B) + (size_t)m * D;
        u32x4 hv[4];
#pragma unroll
        for (int j = 0; j < 4; ++j) hv[j] = *(const u32x4*)(hrow + j * 512 + lane * 8);
        float cf[4];
#pragma unroll
        for (int bt = 0; bt < 4; ++bt) {
            float mine = 0.f;
#pragma unroll 1
            for (int i0 = 0; i0 < 32; i0 += 4) {
                u32x4 uv[4][4];
#pragma unroll
                for (int i = 0; i < 4; ++i) {
                    const int id = __builtin_amdgcn_readlane(bt < 2 ? idA : idB, (bt & 1) * 32 + i0 + i);
                    const bf16_t* ur = PU + (size_t)id * D + lane * 8;
#pragma unroll
                    for (int j = 0; j < 4; ++j) uv[i][j] = *(const u32x4*)(ur + j * 512);
                }
#pragma unroll
                for (int i = 0; i < 4; ++i) {
                    float s = 0.f;
#pragma unroll
                    for (int j = 0; j < 4; ++j) s = dot8(hv[j], uv[i][j], s);
                    s = wave_sum(s);
                    mine = ((lane >> 1) == i0 + i) ? s : mine;
                }
            }
            const float g = __shfl(bt < 2 ? gA : gB, (bt & 1) * 32 + (lane >> 1));
            cf[bt] = geluf_(mine) * g;
        }
        float acc[4][8];
#pragma unroll
        for (int j = 0; j < 4; ++j)
#pragma unroll
            for (int k = 0; k < 8; ++k) acc[j][k] = 0.f;
#pragma unroll
        for (int bt = 0; bt < 4; ++bt) {
#pragma unroll 1
            for (int i0 = 0; i0 < 32; i0 += 4) {
                u32x4 vv[4][4]; float cs[4];
#pragma unroll
                for (int i = 0; i < 4; ++i) {
                    const int id = __builtin_amdgcn_readlane(bt < 2 ? idA : idB, (bt & 1) * 32 + i0 + i);
                    cs[i] = __uint_as_float((unsigned)__builtin_amdgcn_readlane((int)__float_as_uint(cf[bt]), 2 * (i0 + i)));
                    const bf16_t* vr = PV + (size_t)id * D + lane * 8;
#pragma unroll
                    for (int j = 0; j < 4; ++j) vv[i][j] = *(const u32x4*)(vr + j * 512);
                }
#pragma unroll
                for (int i = 0; i < 4; ++i)
#pragma unroll
                    for (int j = 0; j < 4; ++j) {
                        acc[j][0] += cs[i] * bflo(vv[i][j].x); acc[j][1] += cs[i] * bfhi(vv[i][j].x);
                        acc[j][2] += cs[i] * bflo(vv[i][j].y); acc[j][3] += cs[i] * bfhi(vv[i][j].y);
                        acc[j][4] += cs[i] * bflo(vv[i][j].z); acc[j][5] += cs[i] * bfhi(vv[i][j].z);
                        acc[j][6] += cs[i] * bflo(vv[i][j].w); acc[j][7] += cs[i] * bfhi(vv[i][j].w);
                    }
            }
        }
        float* orow = a.out + (size_t)m * D;
#pragma unroll
        for (int j = 0; j < 4; ++j) {
            const int col = j * 512 + lane * 8;
            const float* gp = mod + b * NMOD + 5 * D + col;
#pragma unroll
            for (int k4 = 0; k4 < 2; ++k4) {
                const f32x4 g2 = *(const f32x4*)(gp + 4 * k4);
                f32x4 xv = *(const f32x4*)(orow + col + 4 * k4);
#pragma unroll
                for (int k = 0; k < 4; ++k) xv[k] += g2[k] * acc[j][4 * k4 + k];
                *(f32x4*)(orow + col + 4 * k4) = xv;
            }
        }
    }
}

#if DBG
DI float naive_mod(const Args& a, int b, int n) {
    float s = a.b_ada[n];
    for (int k = 0; k < D; ++k) s += siluf_(a.c[b * D + k]) * a.w_ada[(size_t)k * NMOD + n];
    return s;
}
DI void check_p0(const Args& a) {
    unsigned* ctl = (unsigned*)(a.ws + WS_CTL);
    const int gt = blockIdx.x * NTHREADS + otid();
    const float* mod = (const float*)ctl + CW_MOD;
    if (gt < 256) { const int b = gt & 1, n = (gt * 97 + 13) % NMOD; const float ref = naive_mod(a, b, n); dbg_report(ctl, 0, relerr(mod[b * NMOD + n], ref, 0.02f)); }
    else if (gt < 1280) {
        const int i = gt - 256; const unsigned h = (unsigned)i * 2654435761u;
        {   const int n = h % NPROJ, k = (h >> 13) % D; const int nsrc = n < 3072 ? n : n + 8;
            dbg_report(ctl, 1, relerr(bf2f(((const bf16_t*)(a.ws + WS_WIN))[(size_t)n * D + k]), a.w_in[(size_t)k * INW + nsrc], 1e-3f) * 0.5f); }
        {   const int n = h % D, k = (h >> 12) % SW; dbg_report(ctl, 1, relerr(bf2f(((const bf16_t*)(a.ws + WS_WSSM))[(size_t)n * SW + k]), a.w_ssm_up[(size_t)k * D + n], 1e-3f) * 0.5f); }
        {   const int n = h % D, k = (h >> 12) % AW; dbg_report(ctl, 1, relerr(bf2f(((const bf16_t*)(a.ws + WS_WATTN))[(size_t)n * AW + k]), a.w_attn_up[(size_t)k * D + n], 1e-3f) * 0.5f); }
        {   const int n = h % D, k = (h >> 12) % D; dbg_report(ctl, 1, relerr(bf2f(((const bf16_t*)(a.ws + WS_WOUT))[(size_t)n * D + k]), a.w_out[(size_t)k * D + n], 1e-3f) * 0.5f);
            dbg_report(ctl, 1, relerr(bf2f(((const bf16_t*)(a.ws + WS_WPQ))[(size_t)n * D + k]), a.w_peer_q[(size_t)k * D + n], 1e-3f) * 0.5f); }
        {   const int n = h % SW, k = (h >> 12) % SW; dbg_report(ctl, 1, relerr(bf2f(((const bf16_t*)(a.ws + WS_WGLU))[(size_t)n * SW + k]), a.w_glu[(size_t)k * SW + n], 1e-3f) * 0.5f); }
        {   const size_t e = ((size_t)h * 8191u + i) % ((size_t)NEXP * D); dbg_report(ctl, 1, relerr(bf2f(((const bf16_t*)(a.ws + WS_PU))[e]), a.peer_u[e], 1e-4f) * 0.5f);
            dbg_report(ctl, 1, relerr(bf2f(((const bf16_t*)(a.ws + WS_PV))[e]), a.peer_v[e], 1e-3f) * 0.5f); }
        {   const size_t e = (size_t)h % (16 * 128 * 128); dbg_report(ctl, 1, relerr(bf2f(((const bf16_t*)(a.ws + WS_KEYS))[e]), a.sub_keys[e], 1e-3f) * 0.5f); }
    }
}
DI void check_p1(const Args& a) {
    unsigned* ctl = (unsigned*)(a.ws + WS_CTL);
    const int tid_ = otid(); const int lane = tid_ & 63, gw = blockIdx.x * NWAVES + (tid_ >> 6);
    if (gw >= 64) return;
    const int m = (int)(((unsigned)gw * 2654435761u) % T), b = m >> 14;
    const float* mod = (const float*)ctl + CW_MOD;
    const float* xr = a.x + (size_t)m * D;
    float ss = 0.f;
    for (int k = lane; k < D; k += 64) ss += xr[k] * xr[k];
    const float r = rsqrtf(wave_sum(ss) / D + RMS_EPS);
    float f[8] = {0, 0, 0, 0, 0, 0, 0, 0};
    const bf16_t* hb = (const bf16_t*)(a.ws + WS_HB) + (size_t)m * D;
    for (int k = lane; k < D; k += 64) {
        const float sc = mod[b * NMOD + 1 * D + k], shv = mod[b * NMOD + k];
        const float h = xr[k] * r * a.norm1_w[k] * (1.0f + sc) + shv;
        dbg_report(ctl, 2, relerr(bf2f(hb[k]), h, 0.05f));
        for (int j = 0; j < 8; ++j) f[j] += h * a.w_in[(size_t)k * INW + 3072 + j];
    }
    for (int j = 0; j < 8; ++j) {
        const float z = wave_sum(f[j]) + a.b_forget[j];
        const float ref = -log1pf(expf(-z));
        if (lane == 0) dbg_report(ctl, 3, relerr(((const float*)(a.ws + WS_LF))[(size_t)m * 8 + j], ref, 0.01f));
    }
}
DI void check_p2(const Args& a) {
    unsigned* ctl = (unsigned*)(a.ws + WS_CTL);
    const int gt = blockIdx.x * NTHREADS + otid();
    if (gt >= 4096) return;
    const unsigned h = (unsigned)gt * 2654435761u;
    const int m = (h >> 7) % T, n = (h % 977 + gt * 7) % NPROJ;
    const bf16_t* hb = (const bf16_t*)(a.ws + WS_HB) + (size_t)m * D; const bf16_t* w = (const bf16_t*)(a.ws + WS_WIN) + (size_t)n * D;
    float s = 0.f;
    for (int k = 0; k < D; ++k) s += bf2f(hb[k]) * bf2f(w[k]);
    float got;
    if (n < 3072) got = bf2f(((const bf16_t*)(a.ws + WS_QKV))[(size_t)m * 3072 + n]);
    else if (n < 3584) got = bf2f(((const bf16_t*)(a.ws + WS_U))[(size_t)m * 512 + n - 3072]);
    else { got = bf2f(((const bf16_t*)(a.ws + WS_GATES))[(size_t)m * 4096 + n - 3584]); s = sigmoidf_(s); }
    dbg_report(ctl, 4, relerr(got, s, 0.05f));
}

DI void check_p3(const Args& a) {
    unsigned* ctl = (unsigned*)(a.ws + WS_CTL);
    const int tid_ = otid(); const int lane = tid_ & 63, gw = blockIdx.x * NWAVES + (tid_ >> 6);
    if (gw >= 48) return;
    const unsigned hsh = (unsigned)(gw + 1) * 2654435761u;
    const int b = gw & 1, h = (gw >> 1) & 7, t = (gw < 16) ? (gw * 37) : (int)(hsh % SEQ);
    const bf16_t* qkv = (const bf16_t*)(a.ws + WS_QKV);
    const bf16_t* vt = (const bf16_t*)(a.ws + WS_VT) + (size_t)(b * AH + h) * HD * SEQ;
    const float* F = (const float*)(a.ws + WS_F) + (size_t)(b * AH + h) * SEQ;
    float* scr = (float*)(a.ws + WS_DBGS) + (size_t)gw * SEQ;
    const size_t mrow = (size_t)b * SEQ;
    const bf16_t* qp = qkv + (mrow + t) * 3072 + h * 128;
    float mx = -1e30f;
    for (int s = lane; s <= t; s += 64) {
        const bf16_t* kp = qkv + (mrow + s) * 3072 + 1024 + h * 128;
        float d = 0.f;
        for (int k = 0; k < HD; ++k) d += bf2f(qp[k]) * bf2f(kp[k]);
        d += F[t] - F[s];
        scr[s] = d; mx = fmaxf(mx, d);
    }
    for (int o = 1; o < 64; o <<= 1) mx = fmaxf(mx, __shfl_xor(mx, o));
    float l = 0.f;
    for (int s = lane; s <= t; s += 64) { const float p = exp2f(scr[s] - mx); scr[s] = p; l += p; }
    l = wave_sum(l);
    __builtin_amdgcn_fence(__ATOMIC_RELEASE, "agent"); __builtin_amdgcn_fence(__ATOMIC_ACQUIRE, "agent");
    const bf16_t* yo = (const bf16_t*)(a.ws + WS_YATT) + (mrow + t) * AW + h * 128;
    for (int dd = 0; dd < 2; ++dd) {
        const int d = lane + 64 * dd;
        float acc = 0.f;
        for (int s = 0; s <= t; ++s) {
            const int pos = (s & ~15) + 8 * ((s >> 2) & 1) + 4 * ((s >> 3) & 1) + (s & 3);
            acc += scr[s] * bf2f(vt[(size_t)d * SEQ + pos]);
        }
        dbg_report(ctl, 5, relerr(bf2f(yo[d]), acc / l, 0.5f));
    }
}


DI void check_p2b(const Args& a) {
    unsigned* ctl = (unsigned*)(a.ws + WS_CTL);
    const int tid_ = otid(); const int lane = tid_ & 63, gw = blockIdx.x * NWAVES + (tid_ >> 6);
    if (gw < 32) {
        const unsigned hsh = (unsigned)(gw + 3) * 2654435761u;
        const int m = 16384 + (hsh % 16384), h = (hsh >> 20) & 7, qk = gw & 1;
        const bf16_t* hb = (const bf16_t*)(a.ws + WS_HB) + (size_t)m * D;
        float raw[2], ss = 0.f;
        for (int dd = 0; dd < 2; ++dd) {
            const int d = lane + 64 * dd;
            const bf16_t* w = (const bf16_t*)(a.ws + WS_WIN) + (size_t)(qk * 1024 + h * 128 + d) * D;
            float s = 0.f;
            for (int k = 0; k < D; ++k) s += bf2f(hb[k]) * bf2f(w[k]);
            raw[dd] = s; ss += s * s;
        }
        ss = wave_sum(ss);
        const float r = rsqrtf(ss / HD + RMS_EPS);
        for (int dd = 0; dd < 2; ++dd) {
            const int d = lane + 64 * dd;
            const float ref = raw[dd] * r * (qk ? a.k_norm_w[d] : a.q_norm_w[d] * 0.08838834764831845f * LOG2E);
            dbg_report(ctl, 6, relerr(bf2f(((const bf16_t*)(a.ws + WS_QKV))[(size_t)m * 3072 + qk * 1024 + h * 128 + d]), ref, 0.05f));
        }
    } else if (gw < 48 && lane == 0) {
        const int bh = gw - 32, b = bh >> 3, h = bh & 7;
        const float* lf = (const float*)(a.ws + WS_LF); const float* F = (const float*)(a.ws + WS_F) + (size_t)bh * SEQ;
        double c = 0.0;
        for (int s = 0; s < 3000; ++s) { c += (double)lf[((size_t)b * SEQ + s) * 8 + h]; if (s % 499 == 0) dbg_report(ctl, 7, relerr(F[s], (float)(c * 1.4426950408889634), 0.01f)); }
    }
}


DI void check_p456(const Args& a, int which) {
    unsigned* ctl = (unsigned*)(a.ws + WS_CTL);
    const int gt = blockIdx.x * NTHREADS + otid();
    if (gt >= 2048) return;
    const unsigned h = (unsigned)(gt + 11) * 2654435761u;
    const int m = (h >> 7) % T;
    if (which == 0) {
        const int n = h % SW;
        const bf16_t* g = (const bf16_t*)(a.ws + WS_GY) + (size_t)m * SW; const bf16_t* w = (const bf16_t*)(a.ws + WS_WGLU) + (size_t)n * SW;
        float s = a.b_glu[n];
        for (int k = 0; k < SW; ++k) s += bf2f(g[k]) * bf2f(w[k]);
        dbg_report(ctl, 8, relerr(bf2f(((const bf16_t*)(a.ws + WS_YG))[(size_t)m * SW + n]), bf2f(g[n]) * sigmoidf_(s), 0.2f));
    } else if (which == 1) {
        const int n = h % D;
        const bf16_t* yg = (const bf16_t*)(a.ws + WS_YG) + (size_t)m * SW; const bf16_t* w1 = (const bf16_t*)(a.ws + WS_WSSM) + (size_t)n * SW;
        const bf16_t* ya = (const bf16_t*)(a.ws + WS_YATT) + (size_t)m * AW; const bf16_t* w2 = (const bf16_t*)(a.ws + WS_WATTN) + (size_t)n * AW;
        float s1 = 0.f, s2 = 0.f;
        for (int k = 0; k < SW; ++k) s1 += bf2f(yg[k]) * bf2f(w1[k]);
        for (int k = 0; k < AW; ++k) s2 += bf2f(ya[k]) * bf2f(w2[k]);
        const bf16_t* gt_ = (const bf16_t*)(a.ws + WS_GATES) + (size_t)m * 4096;
        const float ref = bf2f(gt_[n]) * s1 + bf2f(gt_[2048 + n]) * s2;
        dbg_report(ctl, 9, relerr(bf2f(((const bf16_t*)(a.ws + WS_MRG))[(size_t)m * D + n]), ref, 0.3f));
    } else {
        const int n = h % D, b = m >> 14;
        const bf16_t* mr = (const bf16_t*)(a.ws + WS_MRG) + (size_t)m * D; const bf16_t* w = (const bf16_t*)(a.ws + WS_WOUT) + (size_t)n * D;
        float s = 0.f;
        for (int k = 0; k < D; ++k) s += bf2f(mr[k]) * bf2f(w[k]);
        const float g1 = ((const float*)ctl + CW_MOD)[b * NMOD + 2 * D + n];
        dbg_report(ctl, 10, relerr(a.out[(size_t)m * D + n], a.x[(size_t)m * D + n] + g1 * s, 1.0f) * 10.f);
    }
}


DI void check_p8(const Args& a) {
    unsigned* ctl = (unsigned*)(a.ws + WS_CTL);
    const int gt = blockIdx.x * NTHREADS + otid();
    if (gt >= 2048) return;
    const unsigned h = (unsigned)(gt + 5) * 2654435761u;
    const int m = (h >> 7) % T, n = h % D;
    const bf16_t* hr = (const bf16_t*)(a.ws + WS_H2B) + (size_t)m * D; const bf16_t* w = (const bf16_t*)(a.ws + WS_WPQ) + (size_t)n * D;
    float s = 0.f;
    for (int k = 0; k < D; ++k) s += bf2f(hr[k]) * bf2f(w[k]);
    dbg_report(ctl, 11, relerr(bf2f(((const bf16_t*)(a.ws + WS_QP))[(size_t)m * D + n]), s, 0.3f));
}
DI void check_p9(const Args& a) {
    unsigned* ctl = (unsigned*)(a.ws + WS_CTL);
    const int tid_ = otid(); const int lane = tid_ & 63, gw = blockIdx.x * NWAVES + (tid_ >> 6);
    if (gw >= 64) return;
    const unsigned hsh = (unsigned)(gw + 7) * 2654435761u;
    const int m = (hsh >> 5) % T, h = gw & 7;
    const bf16_t* qp = (const bf16_t*)(a.ws + WS_QP) + (size_t)m * D + h * 256;
    const bf16_t* keys = (const bf16_t*)(a.ws + WS_KEYS) + (size_t)h * 2 * NKEYS * 128;
    float* scr = (float*)(a.ws + WS_DBGS) + (size_t)gw * 256;
    for (int r = lane; r < 256; r += 64) {
        const int p = r >> 7; float s = 0.f;
        for (int k = 0; k < 128; ++k) s += bf2f(qp[p * 128 + k]) * bf2f(keys[(size_t)r * 128 + k]);
        scr[r] = s;
    }
    __builtin_amdgcn_fence(__ATOMIC_RELEASE, "agent"); __builtin_amdgcn_fence(__ATOMIC_ACQUIRE, "agent");
    const int* ids = (const int*)(a.ws + WS_IDS) + (size_t)m * NSEL + h * 16; const float* gwp = (const float*)(a.ws + WS_GW) + (size_t)m * NSEL + h * 16;
    float tv[16]; int te[16]; unsigned long long takenlo[4] = {0, 0, 0, 0};
    for (int r = 0; r < 16; ++r) {
        float best = -1e30f; int be = -1;
        for (int c = 0; c < 256; ++c) { const int e = lane * 256 + c; if ((takenlo[c >> 6] >> (c & 63)) & 1ull) continue; const float v = scr[e >> 7] + scr[128 + (e & 127)]; if (v > best) { best = v; be = e; } }
        float wb = best; for (int o = 1; o < 64; o <<= 1) wb = fmaxf(wb, __shfl_xor(wb, o));
        const unsigned long long bal = __ballot(best == wb); const int wl = __ffsll((long long)bal) - 1;
        const int we = __shfl(be, wl);
        if (lane == wl) { const int c = we - lane * 256; takenlo[c >> 6] |= 1ull << (c & 63); }
        tv[r] = wb; te[r] = we;
    }
    float es = 0.f; for (int r = 0; r < 16; ++r) es += expf(tv[r] - tv[0]);
    float err = 0.f;
    for (int r = 0; r < 16; ++r) {
        bool found = false;
        for (int k = 0; k < 16; ++k) if (ids[k] == te[r]) { found = true; err += fabsf(gwp[k] - expf(tv[r] - tv[0]) / es); }
        if (!found) err += expf(tv[r] - tv[0]) / es;
    }
    if (lane == 0) dbg_report(ctl, 12, err);
}
DI void check_p10(const Args& a) {
    unsigned* ctl = (unsigned*)(a.ws + WS_CTL);
    const int tid_ = otid(); const int lane = tid_ & 63, gw = blockIdx.x * NWAVES + (tid_ >> 6);
    if (gw >= 32) return;
    const unsigned hsh = (unsigned)(gw + 17) * 2654435761u;
    const int m = (hsh >> 5) % T, b = m >> 14;
    const bf16_t* hrow = (const bf16_t*)(a.ws + WS_H2B) + (size_t)m * D;
    const int* ids = (const int*)(a.ws + WS_IDS) + (size_t)m * NSEL; const float* gwp = (const float*)(a.ws + WS_GW) + (size_t)m * NSEL;
    const bf16_t* PU = (const bf16_t*)(a.ws + WS_PU); const bf16_t* PV = (const bf16_t*)(a.ws + WS_PV);
    float* scr = (float*)(a.ws + WS_DBGS) + 65536 + (size_t)gw * 128;
    for (int e = 0; e < NSEL; ++e) {
        float s = 0.f;
        for (int k = lane; k < D; k += 64) s += bf2f(hrow[k]) * bf2f(PU[(size_t)ids[e] * D + k]);
        s = wave_sum(s);
        if (lane == 0) scr[e] = geluf_(s) * gwp[e];
    }
    __builtin_amdgcn_fence(__ATOMIC_RELEASE, "agent"); __builtin_amdgcn_fence(__ATOMIC_ACQUIRE, "agent");
    const float* mod = (const float*)ctl + CW_MOD;
    for (int c = 0; c < 8; ++c) {
        const int n = (hsh >> (c + 2)) % D;
        float pe = 0.f;
        for (int e = lane; e < NSEL; e += 64) pe += scr[e] * bf2f(PV[(size_t)ids[e] * D + n]);
        pe = wave_sum(pe);
        const bf16_t* mr = (const bf16_t*)(a.ws + WS_MRG) + (size_t)m * D; const bf16_t* w = (const bf16_t*)(a.ws + WS_WOUT) + (size_t)n * D;
        float s = 0.f;
        for (int k = lane; k < D; k += 64) s += bf2f(mr[k]) * bf2f(w[k]);
        s = wave_sum(s);
        const float g1 = mod[b * NMOD + 2 * D + n], g2 = mod[b * NMOD + 5 * D + n];
        const float ref = a.x[(size_t)m * D + n] + g1 * s + g2 * pe;
        if (lane == 0) dbg_report(ctl, 13, relerr(a.out[(size_t)m * D + n], ref, 1.0f) * 10.f);
    }
}

__constant__ float dbg_tol[16] = {1e-3f, 4e-3f, 1e-2f, 1e-3f, 2e-2f, 2e-2f, 2e-2f, 2e-2f, 2e-2f, 2e-2f, 2e-2f, 2e-2f, 1e-1f, 2e-2f, 2e-2f, 2e-2f};
#endif

__global__ void __launch_bounds__(NTHREADS, 2) mk_fwd(Args a) {
    extern __shared__ __attribute__((aligned(16))) unsigned char lds_raw[];
    LAS unsigned char* lds = (LAS unsigned char*)lds_raw;
    cg::grid_group grid = cg::this_grid();
    const int tid = otid(), G = gridDim.x, blk = blockIdx.x;
    unsigned char* ws = a.ws;
    unsigned* ctl = (unsigned*)(ws + WS_CTL);

    phase0(a, lds);
    grid.sync();
#if DBG
    check_p0(a);
    grid.sync();
#endif
    if (DBG_STOP > 1) row_pass<true>(a, lds, a.x, a.norm1_w, 0, 1, (bf16_t*)(ws + WS_HB));
    grid.sync();
#if DBG
    if (DBG_STOP > 1) check_p1(a);
    grid.sync();
#endif
    if (DBG_STOP > 2) {
        pg8::Gemm g{(const bf16_t*)(ws + WS_HB), (const bf16_t*)(ws + WS_WIN), T, NPROJ, D};
        pg8::StaticOrder S; S.init(T, NPROJ, G, blk);
        EpiProj E{(bf16_t*)(ws + WS_QKV), (bf16_t*)(ws + WS_U), (bf16_t*)(ws + WS_GATES)};
        pg8::gemm_phase<EpiProj, pg8::StaticOrder, G_ALIGN, G_SP2>(lds, g, S, E);
    }
    grid.sync();
#if DBG
    if (DBG_STOP > 2) check_p2(a);
    grid.sync();
#endif

    if (DBG_STOP > 3) phase2b(a, lds);
    grid.sync();
#if DBG
    if (DBG_STOP > 3) check_p2b(a);
    grid.sync();
#endif
    if (DBG_STOP > 4) phase3(a, lds);
    grid.sync();
#if DBG
    if (DBG_STOP > 4) check_p3(a);
    grid.sync();
#endif

    if (DBG_STOP > 5) {
        pg8::Gemm g{(const bf16_t*)(ws + WS_GY), (const bf16_t*)(ws + WS_WGLU), T, SW, SW};
        pg8::StaticOrder S; S.init(T, SW, G, blk);
        EpiGlu E{(const bf16_t*)(ws + WS_GY), a.b_glu, (bf16_t*)(ws + WS_YG)};
        pg8::gemm_phase<EpiGlu, pg8::StaticOrder, G_ALIGN, G_SP2>(lds, g, S, E);
    }
    grid.sync();
#if DBG
    if (DBG_STOP > 5) check_p456(a, 0);
    grid.sync();
#endif
    if (DBG_STOP > 6) {
        { pg8::Gemm g{(const bf16_t*)(ws + WS_YG), (const bf16_t*)(ws + WS_WSSM), T, D, SW};
          pg8::StaticOrder S; S.init(T, D, G, blk);
          EpiSsmUp E{(const bf16_t*)(ws + WS_GATES), (bf16_t*)(ws + WS_MRG)};
          pg8::gemm_phase<EpiSsmUp, pg8::StaticOrder, G_ALIGN, G_SP2>(lds, g, S, E); }
        { pg8::Gemm g{(const bf16_t*)(ws + WS_YATT), (const bf16_t*)(ws + WS_WATTN), T, D, AW};
          pg8::StaticOrder S; S.init(T, D, G, blk);
          EpiAttnUp E{(const bf16_t*)(ws + WS_GATES), (bf16_t*)(ws + WS_MRG)};
          pg8::gemm_phase<EpiAttnUp, pg8::StaticOrder, G_ALIGN, G_SP2>(lds, g, S, E); }
    }
    grid.sync();
#if DBG
    if (DBG_STOP > 6) check_p456(a, 1);
    grid.sync();
#endif
    if (DBG_STOP > 7) {
        pg8::Gemm g{(const bf16_t*)(ws + WS_MRG), (const bf16_t*)(ws + WS_WOUT), T, D, D};
        pg8::StaticOrder S; S.init(T, D, G, blk);
        EpiOut E{a.x, (const float*)ctl + CW_MOD, a.b_ada, a.out};
        pg8::gemm_phase<EpiOut, pg8::StaticOrder, G_ALIGN, G_SP2>(lds, g, S, E);
    }
    grid.sync();
#if DBG
    if (DBG_STOP > 7) check_p456(a, 2);
    grid.sync();
#endif

    if (DBG_STOP > 8) row_pass<false>(a, lds, a.out, a.norm2_w, 3, 4, (bf16_t*)(ws + WS_H2B));
    grid.sync();
    if (DBG_STOP > 9) {
        pg8::Gemm g{(const bf16_t*)(ws + WS_H2B), (const bf16_t*)(ws + WS_WPQ), T, D, D};
        pg8::StaticOrder S; S.init(T, D, G, blk);
        EpiPlain E{(bf16_t*)(ws + WS_QP), D};
        pg8::gemm_phase<EpiPlain, pg8::StaticOrder, G_ALIGN, G_SP2>(lds, g, S, E);
    }
    grid.sync();
#if DBG
    if (DBG_STOP > 9) check_p8(a);
    grid.sync();
#endif
    if (DBG_STOP > 10) phase9(a, lds);
    grid.sync();
#if DBG
    if (DBG_STOP > 10) check_p9(a);
    grid.sync();
#endif
    if (DBG_STOP > 11) phase10(a);
#if DBG
    grid.sync();
    if (DBG_STOP > 11) check_p10(a);
#endif

    if (DBG_STOP <= 7) {
        const f32x4* x4 = (const f32x4*)a.x; f32x4* o4 = (f32x4*)a.out;
        const size_t n4 = (size_t)T * D / 4;
        for (size_t i = (size_t)blk * NTHREADS + tid; i < n4; i += (size_t)G * NTHREADS) o4[i] = x4[i];
    }
#if DBG
    grid.sync();
    {
        int code = 0;
        for (int i = 15; i >= 0; --i) { const float e = __uint_as_float(__hip_atomic_load(ctl + CW_DBG + i, __ATOMIC_RELAXED, __HIP_MEMORY_SCOPE_AGENT));
            if (e > dbg_tol[i]) { if (i >= DBG_LO && i < DBG_LO + 4) code |= 1 << (i - DBG_LO); else if (i < DBG_LO) code = 20 + i; } }
#ifdef DBG_MAG
        { const float e = __uint_as_float(__hip_atomic_load(ctl + CW_DBG + DBG_MAG, __ATOMIC_RELAXED, __HIP_MEMORY_SCOPE_AGENT)); code = 1; (void)e; }
#endif
        if (code) {
#ifdef DBG_MAG
            const float s = 1.0f + fminf(__uint_as_float(__hip_atomic_load(ctl + CW_DBG + DBG_MAG, __ATOMIC_RELAXED, __HIP_MEMORY_SCOPE_AGENT)), 1000.f);
#else
            const float s = 1.0f + (float)code;
#endif
            f32x4* o4 = (f32x4*)a.out; const size_t n4 = (size_t)T * D / 4;
            for (size_t i = (size_t)blk * NTHREADS + tid; i < n4; i += (size_t)G * NTHREADS) o4[i] = o4[i] * s;
        }
    }
#endif
}

extern "C" void kernel_launch(void* const* d_in, const int* in_sizes, int n_in, void* d_out, int out_size,
                              void* d_ws, size_t ws_size, hipStream_t stream) {
    static int grid = 0;
    if (grid == 0) {
        int dev = 0, cus = 0, per_cu = 0;
        (void)hipGetDevice(&dev);
        (void)hipDeviceGetAttribute(&cus, hipDeviceAttributeMultiprocessorCount, dev);
        (void)hipFuncSetAttribute((const void*)mk_fwd, hipFuncAttributeMaxDynamicSharedMemorySize, LDS_BYTES);
        (void)hipOccupancyMaxActiveBlocksPerMultiprocessor(&per_cu, (const void*)mk_fwd, NTHREADS, LDS_BYTES);
        if (per_cu < 1) per_cu = 1;
        grid = cus * per_cu;
        if (n_in != 27 || ws_size < WS_END) { fprintf(stderr, "kernel_launch: unexpected n_in %d / ws_size %zu\n", n_in, ws_size); }
    }
    (void)hipMemsetAsync((char*)d_ws + WS_CTL, 0, CTL_ZERO_BYTES, stream);
    Args a{};
    const float** ap = (const float**)&a;
    for (int i = 0; i < 27; ++i) ap[i] = (const float*)d_in[i];
    a.out = (float*)d_out; a.ws = (unsigned char*)d_ws;
    void* args[] = {&a};
    hipError_t e = hipLaunchCooperativeKernel((const void*)mk_fwd, dim3(grid), dim3(NTHREADS), args, LDS_BYTES, stream);
    if (e != hipSuccess) fprintf(stderr, "cooperative launch failed: %s (grid %d)\n", hipGetErrorString(e), grid);
}
```

```cpp
#include <hip/hip_runtime.h>
#include <hip/hip_cooperative_groups.h>
#include <cstdio>
#include <cstdint>
namespace cg = cooperative_groups;

#ifndef DBG
#define DBG 0
#endif
#ifndef PROBE
#define PROBE 0
#endif
#ifndef DBG_LO
#define DBG_LO 10
#endif
#ifndef DBG_STOP
#define DBG_STOP 99
#endif

#define DI __device__ __forceinline__
#define GAS __attribute__((address_space(1)))
#define LAS __attribute__((address_space(3)))
typedef unsigned short bf16_t;
typedef short bf16x8 __attribute__((ext_vector_type(8)));
typedef float f32x4 __attribute__((ext_vector_type(4)));
typedef float f32x16 __attribute__((ext_vector_type(16)));
typedef unsigned u32x4 __attribute__((ext_vector_type(4)));
typedef unsigned u32x2 __attribute__((ext_vector_type(2)));
typedef __bf16 bf16x2_t __attribute__((ext_vector_type(2)));

constexpr int NTHREADS = 512, NWAVES = 8;
constexpr int LDS_BYTES = 147456;
constexpr int NB = 2, SEQ = 16384, T = NB * SEQ, D = 2048;
constexpr int AH = 8, HD = 128, AW = 1024;
constexpr int SW = 512, SGRP = 32, SCH = 16, SST = 64;
constexpr int INW = 7688, NPROJ = 7680;
constexpr int NMOD = 6 * D;
constexpr int PH = 8, NKEYS = 128, NEXP = 16384, TOPK = 16, NSEL = PH * TOPK;
constexpr float RMS_EPS = 1e-6f;
constexpr float LOG2E = 1.4426950408889634f;

constexpr size_t MiB = 1u << 20;
constexpr size_t WS_CTL = 0, CTL_ZERO_BYTES = 1 * MiB;
constexpr size_t WS_LF = 1 * MiB;
constexpr size_t WS_F = 2 * MiB;
constexpr size_t WS_WF = 3 * MiB;
constexpr size_t WS_KEYS = 3 * MiB + 512 * 1024;
constexpr size_t WS_WGLU = 4 * MiB, WS_WSSM = 5 * MiB, WS_WATTN = 7 * MiB, WS_WOUT = 11 * MiB, WS_WPQ = 19 * MiB, WS_WIN = 27 * MiB;
constexpr size_t WS_S5TAB = 57 * MiB;
constexpr size_t WS_PU = 64 * MiB, WS_PV = 88 * MiB;
constexpr size_t WS_HB = 192 * MiB;
constexpr size_t WS_QKV = 320 * MiB;
constexpr size_t WS_U = 512 * MiB;
constexpr size_t WS_YATT = 544 * MiB;
constexpr size_t WS_GY = 608 * MiB;
constexpr size_t WS_YG = 640 * MiB;
constexpr size_t WS_GATES = 672 * MiB;
constexpr size_t WS_END = 1024 * MiB;
constexpr int CW_DBG = 64;
constexpr int CW_QUEUE = 256;
constexpr int CW_SEGT = 1024;
constexpr int CW_MOD = 819200;

struct Args {
    const float *x, *c, *w_ada, *b_ada, *norm1_w, *w_in, *b_forget, *q_norm_w, *k_norm_w;
    const float *A_re, *A_im, *log_dt, *B_re, *B_im, *C_re, *C_im, *Dskip;
    const float *w_glu, *b_glu, *w_ssm_up, *w_attn_up, *w_out, *norm2_w, *w_peer_q, *sub_keys, *peer_u, *peer_v;
    float* out; unsigned char* ws;
};

DI unsigned pk2(float lo, float hi) { bf16x2_t v; v.x = (__bf16)lo; v.y = (__bf16)hi; return __builtin_bit_cast(unsigned, v); }
DI float bf2f(unsigned h) { return __uint_as_float(h << 16); }
DI float bflo(unsigned w) { return __uint_as_float(w << 16); }
DI float bfhi(unsigned w) { return __uint_as_float(w & 0xffff0000u); }
DI float sigmoidf_(float z) { return __builtin_amdgcn_rcpf(1.0f + __expf(-z)); }
DI float siluf_(float z) { return z / (1.0f + __expf(-z)); }
DI float geluf_(float z) { return 0.5f * z * (1.0f + erff(z * 0.70710678118654752f)); }
DI float wave_sum(float v) {
#pragma unroll
    for (int o = 1; o < 64; o <<= 1) v += __shfl_xor(v, o);
    return v;
}
DI int otid() { int t = threadIdx.x; asm volatile("" : "+v"(t)); return t; }
#define LDS_WAIT() asm volatile("s_waitcnt lgkmcnt(0)" ::: "memory")
DI void dbg_report(unsigned* ctl, int id, float err) {
    if (!(err == err)) err = 1e30f;
    atomicMax(ctl + CW_DBG + id, __float_as_uint(fabsf(err)));
}
DI float relerr(float got, float ref, float floor_) { return fabsf(got - ref) / (fabsf(ref) + floor_); }

namespace pg8 {
constexpr int BM = 256, BK = 64, HALF = 128, HTB = HALF * BK * 2, NXCD = 8, WGM = 8;
DI int lds_byte(int r, int c) { const int st = (r >> 4) * 2 + (c >> 5), rr = r & 15, cc = c & 31, ob = rr * 64 + cc * 2; return st * 1024 + (ob ^ (((ob >> 9) & 1) << 5)); }
DI void stage_rc(int b, int& R, int& C) { const int st = b / 1024, sb = b % 1024, swz = sb ^ (((sb >> 9) & 1) << 5); R = (st >> 1) * 16 + swz / 64; C = (st & 1) * 32 + (swz % 64) / 2; }
DI int perm32(int rho) { const int n = rho >> 4, i = rho & 15; return 8 * (i >> 2) + 4 * n + (i & 3); }
struct Unit { int pm, pn; };
struct Gemm { const bf16_t* A; const bf16_t* Bt; int M, N, K; };
struct StaticOrder {
    int nM, nN, nwg, G, c;
    DI void init(int M, int N, int G_, int c_) { nM = M / BM; nN = N / BM; nwg = nM * nN; G = G_; c = c_; }
    DI bool next(int i, Unit& u) const {
        const long L = (long)i * G + c; if (L >= nwg) return false;
        int wgid = (int)L; { const int q = nwg / NXCD, r = nwg % NXCD, xcd = wgid % NXCD, off = wgid / NXCD; wgid = (xcd < r ? xcd * (q + 1) : r * (q + 1) + (xcd - r) * q) + off; }
        const int nig = WGM * nN, gid = wgid / nig, fm = gid * WGM, gsz = (nM - fm) < WGM ? (nM - fm) : WGM;
        u.pm = fm + ((wgid % nig) % gsz); u.pn = (wgid % nig) / gsz; return true;
    }
    DI void a_ready(const Unit&) const {}
    DI void done(const Unit&) const {}
};
template <class Epi, class Sched, bool ALIGN_EPI = false, bool SP2 = false>
DI void gemm_phase(LAS unsigned char* lds, const Gemm g, const Sched& S, const Epi& E) {
    int tid = threadIdx.x; asm volatile("" : "+v"(tid));
    const int wid = __builtin_amdgcn_readfirstlane(tid >> 6), lane = tid & 63, wr = wid >> 2, wc = wid & 3, fr = lane & 15, fq = lane >> 4;
    const int K = g.K, nt = K / BK;
    unsigned voffA[2], voffB[2];
#pragma unroll
    for (int i = 0; i < 2; ++i) { int R, C; stage_rc(tid * 16 + i * 8192, R, C); const int Rb = Epi::PERM ? ((R & ~31) + perm32(R & 31)) : R;
        voffA[i] = (unsigned)(R * K + C) * 2u; voffB[i] = (unsigned)(Rb * K + C) * 2u; }
    const size_t kstep = (size_t)(BK * 2);
    const size_t hstep = (size_t)HALF * K * 2;
    const size_t tstep = 2 * hstep;
    const unsigned ldsw = (unsigned)wid * 1024u;
    const int aoff = lds_byte(wr * 64 + fr, fq * 8), boff = lds_byte(wc * 32 + fr, fq * 8);
#define PG8_SA(b, h) (((b) * 2 + (h)) * HTB)
#define PG8_SB(b, h) ((4 + (b) * 2 + (h)) * HTB)
#define PG8_STAGE(bufoff, gbase, voff) do { _Pragma("unroll") for (int _i = 0; _i < 2; ++_i) \
        __builtin_amdgcn_global_load_lds((const unsigned*)((const char*)(gbase) + (voff)[_i]), (LAS unsigned*)(lds + (bufoff) + ldsw + _i * 8192), 16, 0, 0); } while (0)
#define PG8_LDA(dst, b, h) do { _Pragma("unroll") for (int m = 0; m < 4; ++m) _Pragma("unroll") for (int k = 0; k < 2; ++k) dst[m][k] = *(const LAS bf16x8*)(lds + PG8_SA(b, h) + aoff + m * 2048 + k * 1024); } while (0)
#define PG8_LDB(dst, b, h) do { _Pragma("unroll") for (int n = 0; n < 2; ++n) _Pragma("unroll") for (int k = 0; k < 2; ++k) dst[n][k] = *(const LAS bf16x8*)(lds + PG8_SB(b, h) + boff + n * 2048 + k * 1024); } while (0)
#define PG8_MMA(ai, bj, At, Bt) do { __builtin_amdgcn_s_setprio(1); _Pragma("unroll") for (int m = 0; m < 4; ++m) _Pragma("unroll") for (int n = 0; n < 2; ++n) _Pragma("unroll") for (int k = 0; k < 2; ++k) \
        acc[ai][bj][m][n] = __builtin_amdgcn_mfma_f32_16x16x32_bf16(Bt[n][k], At[m][k], acc[ai][bj][m][n], 0, 0, 0); __builtin_amdgcn_s_setprio(0); } while (0)
#define PG8_WAIT_V(n) asm volatile("s_waitcnt vmcnt(" #n ")" ::: "memory")
#define PG8_WAIT_L(n) asm volatile("s_waitcnt lgkmcnt(" #n ")" ::: "memory")
#define PG8_BAR __builtin_amdgcn_s_barrier()
#define PG8_SCHED __builtin_amdgcn_sched_barrier(0)
    Unit cur, nxt; int ui = 0;
    if (!S.next(0, cur)) return;
    f32x4 acc[2][2][4][2];
#pragma unroll
    for (int a = 0; a < 2; ++a)
#pragma unroll
        for (int b = 0; b < 2; ++b)
#pragma unroll
            for (int m = 0; m < 4; ++m)
#pragma unroll
                for (int n = 0; n < 2; ++n) acc[a][b][m][n] = (f32x4){0.f, 0.f, 0.f, 0.f};
    bf16x8 At[4][2], B0[2][2], B1[2][2];
    const char* cA = (const char*)g.A + (size_t)cur.pm * tstep; const char* cB = (const char*)g.Bt + (size_t)cur.pn * tstep;
    S.a_ready(cur);
    if constexpr (SP2) {
        PG8_STAGE(PG8_SB(0, 0), cB, voffB); PG8_STAGE(PG8_SB(0, 1), cB + hstep, voffB); PG8_STAGE(PG8_SA(0, 0), cA, voffA); PG8_STAGE(PG8_SA(0, 1), cA + hstep, voffA);
        if (wr == 1) PG8_BAR;
        PG8_WAIT_V(2); PG8_BAR;
        PG8_STAGE(PG8_SB(1, 0), cB + kstep, voffB); PG8_STAGE(PG8_SA(1, 0), cA + kstep, voffA); PG8_STAGE(PG8_SB(1, 1), cB + hstep + kstep, voffB);
        PG8_WAIT_V(6); PG8_BAR;
    } else {
        PG8_STAGE(PG8_SB(0, 0), cB, voffB); PG8_STAGE(PG8_SA(0, 0), cA, voffA); PG8_STAGE(PG8_SB(0, 1), cB + hstep, voffB); PG8_STAGE(PG8_SA(0, 1), cA + hstep, voffA);
        if (wr == 1) PG8_BAR;
        PG8_WAIT_V(4); PG8_BAR;
        PG8_STAGE(PG8_SB(1, 0), cB + kstep, voffB); PG8_STAGE(PG8_SA(1, 0), cA + kstep, voffA); PG8_STAGE(PG8_SB(1, 1), cB + hstep + kstep, voffB);
        PG8_WAIT_V(6); PG8_BAR;
    }
    for (;;) {
        const bool has_next = S.next(ui + 1, nxt);
        const char* nA = has_next ? (const char*)g.A + (size_t)nxt.pm * tstep : cA; const char* nB = has_next ? (const char*)g.Bt + (size_t)nxt.pn * tstep : cB;
        for (int t = 0; t < nt; t += 2) {
            const bool last = (t == nt - 2);
            const char* a1 = cA + (size_t)(t + 1) * kstep;
            const char* a2 = last ? nA : cA + (size_t)(t + 2) * kstep; const char* b2 = last ? nB : cB + (size_t)(t + 2) * kstep;
            const char* a3 = a2 + kstep; const char* b3 = b2 + kstep;
            if (last && has_next) S.a_ready(nxt);
            if constexpr (SP2) {
            PG8_LDB(B0, 0, 0); PG8_LDB(B1, 0, 1); PG8_SCHED; PG8_LDA(At, 0, 0); PG8_STAGE(PG8_SA(1, 1), a1 + hstep, voffA);
            PG8_WAIT_V(8); PG8_WAIT_L(0); PG8_BAR; PG8_MMA(0, 0, At, B0); PG8_MMA(0, 1, At, B1); PG8_BAR; PG8_SCHED;
            PG8_LDA(At, 0, 1); PG8_STAGE(PG8_SB(0, 0), b2, voffB); PG8_STAGE(PG8_SB(0, 1), b2 + hstep, voffB); PG8_STAGE(PG8_SA(0, 0), a2, voffA);
            PG8_WAIT_V(8); PG8_WAIT_L(0); PG8_BAR; PG8_MMA(1, 0, At, B0); PG8_MMA(1, 1, At, B1); PG8_BAR; PG8_SCHED;
            PG8_LDB(B0, 1, 0); PG8_LDB(B1, 1, 1); PG8_SCHED; PG8_LDA(At, 1, 0); PG8_STAGE(PG8_SA(0, 1), a2 + hstep, voffA);
            PG8_WAIT_V(8); PG8_WAIT_L(0); PG8_BAR; PG8_MMA(0, 0, At, B0); PG8_MMA(0, 1, At, B1); PG8_BAR; PG8_SCHED;
            PG8_LDA(At, 1, 1); PG8_STAGE(PG8_SB(1, 0), b3, voffB); PG8_STAGE(PG8_SB(1, 1), b3 + hstep, voffB); PG8_STAGE(PG8_SA(1, 0), a3, voffA);
            PG8_WAIT_V(8); PG8_WAIT_L(0); PG8_BAR; PG8_MMA(1, 0, At, B0); PG8_MMA(1, 1, At, B1); PG8_BAR; PG8_SCHED;
            } else {
            PG8_LDB(B0, 0, 0); PG8_SCHED; PG8_LDA(At, 0, 0); PG8_STAGE(PG8_SA(1, 1), a1 + hstep, voffA);
            PG8_WAIT_L(8); PG8_BAR; PG8_WAIT_L(0); PG8_MMA(0, 0, At, B0); PG8_BAR; PG8_SCHED;
            PG8_LDB(B1, 0, 1); PG8_STAGE(PG8_SB(0, 0), b2, voffB);
            PG8_BAR; PG8_WAIT_L(0); PG8_MMA(0, 1, At, B1); PG8_BAR;
            PG8_LDA(At, 0, 1); PG8_STAGE(PG8_SA(0, 0), a2, voffA);
            PG8_BAR; PG8_WAIT_L(0); PG8_MMA(1, 0, At, B0); PG8_BAR; PG8_SCHED;
            PG8_STAGE(PG8_SB(0, 1), b2 + hstep, voffB);
            PG8_WAIT_V(6); PG8_BAR; PG8_MMA(1, 1, At, B1); PG8_BAR;
            PG8_LDB(B0, 1, 0); PG8_SCHED; PG8_LDA(At, 1, 0); PG8_STAGE(PG8_SA(0, 1), a2 + hstep, voffA);
            PG8_WAIT_L(8); PG8_BAR; PG8_WAIT_L(0); PG8_MMA(0, 0, At, B0); PG8_BAR; PG8_SCHED;
            PG8_LDB(B1, 1, 1); PG8_STAGE(PG8_SB(1, 0), b3, voffB);
            PG8_BAR; PG8_WAIT_L(0); PG8_MMA(0, 1, At, B1); PG8_BAR;
            PG8_LDA(At, 1, 1); PG8_STAGE(PG8_SA(1, 0), a3, voffA);
            PG8_BAR; PG8_WAIT_L(0); PG8_MMA(1, 0, At, B0); PG8_BAR; PG8_SCHED;
            PG8_STAGE(PG8_SB(1, 1), b3 + hstep, voffB);
            PG8_WAIT_V(6); PG8_BAR; PG8_MMA(1, 1, At, B1); PG8_BAR;
            }
        }
        if constexpr (ALIGN_EPI) { if (wr == 0) PG8_BAR; }
        E(acc, cur, wr, wc, fr, fq); S.done(cur);
        if (!has_next) break;
#pragma unroll
        for (int a = 0; a < 2; ++a)
#pragma unroll
            for (int b = 0; b < 2; ++b)
#pragma unroll
                for (int m = 0; m < 4; ++m)
#pragma unroll
                    for (int n = 0; n < 2; ++n) acc[a][b][m][n] = (f32x4){0.f, 0.f, 0.f, 0.f};
        cur = nxt; cA = nA; cB = nB; ++ui;
        if constexpr (ALIGN_EPI) { if (wr == 1) PG8_BAR; }
    }
    PG8_WAIT_V(0);
    if constexpr (!ALIGN_EPI) { if (wr == 0) PG8_BAR; }
    PG8_BAR;
#undef PG8_SA
#undef PG8_SB
#undef PG8_STAGE
#undef PG8_LDA
#undef PG8_LDB
#undef PG8_MMA
#undef PG8_WAIT_V
#undef PG8_WAIT_L
#undef PG8_BAR
#undef PG8_SCHED
}
}
constexpr bool G_ALIGN = true, G_SP2 = true;

template <class F>
DI void epi_foreach(const f32x4 (&acc)[2][2][4][2], const pg8::Unit& u, int wr, int wc, int fr, int fq, const F& f) {
#pragma unroll
    for (int ai = 0; ai < 2; ++ai)
#pragma unroll
        for (int m = 0; m < 4; ++m) {
            const int row = u.pm * 256 + ai * 128 + wr * 64 + m * 16 + fr;
#pragma unroll
            for (int bj = 0; bj < 2; ++bj) {
                const int col0 = u.pn * 256 + bj * 128 + wc * 32 + 8 * fq;
                float v[8];
#pragma unroll
                for (int k = 0; k < 4; ++k) { v[k] = acc[ai][bj][m][0][k]; v[4 + k] = acc[ai][bj][m][1][k]; }
                f(row, col0, v);
            }
        }
}
DI void store8_bf16(bf16_t* p, const float (&v)[8]) {
    u32x4 w; w.x = pk2(v[0], v[1]); w.y = pk2(v[2], v[3]); w.z = pk2(v[4], v[5]); w.w = pk2(v[6], v[7]);
    *(u32x4*)p = w;
}
DI void load8_bf16(const bf16_t* p, float (&v)[8]) {
    const u32x4 w = *(const u32x4*)p;
    v[0] = bflo(w.x); v[1] = bfhi(w.x); v[2] = bflo(w.y); v[3] = bfhi(w.y); v[4] = bflo(w.z); v[5] = bfhi(w.z); v[6] = bflo(w.w); v[7] = bfhi(w.w);
}
DI void load8_u8gate(const unsigned char* p, float (&g)[8]) {
    const u32x2 w = *(const u32x2*)p;
#pragma unroll
    for (int k = 0; k < 4; ++k) { g[k] = (float)((w.x >> (8 * k)) & 0xffu) * (1.0f / 255.0f); g[4 + k] = (float)((w.y >> (8 * k)) & 0xffu) * (1.0f / 255.0f); }
}
struct EpiProj {
    static constexpr bool PERM = true;
    bf16_t *qkv, *u; unsigned char* gates;
    DI void operator()(const f32x4 (&acc)[2][2][4][2], const pg8::Unit& un, int wr, int wc, int fr, int fq) const {
        const int pn = un.pn;
        if (pn < 12) { bf16_t* o = qkv; epi_foreach(acc, un, wr, wc, fr, fq, [&](int row, int col0, float (&v)[8]) { store8_bf16(o + (size_t)row * 3072 + col0, v); }); }
        else if (pn < 14) { bf16_t* o = u; epi_foreach(acc, un, wr, wc, fr, fq, [&](int row, int col0, float (&v)[8]) { store8_bf16(o + (size_t)row * 512 + (col0 - 3072), v); }); }
        else { unsigned char* o = gates; epi_foreach(acc, un, wr, wc, fr, fq, [&](int row, int col0, float (&v)[8]) {
                unsigned w0 = 0u, w1 = 0u;
#pragma unroll
                for (int k = 0; k < 4; ++k) { w0 |= (unsigned)(sigmoidf_(v[k]) * 255.0f + 0.5f) << (8 * k); w1 |= (unsigned)(sigmoidf_(v[4 + k]) * 255.0f + 0.5f) << (8 * k); }
                *(u32x2*)(o + (size_t)row * 4096 + (col0 - 3584)) = (u32x2){w0, w1}; }); }
    }
};


constexpr size_t WS_MRG = WS_HB;
constexpr size_t WS_X1B0 = 448 * MiB, WS_X1B1 = 928 * MiB;
DI bf16_t* x1b_row(unsigned char* ws, int m) { return (bf16_t*)(ws + ((m >> 14) ? WS_X1B1 : WS_X1B0)) + (size_t)(m & 16383) * D; }
struct EpiGlu {
    static constexpr bool PERM = true;
    const bf16_t* gy; const float* bglu; bf16_t* yg;
    DI void operator()(const f32x4 (&acc)[2][2][4][2], const pg8::Unit& un, int wr, int wc, int fr, int fq) const {
        epi_foreach(acc, un, wr, wc, fr, fq, [&](int row, int col0, float (&v)[8]) {
            float g[8]; load8_bf16(gy + (size_t)row * SW + col0, g);
#pragma unroll
            for (int k = 0; k < 8; ++k) v[k] = g[k] * sigmoidf_(v[k] + bglu[col0 + k]);
            store8_bf16(yg + (size_t)row * SW + col0, v); });
    }
};
struct EpiSsmUp {
    static constexpr bool PERM = true;
    const unsigned char* gates; bf16_t* mrg;
    DI void operator()(const f32x4 (&acc)[2][2][4][2], const pg8::Unit& un, int wr, int wc, int fr, int fq) const {
        epi_foreach(acc, un, wr, wc, fr, fq, [&](int row, int col0, float (&v)[8]) {
            float g[8]; load8_u8gate(gates + (size_t)row * 4096 + col0, g);
#pragma unroll
            for (int k = 0; k < 8; ++k) v[k] *= g[k];
            store8_bf16(mrg + (size_t)row * D + col0, v); });
    }
};
struct EpiAttnUp {
    static constexpr bool PERM = true;
    const unsigned char* gates; bf16_t* mrg;
    DI void operator()(const f32x4 (&acc)[2][2][4][2], const pg8::Unit& un, int wr, int wc, int fr, int fq) const {
        epi_foreach(acc, un, wr, wc, fr, fq, [&](int row, int col0, float (&v)[8]) {
            float g[8], o[8]; load8_u8gate(gates + (size_t)row * 4096 + 2048 + col0, g); load8_bf16(mrg + (size_t)row * D + col0, o);
#pragma unroll
            for (int k = 0; k < 8; ++k) v[k] = v[k] * g[k] + o[k];
            store8_bf16(mrg + (size_t)row * D + col0, v); });
    }
};
struct EpiOut {
    static constexpr bool PERM = true;
    const float* x; const float* mod; const float* bada; unsigned char* ws;
    DI void operator()(const f32x4 (&acc)[2][2][4][2], const pg8::Unit& un, int wr, int wc, int fr, int fq) const {
        epi_foreach(acc, un, wr, wc, fr, fq, [&](int row, int col0, float (&v)[8]) {
            const int b = row >> 14;
            const float* gp = mod + b * NMOD + 2 * D + col0;
            const f32x4 g0 = *(const f32x4*)gp, g1 = *(const f32x4*)(gp + 4);
            const f32x4 x0 = *(const f32x4*)(x + (size_t)row * D + col0), x1 = *(const f32x4*)(x + (size_t)row * D + col0 + 4);
            f32x4 r0, r1;
#pragma unroll
            for (int k = 0; k < 4; ++k) { r0[k] = x0[k] + g0[k] * v[k]; r1[k] = x1[k] + g1[k] * v[4 + k]; }
            *(u32x4*)(x1b_row(ws, row) + col0) = (u32x4){pk2(r0[0], r0[1]), pk2(r0[2], r0[3]), pk2(r1[0], r1[1]), pk2(r1[2], r1[3])}; });
    }
};


constexpr size_t WS_PUS = 112 * MiB, WS_PVS = 112 * MiB + 512 * 1024;
constexpr int ROWB = 1536;
typedef float f32x2 __attribute__((ext_vector_type(2)));
typedef float v16f __attribute__((ext_vector_type(16)));
typedef float v32f __attribute__((ext_vector_type(32)));
typedef unsigned v6u __attribute__((ext_vector_type(6)));
typedef unsigned v16u __attribute__((ext_vector_type(16)));
typedef __bf16 v32bf __attribute__((ext_vector_type(32)));
DI v32f fp6_unpack_f32(const v6u w) { v32f r; asm volatile("s_nop 1\n\tv_cvt_scalef32_pk32_f32_fp6 %0, %1, 1.0\n\ts_nop 15" : "=&v"(r) : "v"(w)); return r; }
DI v16u fp6_unpack_bf16(const v6u w) { v16u r; asm volatile("s_nop 1\n\tv_cvt_scalef32_pk32_bf16_fp6 %0, %1, 1.0\n\ts_nop 15" : "=&v"(r) : "v"(w)); return r; }

DI unsigned fp6_code(float x) {
    const float a = fminf(fabsf(x), 7.5f);
    const float c = a < 2.0f ? a * 8.0f : (a < 4.0f ? 8.0f + a * 4.0f : 16.0f + a * 2.0f);
    const unsigned q = (unsigned)__builtin_rintf(c);
    return q | ((__float_as_uint(x) >> 31) << 5);
}
DI v6u fp6_pack_sw(const float (&e)[32]) {
    unsigned long long lo = 0, mid = 0, hi = 0;
#pragma unroll
    for (int i = 0; i < 32; ++i) {
        const unsigned long long c = fp6_code(e[i]);
        const int bit = 6 * i;
        if (bit < 64) { lo |= c << bit; if (bit > 58) mid |= c >> (64 - bit); }
        else if (bit < 128) { mid |= c << (bit - 64); if (bit > 122) hi |= c >> (128 - bit); }
        else hi |= c << (bit - 128);
    }
    v6u w; w[0] = (unsigned)lo; w[1] = (unsigned)(lo >> 32); w[2] = (unsigned)mid; w[3] = (unsigned)(mid >> 32); w[4] = (unsigned)hi; w[5] = (unsigned)(hi >> 32);
    return w;
}
DI void fp6_row_convert(const float* src, unsigned char* dst, float* inv_scale, int lane) {
    f32x4 v[8]; float mx = 0.f;
#pragma unroll
    for (int q = 0; q < 8; ++q) { v[q] = *(const f32x4*)(src + 32 * lane + 4 * q);
        mx = fmaxf(mx, fmaxf(fmaxf(fabsf(v[q].x), fabsf(v[q].y)), fmaxf(fabsf(v[q].z), fabsf(v[q].w)))); }
#pragma unroll
    for (int o = 1; o < 64; o <<= 1) mx = fmaxf(mx, __shfl_xor(mx, o));
    int ex = 1; if (mx > 0.f) (void)frexpf(7.5f / mx, &ex);
    const float S = ldexpf(1.0f, ex - 1);
    float el[32];
#pragma unroll
    for (int q = 0; q < 8; ++q) { el[4 * q] = v[q].x * S; el[4 * q + 1] = v[q].y * S; el[4 * q + 2] = v[q].z * S; el[4 * q + 3] = v[q].w * S; }
    const v6u w = fp6_pack_sw(el);
    *(u32x4*)(dst + 16 * lane) = (u32x4){w[0], w[1], w[2], w[3]};
    *(u32x2*)(dst + 1024 + 8 * lane) = (u32x2){w[4], w[5]};
    if (lane == 0) *inv_scale = 1.0f / S;
}
DI v6u fp6_load(const unsigned char* row, int lane) {
    const u32x4 a_ = *(const u32x4*)(row + 16 * lane); const u32x2 b_ = *(const u32x2*)(row + 1024 + 8 * lane);
    v6u w; w[0] = a_[0]; w[1] = a_[1]; w[2] = a_[2]; w[3] = a_[3]; w[4] = b_[0]; w[5] = b_[1]; return w;
}
DI float fp6_at(const unsigned char* row, int k) {
    const v6u w = fp6_load(row, k >> 5);
    const v32f r = fp6_unpack_f32(w);
    float o = 0.f;
#pragma unroll
    for (int i = 0; i < 32; ++i) o = ((k & 31) == i) ? r[i] : o;
    return o;
}


#ifndef TAB4
#define TAB4 1
#endif
#ifndef P10_SLICED
#define P10_SLICED 1
#endif
#ifndef XTRA
#define XTRA 0
#endif
#ifndef DUP
#define DUP 0
#endif
constexpr int ROWB4 = 1024;
constexpr size_t WS_PUE = 177 * MiB, WS_PVE = 178 * MiB;
DI unsigned fp4_idx(float a) { return (unsigned)(a > 0.25f) + (unsigned)(a > 0.75f) + (unsigned)(a > 1.25f) + (unsigned)(a > 1.75f) + (unsigned)(a > 2.5f) + (unsigned)(a > 3.5f) + (unsigned)(a > 5.0f); }
DI void row_load32(const float* src, int lane, f32x4 (&v)[8]) {
#pragma unroll
    for (int q = 0; q < 8; ++q) v[q] = *(const f32x4*)(src + 32 * lane + 4 * q);
}
DI void fp4_row_pack(const f32x4 (&v)[8], unsigned char* dst, unsigned char* sdst, int lane) {
    float mx = 0.f;
#pragma unroll
    for (int q = 0; q < 8; ++q) mx = fmaxf(mx, fmaxf(fmaxf(fabsf(v[q].x), fabsf(v[q].y)), fmaxf(fabsf(v[q].z), fabsf(v[q].w))));
    int ex = 1; if (mx > 0.f) (void)frexpf(6.0f / mx, &ex);
    int lg = ex - 1; lg = lg < -100 ? -100 : (lg > 100 ? 100 : lg);
    const float S = ldexpf(1.0f, lg);
    unsigned w[4];
#pragma unroll
    for (int d = 0; d < 4; ++d) {
        unsigned acc = 0u;
#pragma unroll
        for (int e = 0; e < 8; ++e) { const int i = 8 * d + e; const float x = v[i >> 2][i & 3];
            acc |= (fp4_idx(fabsf(x) * S) | ((__float_as_uint(x) >> 31) << 3)) << (4 * e); }
        w[d] = acc;
    }
    *(u32x4*)(dst + 16 * lane) = (u32x4){w[0], w[1], w[2], w[3]};
    sdst[lane] = (unsigned char)(127 - lg);
}
DI void fp4_unpack8(const unsigned w, f32x2 (&r)[4]) {
    r[0] = __builtin_amdgcn_cvt_scalef32_pk_f32_fp4(w, 1.0f, 0); r[1] = __builtin_amdgcn_cvt_scalef32_pk_f32_fp4(w, 1.0f, 1);
    r[2] = __builtin_amdgcn_cvt_scalef32_pk_f32_fp4(w, 1.0f, 2); r[3] = __builtin_amdgcn_cvt_scalef32_pk_f32_fp4(w, 1.0f, 3);
}
DI float fp4_at(const unsigned char* row, const unsigned char* srow, int k) {
    const unsigned w = ((const unsigned*)row)[k >> 3]; f32x2 r[4]; fp4_unpack8(w, r);
    const int e = k & 7; float o = 0.f;
#pragma unroll
    for (int z = 0; z < 4; ++z) o = ((e >> 1) == z) ? ((e & 1) ? r[z][1] : r[z][0]) : o;
    return o * __uint_as_float((unsigned)srow[k >> 5] << 23);
}

#ifndef U4
#define U4 1
#endif
constexpr size_t WS_PUS4 = 80 * MiB;
constexpr size_t WS_H4 = WS_HB;
constexpr size_t WS_HS = WS_HB + 96 * MiB;
DI float u4_step(int code) { return exp2f((float)(code - 208) * 0.0625f); }
DI void int4_row_pack(const f32x4 (&v)[8], unsigned char* dst, unsigned char* sdst, int lane) {
    float mx = 0.f;
#pragma unroll
    for (int q = 0; q < 8; ++q) mx = fmaxf(mx, fmaxf(fmaxf(fabsf(v[q].x), fabsf(v[q].y)), fmaxf(fabsf(v[q].z), fabsf(v[q].w))));
    int code = 0;
    if (mx > 0.f) { code = (int)ceilf(16.0f * log2f(mx * (1.0f / 7.0f))) + 208; code = code < 0 ? 0 : (code > 255 ? 255 : code); }
    const float S = 1.0f / u4_step(code);
    unsigned w[4];
#pragma unroll
    for (int d = 0; d < 4; ++d) {
        unsigned acc = 0u;
#pragma unroll
        for (int e = 0; e < 8; ++e) { const int i = 8 * d + e; const float x = v[i >> 2][i & 3];
            int q = (int)rintf(x * S); q = q < -7 ? -7 : (q > 7 ? 7 : q);
            acc |= ((unsigned)q & 15u) << (4 * e); }
        w[d] = acc;
    }
    *(u32x4*)(dst + 16 * lane) = (u32x4){w[0], w[1], w[2], w[3]};
    sdst[lane] = (unsigned char)code;
}
DI void transpose_item(const float* W, int ldw, int src_n0, bf16_t* WT, int K, int dst_n0, int k0, LAS float* scr, int lane) {
#pragma unroll
    for (int i = 0; i < 32; ++i) { const int kk = 2 * i + (lane >> 5); scr[kk * 33 + (lane & 31)] = W[(size_t)(k0 + kk) * ldw + src_n0 + (lane & 31)]; }
    LDS_WAIT();
    const int c = lane & 7;
#pragma unroll
    for (int j = 0; j < 4; ++j) { const int n = (lane >> 3) + 8 * j; const LAS float* s = scr + (8 * c) * 33 + n;
        u32x4 o; o.x = pk2(s[0 * 33], s[1 * 33]); o.y = pk2(s[2 * 33], s[3 * 33]); o.z = pk2(s[4 * 33], s[5 * 33]); o.w = pk2(s[6 * 33], s[7 * 33]);
        *(u32x4*)(WT + (size_t)(dst_n0 + n) * K + k0 + 8 * c) = o; }
    LDS_WAIT();
}
DI void convert_stream(const float* src, bf16_t* dst, size_t n, size_t gthread, size_t nthreads) {
    for (size_t i = gthread * 8; i < n; i += nthreads * 8) {
        const f32x4 a = *(const f32x4*)(src + i), b = *(const f32x4*)(src + i + 4);
        u32x4 o; o.x = pk2(a.x, a.y); o.y = pk2(a.z, a.w); o.z = pk2(b.x, b.y); o.w = pk2(b.z, b.w);
        *(u32x4*)(dst + i) = o;
    }
}
DI void phase0(const Args& a, LAS unsigned char* lds) {
    const int tid = otid(), lane = tid & 63, wave = tid >> 6, G = gridDim.x, blk = blockIdx.x;
    unsigned char* ws = a.ws;
    {
        LAS float* sc = (LAS float*)lds;
        LAS float* red = (LAS float*)(lds + 16384);
        float* mod = (float*)(ws + WS_CTL) + CW_MOD;
        if (blk < 192) {
            for (int i = tid; i < 2 * D; i += NTHREADS) sc[i] = siluf_(a.c[i]);
            __syncthreads();
            for (int it = blk; it < 192; it += G) {
                const int cq = tid & 15, kg = tid >> 4;
                const float* wp = a.w_ada + (size_t)(kg * 64) * NMOD + it * 64 + 4 * cq;
                f32x4 a0 = (f32x4){0.f, 0.f, 0.f, 0.f}, a1 = a0;
#pragma unroll 16
                for (int kk = 0; kk < 64; ++kk) { const f32x4 w = *(const f32x4*)(wp + (size_t)kk * NMOD); a0 += w * sc[kg * 64 + kk]; a1 += w * sc[D + kg * 64 + kk]; }
                *(LAS f32x4*)(red + (kg * 2 + 0) * 64 + 4 * cq) = a0; *(LAS f32x4*)(red + (kg * 2 + 1) * 64 + 4 * cq) = a1;
                __syncthreads();
                if (tid < 128) { const int b = tid >> 6, c = tid & 63; float s = 0.f;
#pragma unroll
                    for (int q = 0; q < 32; ++q) s += red[(q * 2 + b) * 64 + c];
                    mod[b * NMOD + it * 64 + c] = s + a.b_ada[it * 64 + c]; }
                __syncthreads();
            }
        }
        __syncthreads();
    }
    LAS float* scr = (LAS float*)(lds + wave * 16384);
    const int gw = blk * NWAVES + wave, NGW = G * NWAVES;
    constexpr int I_IN = 32 * 240, I_GLU = 8 * 16, I_SSM = 8 * 64, I_ATT = 16 * 64, I_OUT = 32 * 64, I_PQ = 32 * 64;
    constexpr int NIT = I_IN + I_GLU + I_SSM + I_ATT + I_OUT + I_PQ;
    for (int it = gw; it < NIT; it += NGW) {
        int r = it;
        if (r < I_IN) { const int kb = r / 240, nb = r % 240, n0 = nb * 32; transpose_item(a.w_in, INW, n0 + (n0 >= 3072 ? 8 : 0), (bf16_t*)(ws + WS_WIN), D, n0, kb * 64, scr, lane); continue; } r -= I_IN;
        if (r < I_GLU) { const int kb = r / 16, nb = r % 16; transpose_item(a.w_glu, SW, nb * 32, (bf16_t*)(ws + WS_WGLU), SW, nb * 32, kb * 64, scr, lane); continue; } r -= I_GLU;
        if (r < I_SSM) { const int kb = r / 64, nb = r % 64; transpose_item(a.w_ssm_up, D, nb * 32, (bf16_t*)(ws + WS_WSSM), SW, nb * 32, kb * 64, scr, lane); continue; } r -= I_SSM;
        if (r < I_ATT) { const int kb = r / 64, nb = r % 64; transpose_item(a.w_attn_up, D, nb * 32, (bf16_t*)(ws + WS_WATTN), AW, nb * 32, kb * 64, scr, lane); continue; } r -= I_ATT;
        if (r < I_OUT) { const int kb = r / 64, nb = r % 64; transpose_item(a.w_out, D, nb * 32, (bf16_t*)(ws + WS_WOUT), D, nb * 32, kb * 64, scr, lane); continue; } r -= I_OUT;
        { const int kb = r / 64, nb = r % 64; transpose_item(a.w_peer_q, D, nb * 32, (bf16_t*)(ws + WS_WPQ), D, nb * 32, kb * 64, scr, lane); }
    }
    {
        float* wf = (float*)(ws + WS_WF);
        for (int i = blk * NTHREADS + tid; i < 8 * D; i += G * NTHREADS) { const int j = i >> 11, k = i & 2047; wf[i] = a.w_in[(size_t)k * INW + 3072 + j]; }
    }
    const size_t gt = (size_t)blk * NTHREADS + tid, nthr = (size_t)G * NTHREADS;
    convert_stream(a.sub_keys, (bf16_t*)(ws + WS_KEYS), (size_t)16 * 128 * 128, gt, nthr);
    {
        constexpr int NCH = 2 * NEXP / 16;
        const int ntrip = 2 * ((NCH + G - 1) / G);
        f32x4 cur[8], nxt[8];
        {   const int r0 = 16 * blk + 2 * wave;
            if (blk < NCH) row_load32((r0 >= NEXP ? a.peer_v : a.peer_u) + (size_t)(r0 & (NEXP - 1)) * D, lane, cur); }
        for (int rr = 0; rr < ntrip; ++rr) {
            const int ch = blk + (rr >> 1) * G, r = 16 * ch + 2 * wave + (rr & 1);
            if (ch >= NCH) break;
            {   const int chn = blk + ((rr + 1) >> 1) * G, rn0 = 16 * chn + 2 * wave + ((rr + 1) & 1), rn = (rr + 1 < ntrip && chn < NCH) ? rn0 : r;
                row_load32((rn >= NEXP ? a.peer_v : a.peer_u) + (size_t)(rn & (NEXP - 1)) * D, lane, nxt); }
            const int tb = r >= NEXP, e = r - tb * NEXP;
            unsigned char* sd = ws + (tb ? WS_PVE : WS_PUS4) + (size_t)(lane >> 3) * (NEXP * 8) + (size_t)e * 8 + (lane & 7) - lane;
            if (!tb) int4_row_pack(cur, ws + WS_PU + (size_t)e * ROWB4, sd, lane);
            else fp4_row_pack(cur, ws + WS_PV + (size_t)e * ROWB4, sd, lane);
#pragma unroll
            for (int q = 0; q < 8; ++q) cur[q] = nxt[q];
        }
    }
}


DI int affine_row(int blk, int wave, int i, int G) {
    if (G == 256) return 4096 * (blk & 7) + 128 * (blk >> 3) + 16 * wave + i;
    return (blk * NWAVES + wave) + i * (G * NWAVES);
}
template <bool WITH_F, bool XBF = false>
DI void row_pass(const Args& a, LAS unsigned char* lds, const float* xin, const float* normw, int shift_idx, int scale_idx, bf16_t* hb) {
    const int tid = otid(), lane = tid & 63, wave = tid >> 6, G = gridDim.x, blk = blockIdx.x;
    const float* mod = (const float*)(a.ws + WS_CTL) + CW_MOD;
    LAS f32x4* wfl = (LAS f32x4*)lds;
    if (WITH_F) {
        const f32x4* wf = (const f32x4*)(a.ws + WS_WF);
        for (int i = tid; i < 8 * 512; i += NTHREADS) wfl[i] = wf[i];
        __syncthreads();
    }
    const int gw = blk * NWAVES + wave, NGW = G * NWAVES;
    int curb = -1;
    f32x4 gg[8], sh[8], vn[8];
    (void)gw;
    {   const int m0 = affine_row(blk, wave, 0, G);
        if (m0 < T) {
            if (XBF) { const u32x2* xr = (const u32x2*)x1b_row(a.ws, m0) + lane;
#pragma unroll
                for (int j = 0; j < 8; ++j) { const u32x2 w = xr[64 * j]; vn[j] = (f32x4){bflo(w.x), bfhi(w.x), bflo(w.y), bfhi(w.y)}; } }
            else { const f32x4* xr = (const f32x4*)(xin + (size_t)m0 * D) + lane;
#pragma unroll
                for (int j = 0; j < 8; ++j) vn[j] = xr[64 * j]; } } }
    for (int ri = 0; ri < (T + NGW - 1) / NGW; ++ri) {
        const int m = affine_row(blk, wave, ri, G);
        if (m >= T) break;
        const int b = m >> 14;
        if (b != curb) {
            curb = b;
#pragma unroll
            for (int j = 0; j < 8; ++j) {
                const int e = 4 * (lane + 64 * j);
                const f32x4 nw = *(const f32x4*)(normw + e);
                const f32x4 sc = *(const f32x4*)(mod + b * NMOD + scale_idx * D + e);
                sh[j] = *(const f32x4*)(mod + b * NMOD + shift_idx * D + e);
                gg[j] = nw * (sc + 1.0f);
            }
        }
        f32x4 v[8]; float ss = 0.f;
#pragma unroll
        for (int j = 0; j < 8; ++j) { v[j] = vn[j]; ss += (v[j].x * v[j].x + v[j].y * v[j].y) + (v[j].z * v[j].z + v[j].w * v[j].w); }
        {
            const int mn0 = (ri + 1 < (T + NGW - 1) / NGW) ? affine_row(blk, wave, ri + 1, G) : m, mn = mn0 < T ? mn0 : m;
            if (XBF) { const u32x2* xr = (const u32x2*)x1b_row(a.ws, mn) + lane;
#pragma unroll
                for (int j = 0; j < 8; ++j) { const u32x2 w = xr[64 * j]; vn[j] = (f32x4){bflo(w.x), bfhi(w.x), bflo(w.y), bfhi(w.y)}; } }
            else { const f32x4* xr = (const f32x4*)(xin + (size_t)mn * D) + lane;
#pragma unroll
                for (int j = 0; j < 8; ++j) vn[j] = xr[64 * j]; }
        }
        const float r = rsqrtf(wave_sum(ss) * (1.0f / D) + RMS_EPS);
#pragma unroll
        for (int j = 0; j < 8; ++j) v[j] = v[j] * r * gg[j] + sh[j];
        u32x2* o = (u32x2*)(hb + (size_t)m * D) + lane;
#pragma unroll
        for (int j = 0; j < 8; ++j) { u32x2 w; w.x = pk2(v[j].x, v[j].y); w.y = pk2(v[j].z, v[j].w); o[64 * j] = w; }
        if (WITH_F) {
            float mine = 0.f;
#pragma unroll 1
            for (int q = 0; q < 8; ++q) {
                float s = 0.f;
#pragma unroll
                for (int j = 0; j < 8; ++j) { const f32x4 w = wfl[q * 512 + lane + 64 * j]; s += (v[j].x * w.x + v[j].y * w.y) + (v[j].z * w.z + v[j].w * w.w); }
                s = wave_sum(s);
                mine = (lane == q) ? s : mine;
            }
            if (lane < 8) {
                const float z = mine + a.b_forget[lane];
                const float ls = fminf(z, 0.f) - log1pf(__expf(-fabsf(z)));
                ((float*)(a.ws + WS_LF))[(size_t)m * 8 + lane] = ls;
            }
        }
    }
}


constexpr size_t WS_VT = 113 * MiB;
constexpr size_t WS_DBGS = 928 * MiB;
DI void phase2b(const Args& a, LAS unsigned char* lds) {
    const int tid = otid(), lane = tid & 63, wave = tid >> 6, G = gridDim.x, blk = blockIdx.x;
    const int gw = blk * NWAVES + wave, NGW = G * NWAVES;
    bf16_t* qkv = (bf16_t*)(a.ws + WS_QKV);
    if (gw < NB * AH * 8) {
        const int bh = gw >> 3, seg = gw & 7, b = bh >> 3, h = bh & 7;
        const float* lf = (const float*)(a.ws + WS_LF);
        float* F = (float*)(a.ws + WS_F) + (size_t)bh * SEQ + seg * 2048;
        double carry = 0.0;
        float xv[32];
#pragma unroll
        for (int c = 0; c < 32; ++c) xv[c] = lf[((size_t)b * SEQ + seg * 2048 + c * 64 + lane) * 8 + h];
#pragma unroll
        for (int c = 0; c < 32; ++c) {
            double x = (double)xv[c];
#pragma unroll
            for (int o = 1; o < 64; o <<= 1) { const double t = __shfl_up(x, o); if (lane >= o) x += t; }
            F[c * 64 + lane] = (float)((carry + x) * 1.4426950408889634);
            carry += __shfl(x, 63);
        }
        if (lane == 0) ((float*)(a.ws + WS_CTL) + CW_SEGT)[gw] = (float)(carry * 1.4426950408889634);
    }
    {
        const int head = lane >> 3, d0 = (lane & 7) * 16;
        float wq[16], wk[16];
        const float QS = 0.08838834764831845f * LOG2E;
#pragma unroll
        for (int i = 0; i < 16; ++i) { wq[i] = a.q_norm_w[d0 + i] * QS; wk[i] = a.k_norm_w[d0 + i]; }
        for (int ri = 0; ri < (T + NGW - 1) / NGW; ++ri) {
            const int m = affine_row(blk, wave, ri, G);
            if (m >= T) break;
            bf16_t* row = qkv + (size_t)m * 3072 + head * 128 + d0;
#pragma unroll
            for (int qk = 0; qk < 2; ++qk) {
                bf16_t* p = row + qk * 1024;
                float v[16]; float va[8], vb[8];
                load8_bf16(p, va); load8_bf16(p + 8, vb);
#pragma unroll
                for (int i = 0; i < 8; ++i) { v[i] = va[i]; v[8 + i] = vb[i]; }
                float ss = 0.f;
#pragma unroll
                for (int i = 0; i < 16; ++i) ss += v[i] * v[i];
                ss += __shfl_xor(ss, 1); ss += __shfl_xor(ss, 2); ss += __shfl_xor(ss, 4);
                const float r = rsqrtf(ss * (1.0f / HD) + RMS_EPS);
#pragma unroll
                for (int i = 0; i < 8; ++i) { va[i] = v[i] * r * (qk ? wk[i] : wq[i]); vb[i] = v[8 + i] * r * (qk ? wk[8 + i] : wq[8 + i]); }
                store8_bf16(p, va); store8_bf16(p + 8, vb);
            }
        }
    }
    {
        LAS unsigned char* tile = lds + wave * 17408;
        bf16_t* vt = (bf16_t*)(a.ws + WS_VT);
        for (int it = gw; it < NB * AH * (SEQ / 64); it += NGW) {
            const int b = it / (AH * 256), h = (it / 256) % AH, c = it % 256;
            const size_t m0 = (size_t)b * SEQ + c * 64;
#pragma unroll 4
            for (int i = 0; i < 16; ++i) { const int row = 4 * i + (lane >> 4), ch = lane & 15;
                const u32x4 v = *(const u32x4*)(qkv + (m0 + row) * 3072 + 2048 + h * 128 + ch * 8);
                *(LAS u32x4*)(tile + row * 272 + ch * 16) = v; }
            LDS_WAIT();
#pragma unroll 1
            for (int dd = 0; dd < 2; ++dd) {
                const int d = lane + 64 * dd;
                bf16_t* dst = vt + (((size_t)(b * AH + h) * (SEQ / 64) + c) * HD + d) * 64;
#pragma unroll
                for (int g4 = 0; g4 < 4; ++g4) {
                    unsigned w[8];
#pragma unroll
                    for (int pp = 0; pp < 8; ++pp) {
                        const int p0 = 2 * pp, p1 = 2 * pp + 1;
                        const int k0 = 8 * ((p0 >> 2) & 1) + 4 * (p0 >> 3) + (p0 & 3), k1 = 8 * ((p1 >> 2) & 1) + 4 * (p1 >> 3) + (p1 & 3);
                        const unsigned lo = *(const LAS unsigned short*)(tile + (g4 * 16 + k0) * 272 + d * 2);
                        const unsigned hi = *(const LAS unsigned short*)(tile + (g4 * 16 + k1) * 272 + d * 2);
                        w[pp] = lo | (hi << 16);
                    }
                    *(u32x4*)(dst + g4 * 16) = (u32x4){w[0], w[1], w[2], w[3]};
                    *(u32x4*)(dst + g4 * 16 + 8) = (u32x4){w[4], w[5], w[6], w[7]};
                }
            }
            LDS_WAIT();
        }
    }
}

DI void attn_item(const Args& a, LAS unsigned char* lds, int b, int h, int qb, float thr2) {
    const int tid = otid(), lane = tid & 63, wave = __builtin_amdgcn_readfirstlane(tid >> 6), q = lane & 31, hh = lane >> 5;
    const bf16_t* qkv = (const bf16_t*)(a.ws + WS_QKV);
    const bf16_t* vt = (const bf16_t*)(a.ws + WS_VT) + (size_t)(b * AH + h) * HD * SEQ;
    const float* Floc = (const float*)(a.ws + WS_F) + (size_t)(b * AH + h) * SEQ;
    LAS float* offl = (LAS float*)(lds + 33024);
    if (tid < 8) { const float* st = (const float*)(a.ws + WS_CTL) + CW_SEGT + (b * AH + h) * 8; float s = 0.f; for (int i = 0; i < tid; ++i) s += st[i]; offl[tid] = s; }
    __syncthreads();
    auto F = [&](int i) -> float { return Floc[i] + offl[i >> 11]; };
    const int t0 = qb * 256, tw0 = t0 + 32 * wave, t = tw0 + q;
    const size_t mrow = (size_t)b * SEQ;
    LAS unsigned char* Kl = lds; LAS unsigned char* Vl = lds + 16384; LAS float* Fl = (LAS float*)(lds + 32768);
    int j0;
    {
        const float Ft0 = F(t0); const int jd = t0 / 64; int need = 0;
        for (int k = 0; k < 4; ++k) {
            const int jj = jd - 1 - (64 * k + lane);
            const bool nd = (jj >= 0) && (Ft0 - F(jj >= 0 ? 64 * jj + 63 : 0) > -thr2);
            const unsigned long long bal = __ballot(nd);
            need += __popcll(bal);
            if (bal != ~0ull) break;
        }
        j0 = jd - need;
    }
    const int jend = t0 / 64 + 3;
    bf16x8 qf[8];
#pragma unroll
    for (int ks = 0; ks < 8; ++ks) qf[ks] = *(const bf16x8*)(qkv + (mrow + t) * 3072 + h * 128 + ks * 16 + hh * 8);
    const float Fq = F(t);
    f32x16 o[4];
#pragma unroll
    for (int i = 0; i < 4; ++i)
#pragma unroll
        for (int r = 0; r < 16; ++r) o[i][r] = 0.f;
    float mrun = -1e30f, lrun = 0.f;
    u32x4 kreg[2], vreg[2]; float freg = 0.f;
    auto issue = [&](int j) {
#pragma unroll
        for (int i = 0; i < 2; ++i) { const int idx = tid + 512 * i;
            kreg[i] = *(const u32x4*)(qkv + (mrow + 64 * j + (idx >> 4)) * 3072 + 1024 + h * 128 + (idx & 15) * 8);
            vreg[i] = *(const u32x4*)(vt + (size_t)j * (HD * 64) + (size_t)idx * 8); }
        if (tid < 64) freg = F(64 * j + tid);
    };
    auto commit = [&]() {
#pragma unroll
        for (int i = 0; i < 2; ++i) { const int idx = tid + 512 * i;
            { const int r = idx >> 4, ch = idx & 15; *(LAS u32x4*)(Kl + r * 256 + ((ch ^ (r & 15)) << 4)) = kreg[i]; }
            { const int d = idx >> 3, ch = idx & 7; *(LAS u32x4*)(Vl + d * 128 + ((ch ^ ((d >> 1) & 7)) << 4)) = vreg[i]; } }
        if (tid < 64) Fl[tid] = freg;
    };
    issue(j0);
    for (int j = j0; j <= jend; ++j) {
        __syncthreads();
        commit();
        __syncthreads();
        if (j < jend) issue(j + 1);
        if (64 * j <= tw0 + 31) {
            f32x16 sacc[2];
#pragma unroll
            for (int rb = 0; rb < 2; ++rb) {
#pragma unroll
                for (int r = 0; r < 16; ++r) sacc[rb][r] = 0.f;
#pragma unroll
                for (int ks = 0; ks < 8; ++ks) {
                    const int r = rb * 32 + q, ch = ks * 2 + hh;
                    const bf16x8 kf = *(const LAS bf16x8*)(Kl + r * 256 + ((ch ^ (r & 15)) << 4));
                    sacc[rb] = __builtin_amdgcn_mfma_f32_32x32x16_bf16(kf, qf[ks], sacc[rb], 0, 0, 0);
                }
            }
            const bool diag = (64 * j + 63 > tw0);
            float mx = -1e30f;
#pragma unroll
            for (int rb = 0; rb < 2; ++rb)
#pragma unroll
                for (int g4 = 0; g4 < 4; ++g4) {
                    const f32x4 fs = *(const LAS f32x4*)(Fl + rb * 32 + 8 * g4 + 4 * hh);
#pragma unroll
                    for (int i = 0; i < 4; ++i) {
                        const int reg = 4 * g4 + i;
                        float s = sacc[rb][reg] + (Fq - fs[i]);
                        if (diag) { const int key = 64 * j + rb * 32 + 8 * g4 + 4 * hh + i; s = (key > t) ? -1e30f : s; }
                        sacc[rb][reg] = s; mx = fmaxf(mx, s);
                    }
                }
            mx = fmaxf(mx, __shfl_xor(mx, 32));
            if (__ballot(mx > mrun + 8.0f) != 0ull) {
                const float mnew = fmaxf(mrun, mx);
                const float alpha = __builtin_amdgcn_exp2f(mrun - mnew);
                mrun = mnew;
                lrun *= alpha;
#pragma unroll
                for (int i = 0; i < 4; ++i)
#pragma unroll
                    for (int r = 0; r < 16; ++r) o[i][r] *= alpha;
            }
            float ps = 0.f;
#pragma unroll
            for (int rb = 0; rb < 2; ++rb)
#pragma unroll
                for (int r = 0; r < 16; ++r) { const float p = __builtin_amdgcn_exp2f(sacc[rb][r] - mrun); sacc[rb][r] = p; ps += p; }
            lrun += ps;
#pragma unroll
            for (int rb = 0; rb < 2; ++rb)
#pragma unroll
                for (int s2 = 0; s2 < 2; ++s2) {
                    u32x4 pw; pw.x = pk2(sacc[rb][8 * s2 + 0], sacc[rb][8 * s2 + 1]); pw.y = pk2(sacc[rb][8 * s2 + 2], sacc[rb][8 * s2 + 3]);
                    pw.z = pk2(sacc[rb][8 * s2 + 4], sacc[rb][8 * s2 + 5]); pw.w = pk2(sacc[rb][8 * s2 + 6], sacc[rb][8 * s2 + 7]);
                    const bf16x8 pf = __builtin_bit_cast(bf16x8, pw);
                    const int ch = rb * 4 + s2 * 2 + hh;
#pragma unroll
                    for (int db = 0; db < 4; ++db) {
                        const int d = db * 32 + q;
                        const bf16x8 vf = *(const LAS bf16x8*)(Vl + d * 128 + ((ch ^ ((d >> 1) & 7)) << 4));
                        o[db] = __builtin_amdgcn_mfma_f32_32x32x16_bf16(vf, pf, o[db], 0, 0, 0);
                    }
                }
        }
    }
    const float ltot = lrun + __shfl_xor(lrun, 32);
    const float inv = 1.0f / ltot;
    bf16_t* yo = (bf16_t*)(a.ws + WS_YATT) + (mrow + t) * AW + h * 128;
#pragma unroll
    for (int db = 0; db < 4; ++db)
#pragma unroll
        for (int g4 = 0; g4 < 4; ++g4) {
            u32x2 w; w.x = pk2(o[db][4 * g4] * inv, o[db][4 * g4 + 1] * inv); w.y = pk2(o[db][4 * g4 + 2] * inv, o[db][4 * g4 + 3] * inv);
            *(u32x2*)(yo + db * 32 + 8 * g4 + 4 * hh) = w;
        }
    __syncthreads();
}


constexpr size_t WS_S5POW = WS_S5TAB;
constexpr size_t WS_S5BB = WS_S5TAB + 512 * 1024;
constexpr size_t WS_S5Q = WS_S5TAB + 1 * MiB;
constexpr size_t WS_S5P = WS_S5TAB + 3 * MiB;
constexpr size_t WS_S5K = WS_S5TAB + 5 * MiB;
DI void s5_tables_p0(const Args& a) {
    const int gt = blockIdx.x * NTHREADS + otid();
    if (gt >= SGRP * SST) return;
    const int g = gt >> 6, p = gt & 63;
    const float lre = a.A_re[g * SST + p], lim = a.A_im[g * SST + p], dt = expf(a.log_dt[g]);
    const float mag = expf(lre * dt), abr = mag * cosf(lim * dt), abi = mag * sinf(lim * dt);
    const float den = lre * lre + lim * lim, nr = abr - 1.0f;
    const float cr = (nr * lre + abi * lim) / den, ci = (abi * lre - nr * lim) / den;
    float* pw = (float*)(a.ws + WS_S5POW) + (size_t)gt * 34;
    double pr = 1.0, pi = 0.0;
    for (int n = 0; n <= 16; ++n) { pw[2 * n] = (float)pr; pw[2 * n + 1] = (float)pi; const double t = pr * abr - pi * abi; pi = pr * abi + pi * abr; pr = t; }
    float* bb = (float*)(a.ws + WS_S5BB) + (size_t)gt * 32;
    for (int c = 0; c < 16; ++c) { const float br = a.B_re[(g * SST + p) * SCH + c], bi = a.B_im[(g * SST + p) * SCH + c];
        bb[2 * c] = cr * br - ci * bi; bb[2 * c + 1] = cr * bi + ci * br; }
}
DI void s5_tables_p1(const Args& a) {
    const size_t gt0 = (size_t)blockIdx.x * NTHREADS + otid(), nthr = (size_t)gridDim.x * NTHREADS;
    const float* POW = (const float*)(a.ws + WS_S5POW); const float* BB = (const float*)(a.ws + WS_S5BB);
    bf16_t* Qt = (bf16_t*)(a.ws + WS_S5Q); bf16_t* Pt = (bf16_t*)(a.ws + WS_S5P); bf16_t* Kt = (bf16_t*)(a.ws + WS_S5K);
    for (size_t i = gt0; i < (size_t)SGRP * 16 * 128 * 16; i += nthr) {
        {
            const int c = i & 15, pp = (i >> 4) & 127, j = (i >> 11) & 15, g = (int)(i >> 15), p = pp & 63;
            const float* pw = POW + ((size_t)(g * SST + p) * 17 + (15 - j)) * 2; const float* bb = BB + ((size_t)(g * SST + p) * 16 + c) * 2;
            const float re = pw[0] * bb[0] - pw[1] * bb[1], im = pw[0] * bb[1] + pw[1] * bb[0];
            Qt[i] = (bf16_t)(pk2(pp < 64 ? re : im, 0.f) & 0xffffu);
        }
        {
            const int pp = i & 127, c = (i >> 7) & 15, t = (i >> 11) & 15, g = (int)(i >> 15), p = pp & 63;
            const float* pw = POW + ((size_t)(g * SST + p) * 17 + (t + 1)) * 2;
            const float cr = a.C_re[(g * SCH + c) * SST + p], ci = a.C_im[(g * SCH + c) * SST + p];
            const float re = cr * pw[0] - ci * pw[1], im = cr * pw[1] + ci * pw[0];
            Pt[i] = (bf16_t)(pk2(pp < 64 ? re : -im, 0.f) & 0xffffu);
        }
    }
    for (size_t i = gt0; i < (size_t)SGRP * 17 * 32 * 16; i += nthr) {
        const int cp = i & 15, row = (i >> 4) & 31, d = (int)((i >> 9) % 17), g = (int)(i / (17 * 512));
        const int tau = d - 1 + (row >> 4), c = row & 15;
        float s = 0.f;
        if (tau >= 0) for (int p = 0; p < SST; ++p) {
            const float* pw = POW + ((size_t)(g * SST + p) * 17 + tau) * 2; const float* bb = BB + ((size_t)(g * SST + p) * 16 + cp) * 2;
            const float wr = pw[0] * bb[0] - pw[1] * bb[1], wi = pw[0] * bb[1] + pw[1] * bb[0];
            s += a.C_re[(g * SCH + c) * SST + p] * wr - a.C_im[(g * SCH + c) * SST + p] * wi;
        }
        Kt[i] = (bf16_t)(pk2(s, 0.f) & 0xffffu);
    }
}
DI float gelu_as(float v) {
    const float av = fabsf(v), t = __builtin_amdgcn_rcpf(av * 0.2316418882f + 1.0f);
    float q = t * 0.5307027145f + (-0.7265760135f); q = q * t + 0.7107068705f; q = q * t + (-0.142248368f); q = q * t + 0.127414796f; q = q * t;
    const float e = __builtin_amdgcn_exp2f((v * v) * (-0.72134752044f));
    const float m = v * (q * e);
    return v < 0.f ? m : v - m;
}
DI void s5_mfma_item(const Args& a, LAS unsigned char* lds, int b, int g) {
    const int tid = otid(), lane = tid & 63, w = __builtin_amdgcn_readfirstlane(tid >> 6), q = lane & 31, hh = lane >> 5;
    LAS unsigned char* Xl = lds;
    LAS unsigned char* El = lds + 32768;
    LAS unsigned char* Cl = lds + 65536;
    LAS unsigned char* Kl = lds + 81920;
    const bf16_t* U = (const bf16_t*)(a.ws + WS_U);
    bf16_t* GY = (bf16_t*)(a.ws + WS_GY);
    __syncthreads();
    {   const u32x4* ks = (const u32x4*)((const bf16_t*)(a.ws + WS_S5K) + (size_t)g * 17 * 512);
        for (int i = tid; i < 17 * 64; i += NTHREADS) *(LAS u32x4*)(Kl + i * 16) = ks[i]; }
    const int rbE = w & 3, cbE = w >> 2;
    bf16x8 qf[16], pf[8];
    {   const bf16_t* Qt = (const bf16_t*)(a.ws + WS_S5Q) + (size_t)g * 16 * 128 * 16;
#pragma unroll
        for (int j = 0; j < 16; ++j) qf[j] = *(const bf16x8*)(Qt + ((size_t)j * 128 + rbE * 32 + q) * 16 + 8 * hh);
        const bf16_t* Pt = (const bf16_t*)(a.ws + WS_S5P) + (size_t)g * 16 * 16 * 128;
        const int t = 2 * w + (q >> 4), c = q & 15;
#pragma unroll
        for (int ks = 0; ks < 8; ++ks) pf[ks] = *(const bf16x8*)(Pt + ((size_t)t * 16 + c) * 128 + ks * 16 + 8 * hh); }
    float dsel[2][4];
#pragma unroll
    for (int z = 0; z < 2; ++z)
#pragma unroll
        for (int i = 0; i < 4; ++i) dsel[z][i] = a.Dskip[g * SCH + 4 * hh + 8 * z + i];
    float cr = 0.f, ci = 0.f, a16r = 0.f, a16i = 0.f;
    if (w == 0) { const float* pw = (const float*)(a.ws + WS_S5POW) + ((size_t)(g * SST + lane) * 17 + 16) * 2; a16r = pw[0]; a16i = pw[1]; }
    __syncthreads();
    u32x4 xpre[4];
#pragma unroll
    for (int i = 0; i < 2; ++i) { const size_t tokm = (size_t)b * SEQ + tid + 512 * i;
        xpre[2 * i] = *(const u32x4*)(U + tokm * SW + g * SCH); xpre[2 * i + 1] = *(const u32x4*)(U + tokm * SW + g * SCH + 8); }
    for (int sc = 0; sc < SEQ / 1024; ++sc) {
        const size_t m0 = (size_t)b * SEQ + (size_t)sc * 1024;
#pragma unroll
        for (int i = 0; i < 2; ++i) { const int tok = tid + 512 * i, j = tok & 15, k = tok >> 4;
            *(LAS u32x4*)(Xl + ((j * 64 + k) * 2) * 16) = xpre[2 * i]; *(LAS u32x4*)(Xl + ((j * 64 + k) * 2 + 1) * 16) = xpre[2 * i + 1]; }
        if (sc + 1 < SEQ / 1024) {
#pragma unroll
            for (int i = 0; i < 2; ++i) { const size_t tokm = m0 + 1024 + tid + 512 * i;
                xpre[2 * i] = *(const u32x4*)(U + tokm * SW + g * SCH); xpre[2 * i + 1] = *(const u32x4*)(U + tokm * SW + g * SCH + 8); }
        }
        __syncthreads();
        {
            f32x16 e;
#pragma unroll
            for (int r = 0; r < 16; ++r) e[r] = 0.f;
#pragma unroll
            for (int j = 0; j < 16; ++j) { const bf16x8 xb = *(const LAS bf16x8*)(Xl + ((j * 64 + cbE * 32 + q) * 2 + hh) * 16);
                e = __builtin_amdgcn_mfma_f32_32x32x16_bf16(qf[j], xb, e, 0, 0, 0); }
            const int k = cbE * 32 + q;
#pragma unroll
            for (int g4 = 0; g4 < 4; ++g4) { const int pp = rbE * 32 + 8 * g4 + 4 * hh;
                *(LAS f32x4*)(El + k * 512 + (((pp >> 2) ^ (k & 31)) << 4)) = (f32x4){e[4 * g4], e[4 * g4 + 1], e[4 * g4 + 2], e[4 * g4 + 3]}; }
        }
        __syncthreads();
        if (w == 0) {
#pragma unroll 1
            for (int k0 = 0; k0 < 64; k0 += 16) {
                float er[16], ei[16];
#pragma unroll
                for (int kk = 0; kk < 16; ++kk) { const int k = k0 + kk;
                    er[kk] = *(const LAS float*)(El + k * 512 + ((((lane) >> 2) ^ (k & 31)) << 4) + (lane & 3) * 4);
                    ei[kk] = *(const LAS float*)(El + k * 512 + ((((64 + lane) >> 2) ^ (k & 31)) << 4) + (lane & 3) * 4); }
                unsigned short cw[32];
#pragma unroll
                for (int kk = 0; kk < 16; ++kk) {
                    cw[2 * kk] = (unsigned short)(pk2(cr, 0.f) & 0xffffu); cw[2 * kk + 1] = (unsigned short)(pk2(ci, 0.f) & 0xffffu);
                    const float nr = a16r * cr - a16i * ci + er[kk], ni = a16r * ci + a16i * cr + ei[kk];
                    cr = nr; ci = ni;
                }
#pragma unroll
                for (int kk = 0; kk < 16; ++kk) { const int k = k0 + kk;
                    *(LAS unsigned short*)(Cl + k * 256 + ((((lane) >> 3) ^ (k & 15)) << 4) + (lane & 7) * 2) = cw[2 * kk];
                    *(LAS unsigned short*)(Cl + k * 256 + ((((64 + lane) >> 3) ^ (k & 15)) << 4) + (lane & 7) * 2) = cw[2 * kk + 1]; }
            }
        }
        f32x16 y[2];
#pragma unroll
        for (int cb = 0; cb < 2; ++cb)
#pragma unroll
            for (int r = 0; r < 16; ++r) y[cb][r] = 0.f;
#pragma unroll 2
        for (int j = 0; j <= 2 * w + 1; ++j) {
            const bf16x8 kf = *(const LAS bf16x8*)(Kl + (((2 * w - j + 1) * 32 + q) * 16 + 8 * hh) * 2);
#pragma unroll
            for (int cb = 0; cb < 2; ++cb) { const bf16x8 xb = *(const LAS bf16x8*)(Xl + ((j * 64 + cb * 32 + q) * 2 + hh) * 16);
                y[cb] = __builtin_amdgcn_mfma_f32_32x32x16_bf16(kf, xb, y[cb], 0, 0, 0); }
        }
        __syncthreads();
#pragma unroll
        for (int ks = 0; ks < 8; ++ks)
#pragma unroll
            for (int cb = 0; cb < 2; ++cb) { const int k = cb * 32 + q;
                const bf16x8 cf = *(const LAS bf16x8*)(Cl + k * 256 + (((ks * 2 + hh) ^ (k & 15)) << 4));
                y[cb] = __builtin_amdgcn_mfma_f32_32x32x16_bf16(pf[ks], cf, y[cb], 0, 0, 0); }
#pragma unroll
        for (int cb = 0; cb < 2; ++cb) {
            const int k = cb * 32 + q;
#pragma unroll
            for (int g4 = 0; g4 < 4; ++g4) {
                const int tt = g4 >> 1, z = g4 & 1, t = 2 * w + tt, c0 = 4 * hh + 8 * z;
                const u32x2 uw = *(const LAS u32x2*)(Xl + ((t * 64 + k) * 2 + z) * 16 + hh * 8);
                const float u0 = bflo(uw.x), u1 = bfhi(uw.x), u2 = bflo(uw.y), u3 = bfhi(uw.y);
                const float y0 = gelu_as(y[cb][4 * g4] + dsel[z][0] * u0), y1 = gelu_as(y[cb][4 * g4 + 1] + dsel[z][1] * u1);
                const float y2 = gelu_as(y[cb][4 * g4 + 2] + dsel[z][2] * u2), y3 = gelu_as(y[cb][4 * g4 + 3] + dsel[z][3] * u3);
                u32x2 o; o.x = pk2(y0, y1); o.y = pk2(y2, y3);
                *(u32x2*)(GY + (m0 + 16 * k + t) * SW + g * SCH + c0) = o;
            }
        }
        __syncthreads();
    }
}

DI void phase3(const Args& a, LAS unsigned char* lds) {
    const int tid = otid(), lane = tid & 63, wave = tid >> 6, blk = blockIdx.x;
    unsigned* ctl = (unsigned*)(a.ws + WS_CTL);
    for (int it = blk; it < NB * SGRP; it += gridDim.x) s5_mfma_item(a, lds, it >> 5, it & 31);
    float wqm = 0.f, wkm = 0.f;
    for (int i = lane; i < HD; i += 64) { wqm = fmaxf(wqm, fabsf(a.q_norm_w[i])); wkm = fmaxf(wkm, fabsf(a.k_norm_w[i])); }
#pragma unroll
    for (int o = 1; o < 64; o <<= 1) { wqm = fmaxf(wqm, __shfl_xor(wqm, o)); wkm = fmaxf(wkm, __shfl_xor(wkm, o)); }
    const float qkb2 = 11.313708499f * wqm * wkm * LOG2E * 1.02f;
    const float thr2 = 2.0f * qkb2 + 30.0f * LOG2E;
    LAS int* qi = (LAS int*)(lds + 40960);
    for (;;) {
        __syncthreads();
        if (tid == 0) *qi = (int)atomicAdd(ctl + CW_QUEUE, 1u);
        __syncthreads();
        const int it = *qi;
        if (it >= NB * AH * 64) break;
        attn_item(a, lds, it / (AH * 64), (it / 64) % AH, it % 64, thr2);
    }
}


constexpr size_t WS_H2B = WS_QKV;
constexpr size_t WS_QP = WS_GATES;
constexpr size_t WS_IDS = 992 * MiB;
constexpr size_t WS_GW = 1008 * MiB;
struct EpiPlain {
    static constexpr bool PERM = true;
    bf16_t* o; int ldc;
    DI void operator()(const f32x4 (&acc)[2][2][4][2], const pg8::Unit& un, int wr, int wc, int fr, int fq) const {
        epi_foreach(acc, un, wr, wc, fr, fq, [&](int row, int col0, float (&v)[8]) { store8_bf16(o + (size_t)row * ldc + col0, v); });
    }
};
DI unsigned enc_sortable(float f) { const unsigned u = __float_as_uint(f); return u ^ ((u >> 31) ? 0xffffffffu : 0x80000000u); }
DI float dec_sortable(unsigned s) { return __uint_as_float(s ^ ((s >> 31) ? 0x80000000u : 0xffffffffu)); }
#define TOPK_INSERT(L, x_) do { unsigned _x = (x_); _Pragma("unroll") for (int _k = 0; _k < 16; ++_k) { const unsigned _hi = max(L[_k], _x); _x = min(L[_k], _x); L[_k] = _hi; } } while (0)
DI void sort_bitonic16_desc(unsigned (&M)[16]) {
#pragma unroll
    for (int st = 8; st >= 1; st >>= 1)
#pragma unroll
        for (int i = 0; i < 16; ++i) if ((i & st) == 0) { const unsigned a_ = max(M[i], M[i + st]), b_ = min(M[i], M[i + st]); M[i] = a_; M[i + st] = b_; }
}
template <int N> DI void bitonic_sort_desc(unsigned (&v)[N]) {
#pragma unroll
    for (int k = 2; k <= N; k <<= 1)
#pragma unroll
        for (int j = k >> 1; j > 0; j >>= 1)
#pragma unroll
            for (int i = 0; i < N; ++i) { const int l = i ^ j;
                if (l > i) { const bool desc = (i & k) == 0; const unsigned hi_ = max(v[i], v[l]), lo_ = min(v[i], v[l]); v[i] = desc ? hi_ : lo_; v[l] = desc ? lo_ : hi_; } }
}
DI void merge_top16(unsigned (&A)[16], const unsigned (&B)[16]) {
#pragma unroll
    for (int k = 0; k < 16; ++k) A[k] = max(A[k], B[15 - k]);
    sort_bitonic16_desc(A);
}
DI void peer_select_item(const Args& a, LAS unsigned char* lds, int h, int tile) {
    const int tid = otid(), lane = tid & 63, wave = tid >> 6, q = lane & 31, hh = lane >> 5;
    const bf16_t* keys = (const bf16_t*)(a.ws + WS_KEYS) + (size_t)h * 2 * NKEYS * 128;
    __syncthreads();
    for (int i = tid; i < 2 * NKEYS * 16; i += NTHREADS) {
        const int r = i >> 4, ch = i & 15;
        *(LAS u32x4*)(lds + r * 256 + ((ch ^ (r & 15)) << 4)) = *(const u32x4*)(keys + (size_t)r * 128 + ch * 8);
    }
    __syncthreads();
    const size_t m = (size_t)tile * 256 + wave * 32 + q;
    const bf16_t* qp = (const bf16_t*)(a.ws + WS_QP) + m * D + h * 256;
    unsigned S[2][16];
#pragma unroll
    for (int p = 0; p < 2; ++p) {
        bf16x8 qf[8];
#pragma unroll
        for (int ks = 0; ks < 8; ++ks) qf[ks] = *(const bf16x8*)(qp + p * 128 + ks * 16 + hh * 8);
        f32x16 acc[4];
#pragma unroll
        for (int rb = 0; rb < 4; ++rb) {
#pragma unroll
            for (int r = 0; r < 16; ++r) acc[rb][r] = 0.f;
#pragma unroll
            for (int ks = 0; ks < 8; ++ks) {
                const int r = p * 128 + rb * 32 + q, ch = ks * 2 + hh;
                const bf16x8 kf = *(const LAS bf16x8*)(lds + r * 256 + ((ch ^ (r & 15)) << 4));
                acc[rb] = __builtin_amdgcn_mfma_f32_32x32x16_bf16(kf, qf[ks], acc[rb], 0, 0, 0);
            }
        }
        unsigned K0[16], K1[16], K2[16], K3[16];
#pragma unroll
        for (int r = 0; r < 16; ++r) {
            const unsigned n = (r & 3) + 8 * (r >> 2) + 4 * hh;
            K0[r] = (enc_sortable(acc[0][r]) & ~0x7Fu) | n; K1[r] = (enc_sortable(acc[1][r]) & ~0x7Fu) | (32 + n);
            K2[r] = (enc_sortable(acc[2][r]) & ~0x7Fu) | (64 + n); K3[r] = (enc_sortable(acc[3][r]) & ~0x7Fu) | (96 + n);
        }
        bitonic_sort_desc<16>(K0); bitonic_sort_desc<16>(K1); bitonic_sort_desc<16>(K2); bitonic_sort_desc<16>(K3);
        merge_top16(K0, K1); merge_top16(K2, K3); merge_top16(K0, K2);
        unsigned M[16];
#pragma unroll
        for (int k = 0; k < 16; ++k) { const unsigned pl = __shfl_xor(K0[15 - k], 32); M[k] = max(K0[k], pl); }
        sort_bitonic16_desc(M);
#pragma unroll
        for (int k = 0; k < 16; ++k) S[p][k] = M[k];
    }
    float f0[16], f1[16];
#pragma unroll
    for (int k = 0; k < 16; ++k) { f0[k] = dec_sortable(S[0][k] & ~0x7Fu); f1[k] = dec_sortable(S[1][k] & ~0x7Fu); }
    unsigned R[16], X[32], X2[2];
#pragma unroll
    for (int c = 0; c < 16; ++c) R[c] = (enc_sortable(f0[0] + f1[c]) & ~0xFFu) | (unsigned)c;
    {   int idx = 0;
#pragma unroll
        for (int p = 1; p < 16; ++p)
#pragma unroll
            for (int c = 0; c < 16; ++c) if ((p + 1) * (c + 1) <= 16) {
                const unsigned key = (enc_sortable(f0[p] + f1[c]) & ~0xFFu) | (unsigned)(p * 16 + c);
                if (idx < 32) X[idx] = key; else X2[idx - 32] = key;
                ++idx;
            }
    }
    bitonic_sort_desc<16>(R); bitonic_sort_desc<32>(X);
    {   unsigned XT[16];
#pragma unroll
        for (int k = 0; k < 16; ++k) XT[k] = X[k];
        merge_top16(R, XT); }
    TOPK_INSERT(R, X2[0]); TOPK_INSERT(R, X2[1]);
    unsigned pk0[4] = {0, 0, 0, 0}, pk1[4] = {0, 0, 0, 0};
#pragma unroll
    for (int k = 0; k < 16; ++k) { pk0[k >> 2] |= (S[0][k] & 0x7Fu) << (8 * (k & 3)); pk1[k >> 2] |= (S[1][k] & 0x7Fu) << (8 * (k & 3)); }
    int eid[16]; float ew[16]; float esum = 0.f;
    const float tv0 = dec_sortable(R[0] & ~0xFFu);
#pragma unroll
    for (int r = 0; r < 16; ++r) {
        const unsigned pq = R[r] & 0xFFu, p = pq >> 4, c = pq & 15u;
        unsigned w0 = pk0[0], w1 = pk1[0];
        w0 = (p >> 2) == 1 ? pk0[1] : w0; w0 = (p >> 2) == 2 ? pk0[2] : w0; w0 = (p >> 2) == 3 ? pk0[3] : w0;
        w1 = (c >> 2) == 1 ? pk1[1] : w1; w1 = (c >> 2) == 2 ? pk1[2] : w1; w1 = (c >> 2) == 3 ? pk1[3] : w1;
        const unsigned i0 = (w0 >> (8 * (p & 3))) & 0x7Fu, i1 = (w1 >> (8 * (c & 3))) & 0x7Fu;
        eid[r] = (int)(i0 * NKEYS + i1);
        ew[r] = __expf(dec_sortable(R[r] & ~0xFFu) - tv0); esum += ew[r];
    }
    const float inv = 1.0f / esum;
    if (hh == 0) {
        unsigned short* o = (unsigned short*)(a.ws + WS_IDS) + m * NSEL + h * 16;
#pragma unroll
        for (int r = 0; r < 16; r += 8) *(u32x4*)(o + r) = (u32x4){(unsigned)eid[r] | ((unsigned)eid[r + 1] << 16), (unsigned)eid[r + 2] | ((unsigned)eid[r + 3] << 16),
                                                                   (unsigned)eid[r + 4] | ((unsigned)eid[r + 5] << 16), (unsigned)eid[r + 6] | ((unsigned)eid[r + 7] << 16)};
    } else {
        float* o = (float*)(a.ws + WS_GW) + m * NSEL + h * 16;
#pragma unroll
        for (int r = 0; r < 16; r += 4) *(f32x4*)(o + r) = (f32x4){ew[r] * inv, ew[r + 1] * inv, ew[r + 2] * inv, ew[r + 3] * inv};
    }
}
DI void phase9(const Args& a, LAS unsigned char* lds) {
    if (gridDim.x == 256) {
        const int c = blockIdx.x, tile = 16 * (c & 7) + ((c >> 3) & 15), h0 = 4 * (c >> 7);
        for (int hh = 0; hh < 4; ++hh) peer_select_item(a, lds, h0 + hh, tile);
    } else
        for (int it = blockIdx.x; it < PH * (T / 256); it += gridDim.x) peer_select_item(a, lds, it / (T / 256), it % (T / 256));
}

#ifndef EPB
#define EPB 16
#endif
#ifndef EPB2
#define EPB2 8
#endif
DI void phase10(const Args& a) {
    const int tid = otid(), lane = tid & 63, wave = tid >> 6;
    const int gw = blockIdx.x * NWAVES + wave, NGW = gridDim.x * NWAVES;
    const unsigned char* PU = a.ws + WS_PU; const unsigned char* PV = a.ws + WS_PV;
    const float* PUS = (const float*)(a.ws + WS_PUS); const float* PVS = (const float*)(a.ws + WS_PVS);
    const float* mod = (const float*)(a.ws + WS_CTL) + CW_MOD;
    (void)gw;
    for (int ri = 0; ri < (T + NGW - 1) / NGW; ++ri) {
        const int m = affine_row(blockIdx.x, wave, ri, gridDim.x);
        if (m >= T) break;
        const int b = m >> 14;
        const int* ids = (const int*)(a.ws + WS_IDS) + (size_t)m * NSEL; const float* gwp = (const float*)(a.ws + WS_GW) + (size_t)m * NSEL;
        const int idA = ids[lane], idB = ids[64 + lane];
        const float gA = gwp[lane] * PVS[idA], gB = gwp[64 + lane] * PVS[idB];
        const float suA = PUS[idA], suB = PUS[idB];
        const bf16_t* hrow = (const bf16_t*)(a.ws + WS_H2B) + (size_t)m * D + 32 * lane;
        unsigned hp[16];
#pragma unroll
        for (int q = 0; q < 4; ++q) { const u32x4 t4 = *(const u32x4*)(hrow + 8 * q); hp[4 * q] = t4[0]; hp[4 * q + 1] = t4[1]; hp[4 * q + 2] = t4[2]; hp[4 * q + 3] = t4[3]; }
        float cf[4];
#pragma unroll
        for (int bt = 0; bt < 4; ++bt) {
            float part[32];
#pragma unroll
            for (int i0 = 0; i0 < 32; i0 += EPB) {
                v6u uw[EPB];
#pragma unroll
                for (int i = 0; i < EPB; ++i) {
                    const int id = __builtin_amdgcn_readlane(bt < 2 ? idA : idB, (bt & 1) * 32 + i0 + i);
                    uw[i] = fp6_load(PU + (size_t)id * ROWB, lane);
                }
#pragma unroll
                for (int i = 0; i < EPB; ++i) {
                    const v16u rp = fp6_unpack_bf16(uw[i]);
                    float s = 0.f;
#pragma unroll
                    for (int k = 0; k < 16; ++k) { const unsigned pu = rp[k], ph = hp[k];
                        s = __builtin_amdgcn_fdot2_f32_bf16(__builtin_bit_cast(bf16x2_t, ph), __builtin_bit_cast(bf16x2_t, pu), s, false); }
                    part[i0 + i] = s;
                }
                __builtin_amdgcn_sched_barrier(0);
            }
            float p16[16], p8[8], p4[4], p2[2], p1;
            { const bool hi = lane & 32;
#pragma unroll
              for (int i = 0; i < 16; ++i) { const float snd = hi ? part[i] : part[i + 16], kp = hi ? part[i + 16] : part[i]; p16[i] = kp + __shfl_xor(snd, 32); } }
            { const bool hi = lane & 16;
#pragma unroll
              for (int i = 0; i < 8; ++i) { const float snd = hi ? p16[i] : p16[i + 8], kp = hi ? p16[i + 8] : p16[i]; p8[i] = kp + __shfl_xor(snd, 16); } }
            { const bool hi = lane & 8;
#pragma unroll
              for (int i = 0; i < 4; ++i) { const float snd = hi ? p8[i] : p8[i + 4], kp = hi ? p8[i + 4] : p8[i]; p4[i] = kp + __shfl_xor(snd, 8); } }
            { const bool hi = lane & 4;
#pragma unroll
              for (int i = 0; i < 2; ++i) { const float snd = hi ? p4[i] : p4[i + 2], kp = hi ? p4[i + 2] : p4[i]; p2[i] = kp + __shfl_xor(snd, 4); } }
            { const bool hi = lane & 2; const float snd = hi ? p2[0] : p2[1], kp = hi ? p2[1] : p2[0]; p1 = kp + __shfl_xor(snd, 2); }
            p1 += __shfl_xor(p1, 1);
            const int src_lane = (bt & 1) * 32 + (lane >> 1);
            const float g = __shfl(bt < 2 ? gA : gB, src_lane), su = __shfl(bt < 2 ? suA : suB, src_lane);
            cf[bt] = geluf_(p1 * su) * g;
        }
        f32x2 acc[16];
#pragma unroll
        for (int k = 0; k < 16; ++k) acc[k] = (f32x2){0.f, 0.f};
#pragma unroll
        for (int bt = 0; bt < 4; ++bt) {
#pragma unroll 1
            for (int i0 = 0; i0 < 32; i0 += EPB2) {
                __builtin_amdgcn_sched_barrier(0);
                v6u vw[EPB2]; float cs[EPB2];
#pragma unroll
                for (int i = 0; i < EPB2; ++i) {
                    const int id = __builtin_amdgcn_readlane(bt < 2 ? idA : idB, (bt & 1) * 32 + i0 + i);
                    cs[i] = __uint_as_float((unsigned)__builtin_amdgcn_readlane((int)__float_as_uint(cf[bt]), 2 * (i0 + i)));
                    vw[i] = fp6_load(PV + (size_t)id * ROWB, lane);
                }
#pragma unroll
                for (int i = 0; i < EPB2; ++i) {
                    const v32f r = fp6_unpack_f32(vw[i]);
                    const f32x2 c2 = (f32x2){cs[i], cs[i]};
#pragma unroll
                    for (int k = 0; k < 16; ++k) acc[k] = __builtin_elementwise_fma(c2, (f32x2){r[2 * k], r[2 * k + 1]}, acc[k]);
                }
            }
        }
        float* orow = a.out + (size_t)m * D + 32 * lane;
        const float* gp = mod + b * NMOD + 5 * D + 32 * lane;
#pragma unroll
        for (int k4 = 0; k4 < 8; ++k4) {
            const f32x4 g2 = *(const f32x4*)(gp + 4 * k4);
            f32x4 xv = *(const f32x4*)(orow + 4 * k4);
#pragma unroll
            for (int k = 0; k < 4; ++k) xv[k] += g2[k] * acc[2 * k4 + (k >> 1)][k & 1];
            *(f32x4*)(orow + 4 * k4) = xv;
        }
    }
}


DI void phase10_fp4(const Args& a) {
    const int tid = otid(), lane = tid & 63, wave = tid >> 6;
    const int gw = blockIdx.x * NWAVES + wave, NGW = gridDim.x * NWAVES;
    const unsigned char* PU = a.ws + WS_PU; const unsigned char* PV = a.ws + WS_PV; const unsigned char* PUE = a.ws + WS_PUE; const unsigned char* PVE = a.ws + WS_PVE;
    const float* mod = (const float*)(a.ws + WS_CTL) + CW_MOD;
    (void)gw;
    for (int ri = 0; ri < (T + NGW - 1) / NGW; ++ri) {
        const int m = affine_row(blockIdx.x, wave, ri, gridDim.x);
        if (m >= T) break;
        const int b = m >> 14;
        const int* ids = (const int*)(a.ws + WS_IDS) + (size_t)m * NSEL; const float* gwp = (const float*)(a.ws + WS_GW) + (size_t)m * NSEL;
        const int idA = ids[lane], idB = ids[64 + lane];
        const float gA = gwp[lane], gB = gwp[64 + lane];
        const bf16_t* hrow = (const bf16_t*)(a.ws + WS_H2B) + (size_t)m * D + 32 * lane;
        f32x2 hf[16];
#pragma unroll
        for (int q = 0; q < 4; ++q) { const u32x4 t4 = *(const u32x4*)(hrow + 8 * q);
#pragma unroll
            for (int z = 0; z < 4; ++z) { const unsigned pw = t4[z]; hf[4 * q + z] = (f32x2){bflo(pw), bfhi(pw)}; } }
        float cf[4];
#pragma unroll
        for (int bt = 0; bt < 4; ++bt) {
            float part[32];
#pragma unroll
            for (int i0 = 0; i0 < 32; i0 += EPB) {
                u32x4 uw[EPB]; unsigned ue[EPB];
#pragma unroll
                for (int i = 0; i < EPB; ++i) {
                    const int id = __builtin_amdgcn_readlane(bt < 2 ? idA : idB, (bt & 1) * 32 + i0 + i);
                    uw[i] = *(const u32x4*)(PU + (size_t)id * ROWB4 + 16 * lane); ue[i] = PUE[(size_t)id * 64 + lane];
                }
#pragma unroll
                for (int i = 0; i < EPB; ++i) {
                    f32x2 s2 = (f32x2){0.f, 0.f};
#pragma unroll
                    for (int d = 0; d < 4; ++d) { f32x2 r[4]; const unsigned wd = uw[i][d]; fp4_unpack8(wd, r);
#pragma unroll
                        for (int z = 0; z < 4; ++z) s2 = __builtin_elementwise_fma(hf[4 * d + z], r[z], s2); }
                    part[i0 + i] = (s2[0] + s2[1]) * __uint_as_float(ue[i] << 23);
                }
                __builtin_amdgcn_sched_barrier(0);
            }
            float p16[16], p8[8], p4[4], p2[2], p1;
            { const bool hi = lane & 32;
#pragma unroll
              for (int i = 0; i < 16; ++i) { const float snd = hi ? part[i] : part[i + 16], kp = hi ? part[i + 16] : part[i]; p16[i] = kp + __shfl_xor(snd, 32); } }
            { const bool hi = lane & 16;
#pragma unroll
              for (int i = 0; i < 8; ++i) { const float snd = hi ? p16[i] : p16[i + 8], kp = hi ? p16[i + 8] : p16[i]; p8[i] = kp + __shfl_xor(snd, 16); } }
            { const bool hi = lane & 8;
#pragma unroll
              for (int i = 0; i < 4; ++i) { const float snd = hi ? p8[i] : p8[i + 4], kp = hi ? p8[i + 4] : p8[i]; p4[i] = kp + __shfl_xor(snd, 8); } }
            { const bool hi = lane & 4;
#pragma unroll
              for (int i = 0; i < 2; ++i) { const float snd = hi ? p4[i] : p4[i + 2], kp = hi ? p4[i + 2] : p4[i]; p2[i] = kp + __shfl_xor(snd, 4); } }
            { const bool hi = lane & 2; const float snd = hi ? p2[0] : p2[1], kp = hi ? p2[1] : p2[0]; p1 = kp + __shfl_xor(snd, 2); }
            p1 += __shfl_xor(p1, 1);
            const float g = __shfl(bt < 2 ? gA : gB, (bt & 1) * 32 + (lane >> 1));
            cf[bt] = geluf_(p1) * g;
        }
        f32x2 acc[16];
#pragma unroll
        for (int k = 0; k < 16; ++k) acc[k] = (f32x2){0.f, 0.f};
#pragma unroll
        for (int bt = 0; bt < 4; ++bt) {
#pragma unroll 1
            for (int i0 = 0; i0 < 32; i0 += EPB2) {
                __builtin_amdgcn_sched_barrier(0);
                u32x4 vw[EPB2]; unsigned ve[EPB2]; float cs[EPB2];
#pragma unroll
                for (int i = 0; i < EPB2; ++i) {
                    const int id = __builtin_amdgcn_readlane(bt < 2 ? idA : idB, (bt & 1) * 32 + i0 + i);
                    cs[i] = __uint_as_float((unsigned)__builtin_amdgcn_readlane((int)__float_as_uint(cf[bt]), 2 * (i0 + i)));
                    vw[i] = *(const u32x4*)(PV + (size_t)id * ROWB4 + 16 * lane); ve[i] = PVE[(size_t)id * 64 + lane];
                }
#pragma unroll
                for (int i = 0; i < EPB2; ++i) {
                    const float cl = cs[i] * __uint_as_float(ve[i] << 23);
                    const f32x2 c2 = (f32x2){cl, cl};
#pragma unroll
                    for (int d = 0; d < 4; ++d) { f32x2 r[4]; const unsigned wd = vw[i][d]; fp4_unpack8(wd, r);
#pragma unroll
                        for (int z = 0; z < 4; ++z) acc[4 * d + z] = __builtin_elementwise_fma(c2, r[z], acc[4 * d + z]); }
                }
            }
        }
        float* orow = a.out + (size_t)m * D + 32 * lane;
        const float* gp = mod + b * NMOD + 5 * D + 32 * lane;
#pragma unroll
        for (int k4 = 0; k4 < 8; ++k4) {
            const f32x4 g2 = *(const f32x4*)(gp + 4 * k4);
            f32x4 xv = *(const f32x4*)(orow + 4 * k4);
#pragma unroll
            for (int k = 0; k < 4; ++k) xv[k] += g2[k] * acc[2 * k4 + (k >> 1)][k & 1];
            *(f32x4*)(orow + 4 * k4) = xv;
        }
    }
}

constexpr size_t WS_SP = WS_GATES + 128 * MiB;
constexpr size_t WS_CF = WS_U;
struct SliceMap { int NS, grp, wv, nwv; };
DI SliceMap slice_map(int blk, int wave, int G) {
    SliceMap s; s.NS = G < 8 ? G : 8; s.grp = blk % s.NS; s.wv = (blk / s.NS) * NWAVES + wave; s.nwv = ((G - s.grp + s.NS - 1) / s.NS) * NWAVES; return s;
}
template <int CTRL> DI float dppf(float x) { return __builtin_bit_cast(float, __builtin_amdgcn_mov_dpp(__builtin_bit_cast(int, x), CTRL, 0xf, 0xf, true)); }
constexpr int DPP_XOR1 = 0xB1, DPP_XOR2 = 0x4E, DPP_MIR8 = 0x141, DPP_XOR8 = 0x128;
DI void hdigits_pass(const Args& a) {
    const int tid = otid(), lane = tid & 63, wave = tid >> 6;
    const int NGW = gridDim.x * NWAVES;
    for (int ri = 0; ri < (T + NGW - 1) / NGW; ++ri) {
        const int m = affine_row(blockIdx.x, wave, ri, gridDim.x);
        if (m >= T) break;
        const bf16_t* hrow = (const bf16_t*)(a.ws + WS_H2B) + (size_t)m * D + 32 * lane;
        u32x4 t4[4]; float mx = 0.f;
#pragma unroll
        for (int q = 0; q < 4; ++q) { t4[q] = *(const u32x4*)(hrow + 8 * q);
#pragma unroll
            for (int z = 0; z < 4; ++z) mx = fmaxf(mx, fmaxf(fabsf(bflo(t4[q][z])), fabsf(bfhi(t4[q][z])))); }
        mx = fmaxf(mx, dppf<DPP_XOR1>(mx)); mx = fmaxf(mx, dppf<DPP_XOR2>(mx)); mx = fmaxf(mx, dppf<DPP_MIR8>(mx));
        const float step = mx * (1.0f / 119.0f), S = mx > 0.f ? 119.0f / mx : 0.f;
        unsigned p0[4], p1[4];
#pragma unroll
        for (int d = 0; d < 4; ++d) {
            unsigned a0 = 0u, a1 = 0u;
#pragma unroll
            for (int e = 0; e < 8; ++e) {
                const unsigned pw = t4[d][e >> 1]; const float x = (e & 1) ? bfhi(pw) : bflo(pw);
                const int q = (int)rintf(x * S), q1 = (q + 8) >> 4;
                a0 |= ((unsigned)q & 15u) << (4 * e); a1 |= ((unsigned)q1 & 15u) << (4 * e);
            }
            p0[d] = a0; p1[d] = a1;
        }
        u32x4* dst = (u32x4*)(a.ws + WS_H4) + ((size_t)m * 64 + lane) * 2;
        dst[0] = (u32x4){p0[0], p0[1], p0[2], p0[3]}; dst[1] = (u32x4){p1[0], p1[1], p1[2], p1[3]};
        if ((lane & 7) == 0) ((float*)(a.ws + WS_HS))[(size_t)m * 8 + (lane >> 3)] = step;
    }
}
DI void p10a_issue(const unsigned char* pu, LAS unsigned char* lds, int idv, int gl, unsigned lo16, unsigned lo1, u32x4 (&uw)[8], unsigned (&uc)[8]) {
#pragma unroll
    for (int j = 0; j < 8; ++j) {
        const unsigned id = (unsigned)__shfl(idv, gl | j);
        uw[j] = *(const u32x4*)(pu + ((id << 10) + lo16)); uc[j] = lds[(id << 3) + lo1];
    }
}
DI float p10a_math(const u32x4 (&uw)[8], const unsigned (&uc)[8], LAS unsigned char* lds, const u32x4& c0, const u32x4& c1, int i) {
    float o = 0.f;
    float us[8];
#pragma unroll
    for (int j = 0; j < 8; ++j) us[j] = ((LAS float*)(lds + NEXP * 8))[uc[j]];
#pragma unroll
    for (int j = 0; j < 8; ++j) {
        int acc;
        asm("v_dot8_i32_i4 %0, %1, %2, 0" : "=v"(acc) : "v"(uw[j][0]), "v"(c1[0]));
#pragma unroll
        for (int d = 1; d < 4; ++d) acc = __builtin_amdgcn_sdot8((int)uw[j][d], (int)c1[d], acc, false);
        acc <<= 4;
#pragma unroll
        for (int d = 0; d < 4; ++d) acc = __builtin_amdgcn_sdot8((int)uw[j][d], (int)c0[d], acc, false);
        float v = (float)acc * us[j];
        asm("" : "+v"(v));
        v += dppf<DPP_XOR1>(v); v += dppf<DPP_XOR2>(v); v += dppf<DPP_MIR8>(v);
        o = (i == j) ? v : o;
    }
    return o;
}
DI void phase10a_u4(const Args& a, LAS unsigned char* lds) {
    const int tid = otid(), lane = tid & 63, wave = tid >> 6;
    const SliceMap sm = slice_map(blockIdx.x, wave, gridDim.x);
    const int g = lane >> 3, i = lane & 7, gl = lane & 56;
    const unsigned lo16 = 16u * i, lo1 = (unsigned)i;
    for (int x = sm.grp; x < 8; x += sm.NS) {
        const unsigned char* pu = a.ws + WS_PU + 128 * x;
        {
            __syncthreads();
            const u32x4* s4 = (const u32x4*)(a.ws + WS_PUS4 + (size_t)x * (NEXP * 8));
            for (int q = tid; q < NEXP * 8 / 16; q += NTHREADS) *(LAS u32x4*)(lds + 16 * q) = s4[q];
            if (tid < 256) ((LAS float*)(lds + NEXP * 8))[tid] = u4_step(tid);
            __syncthreads();
        }
        bf16_t* sp = (bf16_t*)(a.ws + WS_SP) + (size_t)x * T * NSEL + 16 * g + i;
        const unsigned short* idb = (const unsigned short*)(a.ws + WS_IDS) + 16 * g + i;
        const u32x4* h4 = (const u32x4*)(a.ws + WS_H4) + (size_t)(8 * x + i) * 2;
        const float* hsb = (const float*)(a.ws + WS_HS) + x;
        int t = sm.wv;
        if (t >= T) continue;
        int idlo = idb[(size_t)t * NSEL], idhi = idb[(size_t)t * NSEL + 8];
        u32x4 hp0 = h4[(size_t)t * 128], hp1 = h4[(size_t)t * 128 + 1];
        float hs = hsb[(size_t)t * 8];
        u32x4 uwA[8], uwB[8]; unsigned usA[8], usB[8];
        p10a_issue(pu, lds, idlo, gl, lo16, lo1, uwA, usA);
#pragma unroll 1
        for (; t < T; t += sm.nwv) {
            __builtin_amdgcn_sched_barrier(0);
            const u32x4 c0 = hp0, c1 = hp1; const float chs = hs; const int cidhi = idhi;
            {   const int tn = (t + sm.nwv < T) ? t + sm.nwv : t;
                idlo = idb[(size_t)tn * NSEL]; idhi = idb[(size_t)tn * NSEL + 8];
                hp0 = h4[(size_t)tn * 128]; hp1 = h4[(size_t)tn * 128 + 1]; hs = hsb[(size_t)tn * 8];
            }
            p10a_issue(pu, lds, cidhi, gl, lo16, lo1, uwB, usB);
            __builtin_amdgcn_sched_barrier(0);
            const float olo = p10a_math(uwA, usA, lds, c0, c1, i);
            __builtin_amdgcn_sched_barrier(0);
            p10a_issue(pu, lds, idlo, gl, lo16, lo1, uwA, usA);
            __builtin_amdgcn_sched_barrier(0);
            const float ohi = p10a_math(uwB, usB, lds, c0, c1, i);
            { const unsigned pw = pk2(olo * chs, ohi * chs); sp[(size_t)t * NSEL] = (bf16_t)(pw & 0xffffu); sp[(size_t)t * NSEL + 8] = (bf16_t)(pw >> 16); }
        }
    }
}
DI void phase10a_fp4(const Args& a) {
    const int tid = otid(), lane = tid & 63, wave = tid >> 6;
    const SliceMap sm = slice_map(blockIdx.x, wave, gridDim.x);
    const int g = lane >> 3, i = lane & 7, gl = lane & 56;
    for (int x = sm.grp; x < 8; x += sm.NS) {
        const unsigned char* pu = a.ws + WS_PU + 128 * x + 16 * i; const unsigned char* pe = a.ws + WS_PUE + 8 * x + i;
        float* sp = (float*)(a.ws + WS_SP) + (size_t)x * T * NSEL + 16 * g + i;
        const int* idb = (const int*)(a.ws + WS_IDS) + 16 * g + i;
        const bf16_t* hb = (const bf16_t*)(a.ws + WS_H2B) + 256 * x + 32 * i;
        int t = sm.wv;
        if (t >= T) continue;
        int idlo = idb[(size_t)t * NSEL], idhi = idb[(size_t)t * NSEL + 8];
        u32x4 hr[4];
#pragma unroll
        for (int q = 0; q < 4; ++q) hr[q] = *(const u32x4*)(hb + (size_t)t * D + 8 * q);
#pragma unroll 1
        for (; t < T; t += sm.nwv) {
            __builtin_amdgcn_sched_barrier(0);
            u32x4 uw[16]; unsigned ue[16];
#pragma unroll
            for (int j = 0; j < 16; ++j) {
                const int id = __shfl(j < 8 ? idlo : idhi, gl | (j & 7));
                uw[j] = *(const u32x4*)(pu + (size_t)id * ROWB4); ue[j] = pe[(size_t)id * 64];
            }
            f32x2 hf[16];
#pragma unroll
            for (int q = 0; q < 4; ++q) {
#pragma unroll
                for (int z = 0; z < 4; ++z) { const unsigned pw = hr[q][z]; hf[4 * q + z] = (f32x2){bflo(pw), bfhi(pw)}; } }
            {   const int tn = (t + sm.nwv < T) ? t + sm.nwv : t;
                idlo = idb[(size_t)tn * NSEL]; idhi = idb[(size_t)tn * NSEL + 8];
#pragma unroll
                for (int q = 0; q < 4; ++q) hr[q] = *(const u32x4*)(hb + (size_t)tn * D + 8 * q);
            }
            __builtin_amdgcn_sched_barrier(0);
            float olo = 0.f, ohi = 0.f;
#pragma unroll
            for (int j = 0; j < 16; ++j) {
                f32x2 s2 = (f32x2){0.f, 0.f};
#if XTRA == 2
                f32x2 s3 = (f32x2){1.f, 1.f};
#endif
#pragma unroll
                for (int d = 0; d < 4; ++d) { f32x2 r[4]; const unsigned wd = uw[j][d]; fp4_unpack8(wd, r);
#if XTRA == 1
                    { unsigned wd2 = wd; asm volatile("" : "+v"(wd2)); f32x2 r2[4]; fp4_unpack8(wd2, r2); asm volatile("" :: "v"(r2[0]), "v"(r2[1]), "v"(r2[2]), "v"(r2[3])); }
#endif
#if XTRA == 2
#pragma unroll
                    for (int z = 0; z < 4; ++z) s3 = __builtin_elementwise_fma(hf[4 * d + z], r[z], s3);
#endif
#pragma unroll
                    for (int z = 0; z < 4; ++z) s2 = __builtin_elementwise_fma(hf[4 * d + z], r[z], s2); }
#if XTRA == 2
                asm volatile("" :: "v"(s3));
#endif
                float v = (s2[0] + s2[1]) * __uint_as_float(ue[j] << 23);
                v += __shfl_xor(v, 1); v += __shfl_xor(v, 2); v += __shfl_xor(v, 4);
                if (j < 8) olo = (i == j) ? v : olo; else ohi = (i == j - 8) ? v : ohi;
            }
            sp[(size_t)t * NSEL] = olo; sp[(size_t)t * NSEL + 8] = ohi;
        }
    }
}
DI void phase10b(const Args& a) {
    const int gt = blockIdx.x * NTHREADS + otid(), NT = gridDim.x * NTHREADS;
    const u32x2* sp = (const u32x2*)(a.ws + WS_SP); const f32x4* gw = (const f32x4*)(a.ws + WS_GW); u32x2* cf = (u32x2*)(a.ws + WS_CF);
    constexpr int N4 = T * NSEL / 4;
    for (int q = gt; q < N4; q += NT) {
        f32x4 s = (f32x4){0.f, 0.f, 0.f, 0.f};
#pragma unroll
        for (int x = 0; x < 8; ++x) { const u32x2 w = sp[(size_t)x * N4 + q]; s += (f32x4){bflo(w.x), bfhi(w.x), bflo(w.y), bfhi(w.y)}; }
        const f32x4 gg = gw[q];
        f32x4 o;
#pragma unroll
        for (int k = 0; k < 4; ++k) o[k] = geluf_(s[k]) * gg[k];
        cf[q] = (u32x2){pk2(o[0], o[1]), pk2(o[2], o[3])};
    }
}
DI void phase10c_fp4(const Args& a, LAS unsigned char* lds) {
    const int tid = otid(), lane = tid & 63, wave = tid >> 6;
    const SliceMap sm = slice_map(blockIdx.x, wave, gridDim.x);
    const int g = lane >> 3, i = lane & 7, gl = lane & 56;
    const float* mod = (const float*)(a.ws + WS_CTL) + CW_MOD;
    for (int x = sm.grp; x < 8; x += sm.NS) {
        const unsigned char* pv = a.ws + WS_PV + 128 * x;
        const unsigned lo16 = 16u * i, lo1 = (unsigned)i;
        {
            __syncthreads();
            const u32x4* s4 = (const u32x4*)(a.ws + WS_PVE + (size_t)x * (NEXP * 8));
            for (int q = tid; q < NEXP * 8 / 16; q += NTHREADS) *(LAS u32x4*)(lds + 16 * q) = s4[q];
            __syncthreads();
        }
        const unsigned short* idb = (const unsigned short*)(a.ws + WS_IDS) + 16 * g + i;
        const bf16_t* cfb = (const bf16_t*)(a.ws + WS_CF) + 16 * g + i;
        const int col = 256 * x + 32 * i + 16 * ((lane >> 5) & 1) + 8 * ((lane >> 4) & 1) + 4 * ((lane >> 3) & 1);
        int t = sm.wv;
        if (t >= T) continue;
        int idlo = idb[(size_t)t * NSEL], idhi = idb[(size_t)t * NSEL + 8];
        float clo = bf2f(cfb[(size_t)t * NSEL]), chi = bf2f(cfb[(size_t)t * NSEL + 8]);
#pragma unroll 1
        for (; t < T; t += sm.nwv) {
            __builtin_amdgcn_sched_barrier(0);
            u32x4 vw[16]; unsigned ve[16]; float cs[16];
#pragma unroll
            for (int j = 0; j < 16; ++j) {
                const unsigned id = (unsigned)__shfl(j < 8 ? idlo : idhi, gl | (j & 7));
                cs[j] = __shfl(j < 8 ? clo : chi, gl | (j & 7));
                vw[j] = *(const u32x4*)(pv + ((id << 10) + lo16)); ve[j] = lds[(id << 3) + lo1];
            }
            {   const int tn = (t + sm.nwv < T) ? t + sm.nwv : t;
                idlo = idb[(size_t)tn * NSEL]; idhi = idb[(size_t)tn * NSEL + 8];
                clo = bf2f(cfb[(size_t)tn * NSEL]); chi = bf2f(cfb[(size_t)tn * NSEL + 8]);
            }
            float* orow = a.out + (size_t)t * D + col;
            const u32x2 xw = *(const u32x2*)(x1b_row(a.ws, t) + col);
            f32x4 xv = (f32x4){bflo(xw.x), bfhi(xw.x), bflo(xw.y), bfhi(xw.y)};
            const f32x4 g2 = *(const f32x4*)(mod + (t >> 14) * NMOD + 5 * D + col);
            __builtin_amdgcn_sched_barrier(0);
            f32x2 acc[16];
#pragma unroll
            for (int k = 0; k < 16; ++k) acc[k] = (f32x2){0.f, 0.f};
#pragma unroll
            for (int j = 0; j < 16; ++j) {
                const float bs = __uint_as_float(ve[j] << 23);
                const f32x2 c2 = (f32x2){cs[j], cs[j]};
#pragma unroll
                for (int d = 0; d < 4; ++d) { f32x2 r[4]; const unsigned wd = vw[j][d];
                    r[0] = __builtin_amdgcn_cvt_scalef32_pk_f32_fp4(wd, bs, 0); r[1] = __builtin_amdgcn_cvt_scalef32_pk_f32_fp4(wd, bs, 1);
                    r[2] = __builtin_amdgcn_cvt_scalef32_pk_f32_fp4(wd, bs, 2); r[3] = __builtin_amdgcn_cvt_scalef32_pk_f32_fp4(wd, bs, 3);
#pragma unroll
                    for (int z = 0; z < 4; ++z) acc[4 * d + z] = __builtin_elementwise_fma(c2, r[z], acc[4 * d + z]); }
            }
            f32x2 q8[8], q4[4], q2[2];
#pragma unroll
            for (int k = 0; k < 8; ++k) {
#pragma unroll
                for (int c = 0; c < 2; ++c) { const auto r = __builtin_amdgcn_permlane32_swap(__float_as_uint(acc[k][c]), __float_as_uint(acc[8 + k][c]), false, false);
                    q8[k][c] = __uint_as_float(r[0]) + __uint_as_float(r[1]); } }
#pragma unroll
            for (int k = 0; k < 4; ++k) {
#pragma unroll
                for (int c = 0; c < 2; ++c) { const auto r = __builtin_amdgcn_permlane16_swap(__float_as_uint(q8[k][c]), __float_as_uint(q8[4 + k][c]), false, false);
                    q4[k][c] = __uint_as_float(r[0]) + __uint_as_float(r[1]); } }
            { const bool hi = lane & 8;
#pragma unroll
              for (int k = 0; k < 2; ++k) {
#pragma unroll
                  for (int c = 0; c < 2; ++c) { const float kp = hi ? q4[2 + k][c] : q4[k][c], sd = hi ? q4[k][c] : q4[2 + k][c]; q2[k][c] = kp + dppf<DPP_XOR8>(sd); } } }
            xv[0] += g2[0] * q2[0][0]; xv[1] += g2[1] * q2[0][1]; xv[2] += g2[2] * q2[1][0]; xv[3] += g2[3] * q2[1][1];
            __builtin_nontemporal_store(xv, (f32x4*)orow);
        }
    }
}

#if DBG
DI float naive_mod(const Args& a, int b, int n) {
    float s = a.b_ada[n];
    for (int k = 0; k < D; ++k) s += siluf_(a.c[b * D + k]) * a.w_ada[(size_t)k * NMOD + n];
    return s;
}
DI void check_p0(const Args& a) {
    unsigned* ctl = (unsigned*)(a.ws + WS_CTL);
    const int gt = blockIdx.x * NTHREADS + otid();
    const float* mod = (const float*)ctl + CW_MOD;
    if (gt < 256) { const int b = gt & 1, n = (gt * 97 + 13) % NMOD; const float ref = naive_mod(a, b, n); dbg_report(ctl, 0, relerr(mod[b * NMOD + n], ref, 0.02f)); }
    else if (gt < 1280) {
        const int i = gt - 256; const unsigned h = (unsigned)i * 2654435761u;
        {   const int n = h % NPROJ, k = (h >> 13) % D; const int nsrc = n < 3072 ? n : n + 8;
            dbg_report(ctl, 1, relerr(bf2f(((const bf16_t*)(a.ws + WS_WIN))[(size_t)n * D + k]), a.w_in[(size_t)k * INW + nsrc], 1e-3f) * 0.5f); }
        {   const int n = h % D, k = (h >> 12) % SW; dbg_report(ctl, 1, relerr(bf2f(((const bf16_t*)(a.ws + WS_WSSM))[(size_t)n * SW + k]), a.w_ssm_up[(size_t)k * D + n], 1e-3f) * 0.5f); }
        {   const int n = h % D, k = (h >> 12) % AW; dbg_report(ctl, 1, relerr(bf2f(((const bf16_t*)(a.ws + WS_WATTN))[(size_t)n * AW + k]), a.w_attn_up[(size_t)k * D + n], 1e-3f) * 0.5f); }
        {   const int n = h % D, k = (h >> 12) % D; dbg_report(ctl, 1, relerr(bf2f(((const bf16_t*)(a.ws + WS_WOUT))[(size_t)n * D + k]), a.w_out[(size_t)k * D + n], 1e-3f) * 0.5f);
            dbg_report(ctl, 1, relerr(bf2f(((const bf16_t*)(a.ws + WS_WPQ))[(size_t)n * D + k]), a.w_peer_q[(size_t)k * D + n], 1e-3f) * 0.5f); }
        {   const int n = h % SW, k = (h >> 12) % SW; dbg_report(ctl, 1, relerr(bf2f(((const bf16_t*)(a.ws + WS_WGLU))[(size_t)n * SW + k]), a.w_glu[(size_t)k * SW + n], 1e-3f) * 0.5f); }
        {   const size_t e = ((size_t)h * 8191u + i) % ((size_t)NEXP * D); const int er = (int)(e >> 11), ek = (int)(e & 2047);
#if TAB4
            dbg_report(ctl, 1, relerr(fp4_at(a.ws + WS_PU + (size_t)er * ROWB4, a.ws + WS_PUE + (size_t)er * 64, ek), a.peer_u[e], 5e-2f) * 0.012f);
            dbg_report(ctl, 1, relerr(fp4_at(a.ws + WS_PV + (size_t)er * ROWB4, a.ws + WS_PVE + (size_t)er * 64, ek), a.peer_v[e], 6e-1f) * 0.012f); }
#else
            dbg_report(ctl, 1, relerr(fp6_at(a.ws + WS_PU + (size_t)er * ROWB, ek) * ((const float*)(a.ws + WS_PUS))[er], a.peer_u[e], 5e-2f) * 0.05f);
            dbg_report(ctl, 1, relerr(fp6_at(a.ws + WS_PV + (size_t)er * ROWB, ek) * ((const float*)(a.ws + WS_PVS))[er], a.peer_v[e], 6e-1f) * 0.05f); }
#endif
        {   const size_t e = (size_t)h % (16 * 128 * 128); dbg_report(ctl, 1, relerr(bf2f(((const bf16_t*)(a.ws + WS_KEYS))[e]), a.sub_keys[e], 1e-3f) * 0.5f); }
    }
}
DI void check_p1(const Args& a) {
    unsigned* ctl = (unsigned*)(a.ws + WS_CTL);
    const int tid_ = otid(); const int lane = tid_ & 63, gw = blockIdx.x * NWAVES + (tid_ >> 6);
    if (gw >= 64) return;
    const int m = (int)(((unsigned)gw * 2654435761u) % T), b = m >> 14;
    const float* mod = (const float*)ctl + CW_MOD;
    const float* xr = a.x + (size_t)m * D;
    float ss = 0.f;
    for (int k = lane; k < D; k += 64) ss += xr[k] * xr[k];
    const float r = rsqrtf(wave_sum(ss) / D + RMS_EPS);
    float f[8] = {0, 0, 0, 0, 0, 0, 0, 0};
    const bf16_t* hb = (const bf16_t*)(a.ws + WS_HB) + (size_t)m * D;
    for (int k = lane; k < D; k += 64) {
        const float sc = mod[b * NMOD + 1 * D + k], shv = mod[b * NMOD + k];
        const float h = xr[k] * r * a.norm1_w[k] * (1.0f + sc) + shv;
        dbg_report(ctl, 2, relerr(bf2f(hb[k]), h, 0.05f));
        for (int j = 0; j < 8; ++j) f[j] += h * a.w_in[(size_t)k * INW + 3072 + j];
    }
    for (int j = 0; j < 8; ++j) {
        const float z = wave_sum(f[j]) + a.b_forget[j];
        const float ref = -log1pf(expf(-z));
        if (lane == 0) dbg_report(ctl, 3, relerr(((const float*)(a.ws + WS_LF))[(size_t)m * 8 + j], ref, 0.01f));
    }
}
DI void check_p2(const Args& a) {
    unsigned* ctl = (unsigned*)(a.ws + WS_CTL);
    const int gt = blockIdx.x * NTHREADS + otid();
    if (gt >= 4096) return;
    const unsigned h = (unsigned)gt * 2654435761u;
    const int m = (h >> 7) % T, n = (h % 977 + gt * 7) % NPROJ;
    const bf16_t* hb = (const bf16_t*)(a.ws + WS_HB) + (size_t)m * D; const bf16_t* w = (const bf16_t*)(a.ws + WS_WIN) + (size_t)n * D;
    float s = 0.f;
    for (int k = 0; k < D; ++k) s += bf2f(hb[k]) * bf2f(w[k]);
    float got;
    if (n < 3072) got = bf2f(((const bf16_t*)(a.ws + WS_QKV))[(size_t)m * 3072 + n]);
    else if (n < 3584) got = bf2f(((const bf16_t*)(a.ws + WS_U))[(size_t)m * 512 + n - 3072]);
    else { got = bf2f(((const bf16_t*)(a.ws + WS_GATES))[(size_t)m * 4096 + n - 3584]); s = sigmoidf_(s); }
    dbg_report(ctl, 4, relerr(got, s, 0.05f));
}

DI void check_p3(const Args& a) {
    unsigned* ctl = (unsigned*)(a.ws + WS_CTL);
    const int tid_ = otid(); const int lane = tid_ & 63, gw = blockIdx.x * NWAVES + (tid_ >> 6);
    if (gw >= 48) return;
    const unsigned hsh = (unsigned)(gw + 1) * 2654435761u;
    const int b = gw & 1, h = (gw >> 1) & 7, t = (gw < 16) ? (gw * 37) : (int)(hsh % SEQ);
    const bf16_t* qkv = (const bf16_t*)(a.ws + WS_QKV);
    const bf16_t* vt = (const bf16_t*)(a.ws + WS_VT) + (size_t)(b * AH + h) * HD * SEQ;
    const float* Floc = (const float*)(a.ws + WS_F) + (size_t)(b * AH + h) * SEQ; const float* segt = (const float*)(a.ws + WS_CTL) + CW_SEGT + (b * AH + h) * 8;
    auto F = [&](int i) -> float { float o_ = 0.f; for (int z = 0; z < (i >> 11); ++z) o_ += segt[z]; return Floc[i] + o_; };
    float* scr = (float*)(a.ws + WS_DBGS) + (size_t)gw * SEQ;
    const size_t mrow = (size_t)b * SEQ;
    const bf16_t* qp = qkv + (mrow + t) * 3072 + h * 128;
    float mx = -1e30f;
    for (int s = lane; s <= t; s += 64) {
        const bf16_t* kp = qkv + (mrow + s) * 3072 + 1024 + h * 128;
        float d = 0.f;
        for (int k = 0; k < HD; ++k) d += bf2f(qp[k]) * bf2f(kp[k]);
        d += F(t) - F(s);
        scr[s] = d; mx = fmaxf(mx, d);
    }
    for (int o = 1; o < 64; o <<= 1) mx = fmaxf(mx, __shfl_xor(mx, o));
    float l = 0.f;
    for (int s = lane; s <= t; s += 64) { const float p = exp2f(scr[s] - mx); scr[s] = p; l += p; }
    l = wave_sum(l);
    __builtin_amdgcn_fence(__ATOMIC_RELEASE, "agent"); __builtin_amdgcn_fence(__ATOMIC_ACQUIRE, "agent");
    const bf16_t* yo = (const bf16_t*)(a.ws + WS_YATT) + (mrow + t) * AW + h * 128;
    for (int dd = 0; dd < 2; ++dd) {
        const int d = lane + 64 * dd;
        float acc = 0.f;
        for (int s = 0; s <= t; ++s) {
            const int pos = (s & ~15) + 8 * ((s >> 2) & 1) + 4 * ((s >> 3) & 1) + (s & 3);
            acc += scr[s] * bf2f(vt[((size_t)(pos >> 6) * HD + d) * 64 + (pos & 63)]);
        }
        dbg_report(ctl, 5, relerr(bf2f(yo[d]), acc / l, 0.5f));
    }
}


DI void check_p2b(const Args& a) {
    unsigned* ctl = (unsigned*)(a.ws + WS_CTL);
    const int tid_ = otid(); const int lane = tid_ & 63, gw = blockIdx.x * NWAVES + (tid_ >> 6);
    if (gw < 32) {
        const unsigned hsh = (unsigned)(gw + 3) * 2654435761u;
        const int m = 16384 + (hsh % 16384), h = (hsh >> 20) & 7, qk = gw & 1;
        const bf16_t* hb = (const bf16_t*)(a.ws + WS_HB) + (size_t)m * D;
        float raw[2], ss = 0.f;
        for (int dd = 0; dd < 2; ++dd) {
            const int d = lane + 64 * dd;
            const bf16_t* w = (const bf16_t*)(a.ws + WS_WIN) + (size_t)(qk * 1024 + h * 128 + d) * D;
            float s = 0.f;
            for (int k = 0; k < D; ++k) s += bf2f(hb[k]) * bf2f(w[k]);
            raw[dd] = s; ss += s * s;
        }
        ss = wave_sum(ss);
        const float r = rsqrtf(ss / HD + RMS_EPS);
        for (int dd = 0; dd < 2; ++dd) {
            const int d = lane + 64 * dd;
            const float ref = raw[dd] * r * (qk ? a.k_norm_w[d] : a.q_norm_w[d] * 0.08838834764831845f * LOG2E);
            dbg_report(ctl, 6, relerr(bf2f(((const bf16_t*)(a.ws + WS_QKV))[(size_t)m * 3072 + qk * 1024 + h * 128 + d]), ref, 0.05f));
        }
    } else if (gw < 48 && lane == 0) {
        const int bh = gw - 32, b = bh >> 3, h = bh & 7;
        const float* lf = (const float*)(a.ws + WS_LF); const float* F = (const float*)(a.ws + WS_F) + (size_t)bh * SEQ;
        double c = 0.0;
        const float* segt = (const float*)(a.ws + WS_CTL) + CW_SEGT + bh * 8;
        for (int s = 0; s < 3000; ++s) { c += (double)lf[((size_t)b * SEQ + s) * 8 + h]; if (s % 499 == 0) dbg_report(ctl, 7, relerr(F[s] + (s >= 2048 ? segt[0] : 0.f), (float)(c * 1.4426950408889634), 0.01f)); }
    }
}


DI void check_p456(const Args& a, int which) {
    unsigned* ctl = (unsigned*)(a.ws + WS_CTL);
    const int gt = blockIdx.x * NTHREADS + otid();
    if (gt >= 2048) return;
    const unsigned h = (unsigned)(gt + 11) * 2654435761u;
    const int m = (h >> 7) % T;
    if (which == 0) {
        const int n = h % SW;
        const bf16_t* g = (const bf16_t*)(a.ws + WS_GY) + (size_t)m * SW; const bf16_t* w = (const bf16_t*)(a.ws + WS_WGLU) + (size_t)n * SW;
        float s = a.b_glu[n];
        for (int k = 0; k < SW; ++k) s += bf2f(g[k]) * bf2f(w[k]);
        dbg_report(ctl, 8, relerr(bf2f(((const bf16_t*)(a.ws + WS_YG))[(size_t)m * SW + n]), bf2f(g[n]) * sigmoidf_(s), 0.2f));
    } else if (which == 1) {
        const int n = h % D;
        const bf16_t* yg = (const bf16_t*)(a.ws + WS_YG) + (size_t)m * SW; const bf16_t* w1 = (const bf16_t*)(a.ws + WS_WSSM) + (size_t)n * SW;
        const bf16_t* ya = (const bf16_t*)(a.ws + WS_YATT) + (size_t)m * AW; const bf16_t* w2 = (const bf16_t*)(a.ws + WS_WATTN) + (size_t)n * AW;
        float s1 = 0.f, s2 = 0.f;
        for (int k = 0; k < SW; ++k) s1 += bf2f(yg[k]) * bf2f(w1[k]);
        for (int k = 0; k < AW; ++k) s2 += bf2f(ya[k]) * bf2f(w2[k]);
        const bf16_t* gt_ = (const bf16_t*)(a.ws + WS_GATES) + (size_t)m * 4096;
        const float ref = bf2f(gt_[n]) * s1 + bf2f(gt_[2048 + n]) * s2;
        dbg_report(ctl, 9, relerr(bf2f(((const bf16_t*)(a.ws + WS_MRG))[(size_t)m * D + n]), ref, 0.3f));
    } else {
        const int n = h % D, b = m >> 14;
        const bf16_t* mr = (const bf16_t*)(a.ws + WS_MRG) + (size_t)m * D; const bf16_t* w = (const bf16_t*)(a.ws + WS_WOUT) + (size_t)n * D;
        float s = 0.f;
        for (int k = 0; k < D; ++k) s += bf2f(mr[k]) * bf2f(w[k]);
        const float g1 = ((const float*)ctl + CW_MOD)[b * NMOD + 2 * D + n];
        dbg_report(ctl, 10, relerr(a.out[(size_t)m * D + n], a.x[(size_t)m * D + n] + g1 * s, 1.0f) * 10.f);
    }
}


DI void check_p8(const Args& a) {
    unsigned* ctl = (unsigned*)(a.ws + WS_CTL);
    const int gt = blockIdx.x * NTHREADS + otid();
    if (gt >= 2048) return;
    const unsigned h = (unsigned)(gt + 5) * 2654435761u;
    const int m = (h >> 7) % T, n = h % D;
    const bf16_t* hr = (const bf16_t*)(a.ws + WS_H2B) + (size_t)m * D; const bf16_t* w = (const bf16_t*)(a.ws + WS_WPQ) + (size_t)n * D;
    float s = 0.f;
    for (int k = 0; k < D; ++k) s += bf2f(hr[k]) * bf2f(w[k]);
    dbg_report(ctl, 11, relerr(bf2f(((const bf16_t*)(a.ws + WS_QP))[(size_t)m * D + n]), s, 0.3f));
}
DI void check_p9(const Args& a) {
    unsigned* ctl = (unsigned*)(a.ws + WS_CTL);
    const int tid_ = otid(); const int lane = tid_ & 63, gw = blockIdx.x * NWAVES + (tid_ >> 6);
    if (gw >= 64) return;
    const unsigned hsh = (unsigned)(gw + 7) * 2654435761u;
    const int m = (hsh >> 5) % T, h = gw & 7;
    const bf16_t* qp = (const bf16_t*)(a.ws + WS_QP) + (size_t)m * D + h * 256;
    const bf16_t* keys = (const bf16_t*)(a.ws + WS_KEYS) + (size_t)h * 2 * NKEYS * 128;
    float* scr = (float*)(a.ws + WS_DBGS) + (size_t)gw * 256;
    for (int r = lane; r < 256; r += 64) {
        const int p = r >> 7; float s = 0.f;
        for (int k = 0; k < 128; ++k) s += bf2f(qp[p * 128 + k]) * bf2f(keys[(size_t)r * 128 + k]);
        scr[r] = s;
    }
    __builtin_amdgcn_fence(__ATOMIC_RELEASE, "agent"); __builtin_amdgcn_fence(__ATOMIC_ACQUIRE, "agent");
    const int* ids = (const int*)(a.ws + WS_IDS) + (size_t)m * NSEL + h * 16; const float* gwp = (const float*)(a.ws + WS_GW) + (size_t)m * NSEL + h * 16;
    float tv[16]; int te[16]; unsigned long long takenlo[4] = {0, 0, 0, 0};
    for (int r = 0; r < 16; ++r) {
        float best = -1e30f; int be = -1;
        for (int c = 0; c < 256; ++c) { const int e = lane * 256 + c; if ((takenlo[c >> 6] >> (c & 63)) & 1ull) continue; const float v = scr[e >> 7] + scr[128 + (e & 127)]; if (v > best) { best = v; be = e; } }
        float wb = best; for (int o = 1; o < 64; o <<= 1) wb = fmaxf(wb, __shfl_xor(wb, o));
        const unsigned long long bal = __ballot(best == wb); const int wl = __ffsll((long long)bal) - 1;
        const int we = __shfl(be, wl);
        if (lane == wl) { const int c = we - lane * 256; takenlo[c >> 6] |= 1ull << (c & 63); }
        tv[r] = wb; te[r] = we;
    }
    float es = 0.f; for (int r = 0; r < 16; ++r) es += expf(tv[r] - tv[0]);
    float err = 0.f;
    for (int r = 0; r < 16; ++r) {
        bool found = false;
        for (int k = 0; k < 16; ++k) if (ids[k] == te[r]) { found = true; err += fabsf(gwp[k] - expf(tv[r] - tv[0]) / es); }
        if (!found) err += expf(tv[r] - tv[0]) / es;
    }
    if (lane == 0) dbg_report(ctl, 12, err);
}
DI void check_p10(const Args& a) {
    unsigned* ctl = (unsigned*)(a.ws + WS_CTL);
    const int tid_ = otid(); const int lane = tid_ & 63, gw = blockIdx.x * NWAVES + (tid_ >> 6);
    if (gw >= 32) return;
    const unsigned hsh = (unsigned)(gw + 17) * 2654435761u;
    const int m = (hsh >> 5) % T, b = m >> 14;
    const bf16_t* hrow = (const bf16_t*)(a.ws + WS_H2B) + (size_t)m * D;
    const int* ids = (const int*)(a.ws + WS_IDS) + (size_t)m * NSEL; const float* gwp = (const float*)(a.ws + WS_GW) + (size_t)m * NSEL;
    const unsigned char* PU = a.ws + WS_PU; const unsigned char* PV = a.ws + WS_PV;
    float* scr = (float*)(a.ws + WS_DBGS) + 65536 + (size_t)gw * 128;
    for (int e = 0; e < NSEL; ++e) {
        float s = 0.f;
#if TAB4
        for (int k = lane; k < D; k += 64) s += bf2f(hrow[k]) * fp4_at(PU + (size_t)ids[e] * ROWB4, a.ws + WS_PUE + (size_t)ids[e] * 64, k);
        s = wave_sum(s);
        if (lane == 0) scr[e] = geluf_(s) * gwp[e];
#else
        for (int k = lane; k < D; k += 64) s += bf2f(hrow[k]) * fp6_at(PU + (size_t)ids[e] * ROWB, k);
        s = wave_sum(s) * ((const float*)(a.ws + WS_PUS))[ids[e]];
        if (lane == 0) scr[e] = geluf_(s) * gwp[e] * ((const float*)(a.ws + WS_PVS))[ids[e]];
#endif
    }
    __builtin_amdgcn_fence(__ATOMIC_RELEASE, "agent"); __builtin_amdgcn_fence(__ATOMIC_ACQUIRE, "agent");
    const float* mod = (const float*)ctl + CW_MOD;
    for (int c = 0; c < 8; ++c) {
        const int n = (hsh >> (c + 2)) % D;
        float pe = 0.f;
#if TAB4
        for (int e = lane; e < NSEL; e += 64) pe += scr[e] * fp4_at(PV + (size_t)ids[e] * ROWB4, a.ws + WS_PVE + (size_t)ids[e] * 64, n);
#else
        for (int e = lane; e < NSEL; e += 64) pe += scr[e] * fp6_at(PV + (size_t)ids[e] * ROWB, n);
#endif
        pe = wave_sum(pe);
        const bf16_t* mr = (const bf16_t*)(a.ws + WS_MRG) + (size_t)m * D; const bf16_t* w = (const bf16_t*)(a.ws + WS_WOUT) + (size_t)n * D;
        float s = 0.f;
        for (int k = lane; k < D; k += 64) s += bf2f(mr[k]) * bf2f(w[k]);
        s = wave_sum(s);
        const float g1 = mod[b * NMOD + 2 * D + n], g2 = mod[b * NMOD + 5 * D + n];
        const float ref = a.x[(size_t)m * D + n] + g1 * s + g2 * pe;
        if (lane == 0) dbg_report(ctl, 13, relerr(a.out[(size_t)m * D + n], ref, 1.0f) * 10.f);
    }
}


DI void check_fp6(const Args& a) {
    unsigned* ctl = (unsigned*)(a.ws + WS_CTL);
    if (blockIdx.x != 0 || otid() >= 64) return;
    bool ok = true;
#pragma unroll 1
    for (int rnd = 0; rnd < 2; ++rnd) {
        float e[32];
#pragma unroll
        for (int i = 0; i < 32; ++i) { const int c = (i * 7 + 3) & 31;
            const float mag = c < 16 ? 0.125f * c : (c < 24 ? 2.0f + 0.25f * (c - 16) : 4.0f + 0.5f * (c - 24));
            e[i] = (rnd ^ (i & 1)) ? -mag : mag; }
        const v6u w = fp6_pack_sw(e);
        const v32f r = fp6_unpack_f32(w);
#pragma unroll
        for (int i = 0; i < 32; ++i) ok = ok && (r[i] == e[i]);
    }
    dbg_report(ctl, 14, ok ? 1.f : 2.f);
}

__constant__ float dbg_tol[16] = {1e-3f, 4e-3f, 1e-2f, 1e-3f, 2e-2f, 2e-2f, 2e-2f, 2e-2f, 2e-2f, 2e-2f, 2e-2f, 2e-2f, 1e-1f, 2e-2f, 2e-2f, 2e-2f};
#endif


#define XB_TMO      128
#define XB_XCNT(j)  (256  + 64 * (j))
#define XB_XSUB(j)  (1280 + 64 * (j))
#define XB_XGEN(j)  (2304 + 64 * (j))
#define XB_TOP      3328
#define XB_TOPGEN   3392
#define XCD_BAR_WORDS 3456
#define XB_SPIN_CAP (1u << 18)
constexpr int CW_BAR = 4096;
DI unsigned xb_ld(unsigned* p)              { return __hip_atomic_load(p, __ATOMIC_RELAXED, __HIP_MEMORY_SCOPE_AGENT); }
DI unsigned xb_add(unsigned* p, unsigned v) { return __hip_atomic_fetch_add(p, v, __ATOMIC_RELAXED, __HIP_MEMORY_SCOPE_AGENT); }
DI unsigned xb_xcc_id() { return (unsigned)__builtin_amdgcn_s_getreg((3 << 11) | 20) & 0xFu; }
#define XB_SPIN(cond, bar) do { unsigned _sp = 0; while (cond) { __builtin_amdgcn_s_sleep(1); \
    if ((++_sp & 255u) == 0u) { if (xb_ld(&(bar)[XB_TMO])) break; if (_sp > XB_SPIN_CAP) { atomicAdd(&(bar)[XB_TMO], 1u); break; } } } } while (0)
struct XcdBarrier { unsigned* bar; unsigned x; volatile LAS unsigned* st; };
DI XcdBarrier xcd_barrier_post(unsigned* bar, volatile LAS unsigned* st) {
    XcdBarrier b; b.bar = bar; b.x = xb_xcc_id(); b.st = st;
    if (threadIdx.x == 0) (void)xb_add(&bar[XB_XCNT(b.x)], 1u);
    return b;
}
DI void xcd_barrier_complete(unsigned* bar, unsigned x, unsigned& nloc, unsigned& nx) {
    const unsigned G = gridDim.x * gridDim.y * gridDim.z;
    unsigned sum, cnt, mine, sp = 0u;
    for (;;) {
        sum = 0u; cnt = 0u; mine = 0u;
#pragma unroll
        for (unsigned j = 0; j < 16; ++j) { const unsigned c = xb_ld(&bar[XB_XCNT(j)]); sum += c; cnt += (c > 0u) ? 1u : 0u; mine = (j == x) ? c : mine; }
        if (sum == G) break;
        __builtin_amdgcn_s_sleep(1);
        if ((++sp & 255u) == 0u) { if (xb_ld(&bar[XB_TMO])) break; if (sp > XB_SPIN_CAP) { atomicAdd(&bar[XB_TMO], 1u); break; } }
    }
    nloc = mine > 0u ? mine : 1u; nx = cnt > 0u ? cnt : 1u;
}
#ifndef BAR_SCOPE
#define BAR_SCOPE ""
#endif
DI void xcd_barrier(const XcdBarrier& b) {
    asm volatile("s_waitcnt vmcnt(0)" ::: "memory");
    __syncthreads();
    if (threadIdx.x == 0) {
        unsigned* bar = b.bar;
        __builtin_amdgcn_s_waitcnt(0);
        unsigned nloc = b.st[0], nx = b.st[1];
        if (nloc == 0u) { xcd_barrier_complete(bar, b.x, nloc, nx); b.st[0] = nloc; b.st[1] = nx; }
        const unsigned old = xb_add(&bar[XB_XSUB(b.x)], 1u);
        const unsigned gen = old / nloc;
        if (old + 1u == (gen + 1u) * nloc) {
            __builtin_amdgcn_fence(__ATOMIC_RELEASE, BAR_SCOPE);
            asm volatile("s_waitcnt vmcnt(0)" ::: "memory");
            const unsigned og = xb_add(&bar[XB_TOP], 1u);
            const unsigned tg = og / nx;
            if (og + 1u == (tg + 1u) * nx) xb_add(&bar[XB_TOPGEN], 1u);
            else XB_SPIN(xb_ld(&bar[XB_TOPGEN]) == tg, bar);
            __builtin_amdgcn_fence(__ATOMIC_ACQUIRE, BAR_SCOPE);
            xb_add(&bar[XB_XGEN(b.x)], 1u);
            asm volatile("s_waitcnt vmcnt(0)" ::: "memory");
        } else {
            XB_SPIN(xb_ld(&bar[XB_XGEN(b.x)]) == gen, bar);
            __builtin_amdgcn_fence(__ATOMIC_ACQUIRE, BAR_SCOPE);
            asm volatile("s_waitcnt vmcnt(0)" ::: "memory");
        }
    }
    __syncthreads();
}


#ifndef TUNIT
#define TUNIT 50000
#endif
#ifndef TIMING
#define TIMING 0
#endif
__global__ void __launch_bounds__(NTHREADS, 2) mk_fwd(Args a) {
    extern __shared__ __attribute__((aligned(16))) unsigned char lds_raw[];
    LAS unsigned char* lds = (LAS unsigned char*)lds_raw;
    cg::grid_group grid = cg::this_grid();
    const int G = gridDim.x, blk = blockIdx.x;
    unsigned char* ws = a.ws;
    unsigned* ctl = (unsigned*)(ws + WS_CTL);
    unsigned long long* ts = (unsigned long long*)(ctl + 512);
#define STAMP(k) do { if (TIMING && blk == 0 && threadIdx.x == 0) ts[k] = __builtin_amdgcn_s_memrealtime(); } while (0)
#ifndef USE_XB
#define USE_XB 1
#endif
#define SYNC(k) do { if (USE_XB && (k) != 1) xcd_barrier(xbar); else { grid.sync(); if (threadIdx.x == 0) { __builtin_amdgcn_fence(__ATOMIC_ACQUIRE, BAR_SCOPE); asm volatile("s_waitcnt vmcnt(0)" ::: "memory"); } __syncthreads(); } STAMP(k); } while (0)
#if DBG
#define CHECK(stop, call) do { if (DBG_STOP > (stop)) call; grid.sync(); } while (0)
#else
#define CHECK(stop, call) do { } while (0)
#endif
    volatile LAS unsigned* xst = (volatile LAS unsigned*)(lds + LDS_BYTES - 64);
    if (threadIdx.x < 2) xst[threadIdx.x] = 0u;
    __syncthreads();
    XcdBarrier xbar = xcd_barrier_post(ctl + CW_BAR, xst);
    STAMP(0);
    phase0(a, lds);
    s5_tables_p0(a);
    SYNC(1);
#if DUP == 1
    phase0(a, lds); s5_tables_p0(a); SYNC(15);
#endif
    CHECK(0, check_p0(a));
    CHECK(0, check_fp6(a));
    if (DBG_STOP > 1) { s5_tables_p1(a); row_pass<true>(a, lds, a.x, a.norm1_w, 0, 1, (bf16_t*)(ws + WS_HB)); }
    SYNC(2);
#if DUP == 2
    s5_tables_p1(a); row_pass<true>(a, lds, a.x, a.norm1_w, 0, 1, (bf16_t*)(ws + WS_HB)); SYNC(15);
#endif
    CHECK(1, check_p1(a));
    if (DBG_STOP > 2) {
        pg8::Gemm g{(const bf16_t*)(ws + WS_HB), (const bf16_t*)(ws + WS_WIN), T, NPROJ, D};
        pg8::StaticOrder S; S.init(T, NPROJ, G, blk);
        EpiProj E{(bf16_t*)(ws + WS_QKV), (bf16_t*)(ws + WS_U), ws + WS_GATES};
        pg8::gemm_phase<EpiProj, pg8::StaticOrder, G_ALIGN, G_SP2>(lds, g, S, E);
    }
    SYNC(3);
    CHECK(2, check_p2(a));
    if (DBG_STOP > 3) phase2b(a, lds);
    SYNC(4);
    CHECK(3, check_p2b(a));
    if (DBG_STOP > 4) phase3(a, lds);
    SYNC(5);
    CHECK(4, check_p3(a));
    if (DBG_STOP > 5) {
        pg8::Gemm g{(const bf16_t*)(ws + WS_GY), (const bf16_t*)(ws + WS_WGLU), T, SW, SW};
        pg8::StaticOrder S; S.init(T, SW, G, blk);
        EpiGlu E{(const bf16_t*)(ws + WS_GY), a.b_glu, (bf16_t*)(ws + WS_YG)};
        pg8::gemm_phase<EpiGlu, pg8::StaticOrder, G_ALIGN, G_SP2>(lds, g, S, E);
    }
    SYNC(6);
    CHECK(5, check_p456(a, 0));
    for (int dup = 0; dup < (DUP == 5 ? 2 : 1); ++dup) {
        if (dup) SYNC(15);
        { pg8::Gemm g{(const bf16_t*)(ws + WS_YG), (const bf16_t*)(ws + WS_WSSM), T, D, SW};
          pg8::StaticOrder S; S.init(T, D, G, blk);
          EpiSsmUp E{ws + WS_GATES, (bf16_t*)(ws + WS_MRG)};
          pg8::gemm_phase<EpiSsmUp, pg8::StaticOrder, G_ALIGN, G_SP2>(lds, g, S, E); }
        { pg8::Gemm g{(const bf16_t*)(ws + WS_YATT), (const bf16_t*)(ws + WS_WATTN), T, D, AW};
          pg8::StaticOrder S; S.init(T, D, G, blk);
          EpiAttnUp E{ws + WS_GATES, (bf16_t*)(ws + WS_MRG)};
          pg8::gemm_phase<EpiAttnUp, pg8::StaticOrder, G_ALIGN, G_SP2>(lds, g, S, E); }
    }
    SYNC(7);
    CHECK(6, check_p456(a, 1));
    if (DBG_STOP > 7) {
        pg8::Gemm g{(const bf16_t*)(ws + WS_MRG), (const bf16_t*)(ws + WS_WOUT), T, D, D};
        pg8::StaticOrder S; S.init(T, D, G, blk);
        EpiOut E{a.x, (const float*)ctl + CW_MOD, a.b_ada, ws};
        pg8::gemm_phase<EpiOut, pg8::StaticOrder, G_ALIGN, G_SP2>(lds, g, S, E);
    }
    SYNC(8);
    CHECK(7, check_p456(a, 2));
    if (DBG_STOP > 8) row_pass<false, true>(a, lds, nullptr, a.norm2_w, 3, 4, (bf16_t*)(ws + WS_H2B));
    SYNC(9);
    if (DBG_STOP > 9) {
        pg8::Gemm g{(const bf16_t*)(ws + WS_H2B), (const bf16_t*)(ws + WS_WPQ), T, D, D};
        pg8::StaticOrder S; S.init(T, D, G, blk);
        EpiPlain E{(bf16_t*)(ws + WS_QP), D};
        pg8::gemm_phase<EpiPlain, pg8::StaticOrder, G_ALIGN, G_SP2>(lds, g, S, E);
    }
    SYNC(10);
    CHECK(9, check_p8(a));
    for (int dup = 0; dup < (DUP == 9 ? 2 : 1); ++dup) { if (dup) SYNC(15); phase9(a, lds);
#if TAB4 && P10_SLICED && U4
        hdigits_pass(a);
#endif
    }
    SYNC(11);
    CHECK(10, check_p9(a));
#if PROBE == 14
#elif TAB4 && P10_SLICED
#if U4
    if (DBG_STOP > 11) { phase10a_u4(a, lds); SYNC(13);
#if DUP == 10
        phase10a_u4(a, lds); SYNC(15);
#endif
        phase10b(a); SYNC(14);
#if DUP == 11
        phase10b(a); SYNC(15);
#endif
        phase10c_fp4(a, lds); }
#else
    if (DBG_STOP > 11) { phase10a_fp4(a); SYNC(13); phase10b(a); SYNC(14); phase10c_fp4(a, lds); }
#endif
#elif TAB4
    if (DBG_STOP > 11) phase10_fp4(a);
#else
    if (DBG_STOP > 11) phase10(a);
#endif
#if DBG || TIMING
    SYNC(12);
#endif
    CHECK(11, check_p10(a));
#if DBG
    if (DBG_STOP <= 7) {
        const f32x4* x4 = (const f32x4*)a.x; f32x4* o4 = (f32x4*)a.out;
        const size_t n4 = (size_t)T * D / 4;
        for (size_t i = (size_t)blk * NTHREADS + threadIdx.x; i < n4; i += (size_t)G * NTHREADS) o4[i] = x4[i];
    }
    grid.sync();
    {
        int code = 0;
        for (int i = 15; i >= 0; --i) { const float e = __uint_as_float(__hip_atomic_load(ctl + CW_DBG + i, __ATOMIC_RELAXED, __HIP_MEMORY_SCOPE_AGENT));
            if (e > dbg_tol[i]) { if (i >= DBG_LO && i < DBG_LO + 4) code |= 1 << (i - DBG_LO); else if (i < DBG_LO) code = 20 + i; } }
#ifdef DBG_MAG
        code = 1;
#endif
        if (code) {
#ifdef DBG_MAG
            const float s = 1.0f + fminf(__uint_as_float(__hip_atomic_load(ctl + CW_DBG + DBG_MAG, __ATOMIC_RELAXED, __HIP_MEMORY_SCOPE_AGENT)), 1000.f);
#else
            const float s = 1.0f + (float)code;
#endif
            f32x4* o4 = (f32x4*)a.out; const size_t n4 = (size_t)T * D / 4;
            for (size_t i = (size_t)blk * NTHREADS + threadIdx.x; i < n4; i += (size_t)G * NTHREADS) o4[i] = o4[i] * s;
        }
    }
#endif
#ifndef PROBE
#define PROBE 0
#endif
#if PROBE
    {
        SYNC(17);
        float* o = a.out; const size_t n = (size_t)T * D;
        for (size_t i = (size_t)blk * NTHREADS + threadIdx.x; i < n; i += (size_t)G * NTHREADS) {
            float v = 0.f;
            if (PROBE == 1) { if (i < (size_t)T * NSEL) v = ((const float*)(ws + WS_GW))[i]; }
            if (PROBE == 2) { if (i < (size_t)T * NSEL) v = (float)((const int*)(ws + WS_IDS))[i]; }
            if (PROBE == 3) { v = bf2f(((const bf16_t*)(ws + WS_H2B))[i]); }
            if (PROBE == 5) { v = bf2f(((const bf16_t*)(ws + WS_QP))[i]); }
            if (PROBE == 7) { v = bf2f(((const bf16_t*)(ws + WS_MRG))[i]); }
            if (PROBE == 8) { if (i < (size_t)T * SW) v = bf2f(((const bf16_t*)(ws + WS_GY))[i]); else if (i < (size_t)T * SW + (size_t)T * AW) v = bf2f(((const bf16_t*)(ws + WS_YATT))[i - (size_t)T * SW]); }
            if (PROBE == 9) { if (i < (size_t)T * SW) v = bf2f(((const bf16_t*)(ws + WS_YG))[i]); }
            if (PROBE == 15) { if (i < (size_t)NEXP * ROWB4 / 4) v = (float)(((const unsigned*)(ws + WS_PU))[i] >> 8); else if (i < (size_t)NEXP * ROWB4 / 2) v = (float)(((const unsigned*)(ws + WS_PV))[i - (size_t)NEXP * ROWB4 / 4] >> 8); }
            if (PROBE != 14) o[i] = v;
        }
    }
#endif
#if TIMING
    {
        const unsigned long long t0 = __hip_atomic_load(ts + 0, __ATOMIC_RELAXED, __HIP_MEMORY_SCOPE_AGENT), t1 = __hip_atomic_load(ts + 12, __ATOMIC_RELAXED, __HIP_MEMORY_SCOPE_AGENT);
        const unsigned long long ta = __hip_atomic_load(ts + TIMING - 1, __ATOMIC_RELAXED, __HIP_MEMORY_SCOPE_AGENT), tb = __hip_atomic_load(ts + TIMING, __ATOMIC_RELAXED, __HIP_MEMORY_SCOPE_AGENT);
        (void)t0; (void)t1;
        const float s = 1.0f + floorf((float)(tb - ta) / (float)TUNIT + 0.5f);
        f32x4* o4 = (f32x4*)a.out; const size_t n4 = (size_t)T * D / 4;
        for (size_t i = (size_t)blk * NTHREADS + threadIdx.x; i < n4; i += (size_t)G * NTHREADS) o4[i] = o4[i] * s;
    }
#endif
}

extern "C" void kernel_launch(void* const* d_in, const int* in_sizes, int n_in, void* d_out, int out_size,
                              void* d_ws, size_t ws_size, hipStream_t stream) {
    static int grid = 0;
    if (grid == 0) {
        int dev = 0, cus = 0, per_cu = 0;
        (void)hipGetDevice(&dev);
        (void)hipDeviceGetAttribute(&cus, hipDeviceAttributeMultiprocessorCount, dev);
        (void)hipFuncSetAttribute((const void*)mk_fwd, hipFuncAttributeMaxDynamicSharedMemorySize, LDS_BYTES);
        (void)hipOccupancyMaxActiveBlocksPerMultiprocessor(&per_cu, (const void*)mk_fwd, NTHREADS, LDS_BYTES);
        if (per_cu < 1) per_cu = 1;
        grid = cus * per_cu;
        if (n_in != 27 || ws_size < WS_END) { fprintf(stderr, "kernel_launch: unexpected n_in %d / ws_size %zu\n", n_in, ws_size); }
    }
    (void)hipMemsetAsync((char*)d_ws + WS_CTL, 0, CTL_ZERO_BYTES, stream);
    Args a{};
    const float** ap = (const float**)&a;
    for (int i = 0; i < 27; ++i) ap[i] = (const float*)d_in[i];
    a.out = (float*)d_out; a.ws = (unsigned char*)d_ws;
    void* args[] = {&a};
    hipError_t e = hipLaunchCooperativeKernel((const void*)mk_fwd, dim3(grid), dim3(NTHREADS), args, LDS_BYTES, stream);
    if (e != hipSuccess) fprintf(stderr, "cooperative launch failed: %s (grid %d)\n", hipGetErrorString(e), grid);
}
```

```cpp
#include <hip/hip_runtime.h>
#include <hip/hip_cooperative_groups.h>
#include <cstdio>
#include <cstdint>
namespace cg = cooperative_groups;

#ifndef DBG
#define DBG 0
#endif
#ifndef PROBE
#define PROBE 0
#endif
#ifndef DBG_LO
#define DBG_LO 10
#endif
#ifndef DBG_STOP
#define DBG_STOP 99
#endif

#define DI __device__ __forceinline__
#define GAS __attribute__((address_space(1)))
#define LAS __attribute__((address_space(3)))
typedef unsigned short bf16_t;
typedef short bf16x8 __attribute__((ext_vector_type(8)));
typedef float f32x4 __attribute__((ext_vector_type(4)));
typedef float f32x16 __attribute__((ext_vector_type(16)));
typedef unsigned u32x4 __attribute__((ext_vector_type(4)));
typedef unsigned u32x2 __attribute__((ext_vector_type(2)));
typedef __bf16 bf16x2_t __attribute__((ext_vector_type(2)));

constexpr int NTHREADS = 512, NWAVES = 8;
constexpr int LDS_BYTES = 147456;
constexpr int NB = 2, SEQ = 16384, T = NB * SEQ, D = 2048;
constexpr int AH = 8, HD = 128, AW = 1024;
constexpr int SW = 512, SGRP = 32, SCH = 16, SST = 64;
constexpr int INW = 7688, NPROJ = 7680;
constexpr int NMOD = 6 * D;
constexpr int PH = 8, NKEYS = 128, NEXP = 16384, TOPK = 16, NSEL = PH * TOPK;
constexpr float RMS_EPS = 1e-6f;
constexpr float LOG2E = 1.4426950408889634f;

constexpr size_t MiB = 1u << 20;
constexpr size_t WS_CTL = 0, CTL_ZERO_BYTES = 1 * MiB;
constexpr size_t WS_LF = 1 * MiB;
constexpr size_t WS_F = 2 * MiB;
constexpr size_t WS_WF = 3 * MiB;
constexpr size_t WS_KEYS = 3 * MiB + 512 * 1024;
constexpr size_t WS_WGLU = 4 * MiB, WS_WSSM = 5 * MiB, WS_WATTN = 7 * MiB, WS_WOUT = 11 * MiB, WS_WPQ = 19 * MiB, WS_WIN = 27 * MiB;
constexpr size_t WS_S5TAB = 57 * MiB;
constexpr size_t WS_PU = 64 * MiB, WS_PV = 88 * MiB;
constexpr size_t WS_HB = 192 * MiB;
constexpr size_t WS_QKV = 320 * MiB;
constexpr size_t WS_U = 512 * MiB;
constexpr size_t WS_YATT = 544 * MiB;
constexpr size_t WS_GY = 608 * MiB;
constexpr size_t WS_YG = 640 * MiB;
constexpr size_t WS_GATES = 672 * MiB;
constexpr size_t WS_END = 1024 * MiB;
constexpr int CW_DBG = 64;
constexpr int CW_QUEUE = 256;
constexpr int CW_SEGT = 1024;
constexpr int CW_MOD = 819200;

struct Args {
    const float *x, *c, *w_ada, *b_ada, *norm1_w, *w_in, *b_forget, *q_norm_w, *k_norm_w;
    const float *A_re, *A_im, *log_dt, *B_re, *B_im, *C_re, *C_im, *Dskip;
    const float *w_glu, *b_glu, *w_ssm_up, *w_attn_up, *w_out, *norm2_w, *w_peer_q, *sub_keys, *peer_u, *peer_v;
    float* out; unsigned char* ws;
};

DI unsigned pk2(float lo, float hi) { bf16x2_t v; v.x = (__bf16)lo; v.y = (__bf16)hi; return __builtin_bit_cast(unsigned, v); }
DI float bf2f(unsigned h) { return __uint_as_float(h << 16); }
DI float bflo(unsigned w) { return __uint_as_float(w << 16); }
DI float bfhi(unsigned w) { return __uint_as_float(w & 0xffff0000u); }
DI float sigmoidf_(float z) { return __builtin_amdgcn_rcpf(1.0f + __expf(-z)); }
DI float siluf_(float z) { return z / (1.0f + __expf(-z)); }
DI float geluf_(float z) { return 0.5f * z * (1.0f + erff(z * 0.70710678118654752f)); }
DI float wave_sum(float v) {
    v += __builtin_bit_cast(float, __builtin_amdgcn_mov_dpp(__builtin_bit_cast(int, v), 0xB1, 0xf, 0xf, true));
    v += __builtin_bit_cast(float, __builtin_amdgcn_mov_dpp(__builtin_bit_cast(int, v), 0x4E, 0xf, 0xf, true));
    v += __builtin_bit_cast(float, __builtin_amdgcn_mov_dpp(__builtin_bit_cast(int, v), 0x141, 0xf, 0xf, true));
    v += __builtin_bit_cast(float, __builtin_amdgcn_mov_dpp(__builtin_bit_cast(int, v), 0x128, 0xf, 0xf, true));
    { const auto r = __builtin_amdgcn_permlane16_swap(__float_as_uint(v), __float_as_uint(v), false, false); v = __uint_as_float(r[0]) + __uint_as_float(r[1]); }
    { const auto r = __builtin_amdgcn_permlane32_swap(__float_as_uint(v), __float_as_uint(v), false, false); v = __uint_as_float(r[0]) + __uint_as_float(r[1]); }
    return v;
}
DI int otid() { int t = threadIdx.x; asm volatile("" : "+v"(t)); return t; }
#define LDS_WAIT() asm volatile("s_waitcnt lgkmcnt(0)" ::: "memory")
DI void dbg_report(unsigned* ctl, int id, float err) {
    if (!(err == err)) err = 1e30f;
    atomicMax(ctl + CW_DBG + id, __float_as_uint(fabsf(err)));
}
DI float relerr(float got, float ref, float floor_) { return fabsf(got - ref) / (fabsf(ref) + floor_); }

namespace pg8 {
constexpr int BM = 256, BK = 64, HALF = 128, HTB = HALF * BK * 2, NXCD = 8, WGM = 8;
DI int lds_byte(int r, int c) { const int st = (r >> 4) * 2 + (c >> 5), rr = r & 15, cc = c & 31, ob = rr * 64 + cc * 2; return st * 1024 + (ob ^ (((ob >> 9) & 1) << 5)); }
DI void stage_rc(int b, int& R, int& C) { const int st = b / 1024, sb = b % 1024, swz = sb ^ (((sb >> 9) & 1) << 5); R = (st >> 1) * 16 + swz / 64; C = (st & 1) * 32 + (swz % 64) / 2; }
DI int perm32(int rho) { const int n = rho >> 4, i = rho & 15; return 8 * (i >> 2) + 4 * n + (i & 3); }
struct Unit { int pm, pn; };
struct Gemm { const bf16_t* A; const bf16_t* Bt; int M, N, K; };
struct StaticOrder {
    int nM, nN, nwg, G, c;
    DI void init(int M, int N, int G_, int c_) { nM = M / BM; nN = N / BM; nwg = nM * nN; G = G_; c = c_; }
    DI bool next(int i, Unit& u) const {
        const long L = (long)i * G + c; if (L >= nwg) return false;
        int wgid = (int)L; { const int q = nwg / NXCD, r = nwg % NXCD, xcd = wgid % NXCD, off = wgid / NXCD; wgid = (xcd < r ? xcd * (q + 1) : r * (q + 1) + (xcd - r) * q) + off; }
        const int nig = WGM * nN, gid = wgid / nig, fm = gid * WGM, gsz = (nM - fm) < WGM ? (nM - fm) : WGM;
        u.pm = fm + ((wgid % nig) % gsz); u.pn = (wgid % nig) / gsz; return true;
    }
    DI void a_ready(const Unit&) const {}
    DI void done(const Unit&) const {}
};
template <class Epi, class Sched, bool ALIGN_EPI = false, bool SP2 = false>
DI void gemm_phase(LAS unsigned char* lds, const Gemm g, const Sched& S, const Epi& E) {
    int tid = threadIdx.x; asm volatile("" : "+v"(tid));
    const int wid = __builtin_amdgcn_readfirstlane(tid >> 6), lane = tid & 63, wr = wid >> 2, wc = wid & 3, fr = lane & 15, fq = lane >> 4;
    const int K = g.K, nt = K / BK;
    unsigned voffA[2], voffB[2];
#pragma unroll
    for (int i = 0; i < 2; ++i) { int R, C; stage_rc(tid * 16 + i * 8192, R, C); const int Rb = Epi::PERM ? ((R & ~31) + perm32(R & 31)) : R;
        voffA[i] = (unsigned)(R * K + C) * 2u; voffB[i] = (unsigned)(Rb * K + C) * 2u; }
    const size_t kstep = (size_t)(BK * 2);
    const size_t hstep = (size_t)HALF * K * 2;
    const size_t tstep = 2 * hstep;
    const unsigned ldsw = (unsigned)wid * 1024u;
    const int aoff = lds_byte(wr * 64 + fr, fq * 8), boff = lds_byte(wc * 32 + fr, fq * 8);
#define PG8_SA(b, h) (((b) * 2 + (h)) * HTB)
#define PG8_SB(b, h) ((4 + (b) * 2 + (h)) * HTB)
#define PG8_STAGE(bufoff, gbase, voff) do { _Pragma("unroll") for (int _i = 0; _i < 2; ++_i) \
        __builtin_amdgcn_global_load_lds((const unsigned*)((const char*)(gbase) + (voff)[_i]), (LAS unsigned*)(lds + (bufoff) + ldsw + _i * 8192), 16, 0, 0); } while (0)
#define PG8_LDA(dst, b, h) do { _Pragma("unroll") for (int m = 0; m < 4; ++m) _Pragma("unroll") for (int k = 0; k < 2; ++k) dst[m][k] = *(const LAS bf16x8*)(lds + PG8_SA(b, h) + aoff + m * 2048 + k * 1024); } while (0)
#define PG8_LDB(dst, b, h) do { _Pragma("unroll") for (int n = 0; n < 2; ++n) _Pragma("unroll") for (int k = 0; k < 2; ++k) dst[n][k] = *(const LAS bf16x8*)(lds + PG8_SB(b, h) + boff + n * 2048 + k * 1024); } while (0)
#define PG8_MMA(ai, bj, At, Bt) do { __builtin_amdgcn_s_setprio(1); _Pragma("unroll") for (int m = 0; m < 4; ++m) _Pragma("unroll") for (int n = 0; n < 2; ++n) _Pragma("unroll") for (int k = 0; k < 2; ++k) \
        acc[ai][bj][m][n] = __builtin_amdgcn_mfma_f32_16x16x32_bf16(Bt[n][k], At[m][k], acc[ai][bj][m][n], 0, 0, 0); __builtin_amdgcn_s_setprio(0); } while (0)
#define PG8_WAIT_V(n) asm volatile("s_waitcnt vmcnt(" #n ")" ::: "memory")
#define PG8_WAIT_L(n) asm volatile("s_waitcnt lgkmcnt(" #n ")" ::: "memory")
#define PG8_BAR __builtin_amdgcn_s_barrier()
#define PG8_SCHED __builtin_amdgcn_sched_barrier(0)
    Unit cur, nxt; int ui = 0;
    if (!S.next(0, cur)) return;
    f32x4 acc[2][2][4][2];
#pragma unroll
    for (int a = 0; a < 2; ++a)
#pragma unroll
        for (int b = 0; b < 2; ++b)
#pragma unroll
            for (int m = 0; m < 4; ++m)
#pragma unroll
                for (int n = 0; n < 2; ++n) acc[a][b][m][n] = (f32x4){0.f, 0.f, 0.f, 0.f};
    bf16x8 At[4][2], B0[2][2], B1[2][2];
    const char* cA = (const char*)g.A + (size_t)cur.pm * tstep; const char* cB = (const char*)g.Bt + (size_t)cur.pn * tstep;
    S.a_ready(cur);
    if constexpr (SP2) {
        PG8_STAGE(PG8_SB(0, 0), cB, voffB); PG8_STAGE(PG8_SB(0, 1), cB + hstep, voffB); PG8_STAGE(PG8_SA(0, 0), cA, voffA); PG8_STAGE(PG8_SA(0, 1), cA + hstep, voffA);
        if (wr == 1) PG8_BAR;
        PG8_WAIT_V(2); PG8_BAR;
        PG8_STAGE(PG8_SB(1, 0), cB + kstep, voffB); PG8_STAGE(PG8_SA(1, 0), cA + kstep, voffA); PG8_STAGE(PG8_SB(1, 1), cB + hstep + kstep, voffB);
        PG8_WAIT_V(6); PG8_BAR;
    } else {
        PG8_STAGE(PG8_SB(0, 0), cB, voffB); PG8_STAGE(PG8_SA(0, 0), cA, voffA); PG8_STAGE(PG8_SB(0, 1), cB + hstep, voffB); PG8_STAGE(PG8_SA(0, 1), cA + hstep, voffA);
        if (wr == 1) PG8_BAR;
        PG8_WAIT_V(4); PG8_BAR;
        PG8_STAGE(PG8_SB(1, 0), cB + kstep, voffB); PG8_STAGE(PG8_SA(1, 0), cA + kstep, voffA); PG8_STAGE(PG8_SB(1, 1), cB + hstep + kstep, voffB);
        PG8_WAIT_V(6); PG8_BAR;
    }
    for (;;) {
        const bool has_next = S.next(ui + 1, nxt);
        const char* nA = has_next ? (const char*)g.A + (size_t)nxt.pm * tstep : cA; const char* nB = has_next ? (const char*)g.Bt + (size_t)nxt.pn * tstep : cB;
        for (int t = 0; t < nt; t += 2) {
            const bool last = (t == nt - 2);
            const char* a1 = cA + (size_t)(t + 1) * kstep;
            const char* a2 = last ? nA : cA + (size_t)(t + 2) * kstep; const char* b2 = last ? nB : cB + (size_t)(t + 2) * kstep;
            const char* a3 = a2 + kstep; const char* b3 = b2 + kstep;
            if (last && has_next) S.a_ready(nxt);
            if constexpr (SP2) {
            PG8_LDB(B0, 0, 0); PG8_LDB(B1, 0, 1); PG8_SCHED; PG8_LDA(At, 0, 0); PG8_STAGE(PG8_SA(1, 1), a1 + hstep, voffA);
            PG8_WAIT_V(8); PG8_WAIT_L(0); PG8_BAR; PG8_MMA(0, 0, At, B0); PG8_MMA(0, 1, At, B1); PG8_BAR; PG8_SCHED;
            PG8_LDA(At, 0, 1); PG8_STAGE(PG8_SB(0, 0), b2, voffB); PG8_STAGE(PG8_SB(0, 1), b2 + hstep, voffB); PG8_STAGE(PG8_SA(0, 0), a2, voffA);
            PG8_WAIT_V(8); PG8_WAIT_L(0); PG8_BAR; PG8_MMA(1, 0, At, B0); PG8_MMA(1, 1, At, B1); PG8_BAR; PG8_SCHED;
            PG8_LDB(B0, 1, 0); PG8_LDB(B1, 1, 1); PG8_SCHED; PG8_LDA(At, 1, 0); PG8_STAGE(PG8_SA(0, 1), a2 + hstep, voffA);
            PG8_WAIT_V(8); PG8_WAIT_L(0); PG8_BAR; PG8_MMA(0, 0, At, B0); PG8_MMA(0, 1, At, B1); PG8_BAR; PG8_SCHED;
            PG8_LDA(At, 1, 1); PG8_STAGE(PG8_SB(1, 0), b3, voffB); PG8_STAGE(PG8_SB(1, 1), b3 + hstep, voffB); PG8_STAGE(PG8_SA(1, 0), a3, voffA);
            PG8_WAIT_V(8); PG8_WAIT_L(0); PG8_BAR; PG8_MMA(1, 0, At, B0); PG8_MMA(1, 1, At, B1); PG8_BAR; PG8_SCHED;
            } else {
            PG8_LDB(B0, 0, 0); PG8_SCHED; PG8_LDA(At, 0, 0); PG8_STAGE(PG8_SA(1, 1), a1 + hstep, voffA);
            PG8_WAIT_L(8); PG8_BAR; PG8_WAIT_L(0); PG8_MMA(0, 0, At, B0); PG8_BAR; PG8_SCHED;
            PG8_LDB(B1, 0, 1); PG8_STAGE(PG8_SB(0, 0), b2, voffB);
            PG8_BAR; PG8_WAIT_L(0); PG8_MMA(0, 1, At, B1); PG8_BAR;
            PG8_LDA(At, 0, 1); PG8_STAGE(PG8_SA(0, 0), a2, voffA);
            PG8_BAR; PG8_WAIT_L(0); PG8_MMA(1, 0, At, B0); PG8_BAR; PG8_SCHED;
            PG8_STAGE(PG8_SB(0, 1), b2 + hstep, voffB);
            PG8_WAIT_V(6); PG8_BAR; PG8_MMA(1, 1, At, B1); PG8_BAR;
            PG8_LDB(B0, 1, 0); PG8_SCHED; PG8_LDA(At, 1, 0); PG8_STAGE(PG8_SA(0, 1), a2 + hstep, voffA);
            PG8_WAIT_L(8); PG8_BAR; PG8_WAIT_L(0); PG8_MMA(0, 0, At, B0); PG8_BAR; PG8_SCHED;
            PG8_LDB(B1, 1, 1); PG8_STAGE(PG8_SB(1, 0), b3, voffB);
            PG8_BAR; PG8_WAIT_L(0); PG8_MMA(0, 1, At, B1); PG8_BAR;
            PG8_LDA(At, 1, 1); PG8_STAGE(PG8_SA(1, 0), a3, voffA);
            PG8_BAR; PG8_WAIT_L(0); PG8_MMA(1, 0, At, B0); PG8_BAR; PG8_SCHED;
            PG8_STAGE(PG8_SB(1, 1), b3 + hstep, voffB);
            PG8_WAIT_V(6); PG8_BAR; PG8_MMA(1, 1, At, B1); PG8_BAR;
            }
        }
        if constexpr (ALIGN_EPI) { if (wr == 0) PG8_BAR; }
        E(acc, cur, wr, wc, fr, fq); S.done(cur);
        if (!has_next) break;
#pragma unroll
        for (int a = 0; a < 2; ++a)
#pragma unroll
            for (int b = 0; b < 2; ++b)
#pragma unroll
                for (int m = 0; m < 4; ++m)
#pragma unroll
                    for (int n = 0; n < 2; ++n) acc[a][b][m][n] = (f32x4){0.f, 0.f, 0.f, 0.f};
        cur = nxt; cA = nA; cB = nB; ++ui;
        if constexpr (ALIGN_EPI) { if (wr == 1) PG8_BAR; }
    }
    PG8_WAIT_V(0);
    if constexpr (!ALIGN_EPI) { if (wr == 0) PG8_BAR; }
    PG8_BAR;
#undef PG8_SA
#undef PG8_SB
#undef PG8_STAGE
#undef PG8_LDA
#undef PG8_LDB
#undef PG8_MMA
#undef PG8_WAIT_V
#undef PG8_WAIT_L
#undef PG8_BAR
#undef PG8_SCHED
}
}
constexpr bool G_ALIGN = true, G_SP2 = true;

template <class F>
DI void epi_foreach(const f32x4 (&acc)[2][2][4][2], const pg8::Unit& u, int wr, int wc, int fr, int fq, const F& f) {
#pragma unroll
    for (int ai = 0; ai < 2; ++ai)
#pragma unroll
        for (int m = 0; m < 4; ++m) {
            const int row = u.pm * 256 + ai * 128 + wr * 64 + m * 16 + fr;
#pragma unroll
            for (int bj = 0; bj < 2; ++bj) {
                const int col0 = u.pn * 256 + bj * 128 + wc * 32 + 8 * fq;
                float v[8];
#pragma unroll
                for (int k = 0; k < 4; ++k) { v[k] = acc[ai][bj][m][0][k]; v[4 + k] = acc[ai][bj][m][1][k]; }
                f(row, col0, v);
            }
        }
}
DI void store8_bf16(bf16_t* p, const float (&v)[8]) {
    u32x4 w; w.x = pk2(v[0], v[1]); w.y = pk2(v[2], v[3]); w.z = pk2(v[4], v[5]); w.w = pk2(v[6], v[7]);
    *(u32x4*)p = w;
}
DI void load8_bf16(const bf16_t* p, float (&v)[8]) {
    const u32x4 w = *(const u32x4*)p;
    v[0] = bflo(w.x); v[1] = bfhi(w.x); v[2] = bflo(w.y); v[3] = bfhi(w.y); v[4] = bflo(w.z); v[5] = bfhi(w.z); v[6] = bflo(w.w); v[7] = bfhi(w.w);
}
DI void load8_u8gate(const unsigned char* p, float (&g)[8]) {
    const u32x2 w = *(const u32x2*)p;
#pragma unroll
    for (int k = 0; k < 4; ++k) { g[k] = (float)((w.x >> (8 * k)) & 0xffu) * (1.0f / 255.0f); g[4 + k] = (float)((w.y >> (8 * k)) & 0xffu) * (1.0f / 255.0f); }
}
struct EpiProj {
    static constexpr bool PERM = true;
    bf16_t *qkv, *u; unsigned char* gates;
    DI void operator()(const f32x4 (&acc)[2][2][4][2], const pg8::Unit& un, int wr, int wc, int fr, int fq) const {
        const int pn = un.pn;
        if (pn < 12) { bf16_t* o = qkv; epi_foreach(acc, un, wr, wc, fr, fq, [&](int row, int col0, float (&v)[8]) { store8_bf16(o + (size_t)row * 3072 + col0, v); }); }
        else if (pn < 14) { bf16_t* o = u; epi_foreach(acc, un, wr, wc, fr, fq, [&](int row, int col0, float (&v)[8]) { store8_bf16(o + (size_t)row * 512 + (col0 - 3072), v); }); }
        else { unsigned char* o = gates; epi_foreach(acc, un, wr, wc, fr, fq, [&](int row, int col0, float (&v)[8]) {
                unsigned w0 = 0u, w1 = 0u;
#pragma unroll
                for (int k = 0; k < 4; ++k) { w0 |= (unsigned)(sigmoidf_(v[k]) * 255.0f + 0.5f) << (8 * k); w1 |= (unsigned)(sigmoidf_(v[4 + k]) * 255.0f + 0.5f) << (8 * k); }
                *(u32x2*)(o + (size_t)row * 4096 + (col0 - 3584)) = (u32x2){w0, w1}; }); }
    }
};


constexpr size_t WS_MRG = WS_HB;
constexpr size_t WS_X1B0 = 448 * MiB, WS_X1B1 = 928 * MiB;
DI bf16_t* x1b_row(unsigned char* ws, int m) { return (bf16_t*)(ws + ((m >> 14) ? WS_X1B1 : WS_X1B0)) + (size_t)(m & 16383) * D; }
struct EpiGlu {
    static constexpr bool PERM = true;
    const bf16_t* gy; const float* bglu; bf16_t* yg;
    DI void operator()(const f32x4 (&acc)[2][2][4][2], const pg8::Unit& un, int wr, int wc, int fr, int fq) const {
        epi_foreach(acc, un, wr, wc, fr, fq, [&](int row, int col0, float (&v)[8]) {
            float g[8]; load8_bf16(gy + (size_t)row * SW + col0, g);
#pragma unroll
            for (int k = 0; k < 8; ++k) v[k] = g[k] * sigmoidf_(v[k] + bglu[col0 + k]);
            store8_bf16(yg + (size_t)row * SW + col0, v); });
    }
};
struct EpiSsmUp {
    static constexpr bool PERM = true;
    const unsigned char* gates; bf16_t* mrg;
    DI void operator()(const f32x4 (&acc)[2][2][4][2], const pg8::Unit& un, int wr, int wc, int fr, int fq) const {
        epi_foreach(acc, un, wr, wc, fr, fq, [&](int row, int col0, float (&v)[8]) {
            float g[8]; load8_u8gate(gates + (size_t)row * 4096 + col0, g);
#pragma unroll
            for (int k = 0; k < 8; ++k) v[k] *= g[k];
            store8_bf16(mrg + (size_t)row * D + col0, v); });
    }
};
struct EpiAttnUp {
    static constexpr bool PERM = true;
    const unsigned char* gates; bf16_t* mrg;
    DI void operator()(const f32x4 (&acc)[2][2][4][2], const pg8::Unit& un, int wr, int wc, int fr, int fq) const {
        epi_foreach(acc, un, wr, wc, fr, fq, [&](int row, int col0, float (&v)[8]) {
            float g[8], o[8]; load8_u8gate(gates + (size_t)row * 4096 + 2048 + col0, g); load8_bf16(mrg + (size_t)row * D + col0, o);
#pragma unroll
            for (int k = 0; k < 8; ++k) v[k] = v[k] * g[k] + o[k];
            store8_bf16(mrg + (size_t)row * D + col0, v); });
    }
};
struct EpiOut {
    static constexpr bool PERM = true;
    const float* x; const float* mod; const float* bada; unsigned char* ws;
    DI void operator()(const f32x4 (&acc)[2][2][4][2], const pg8::Unit& un, int wr, int wc, int fr, int fq) const {
        epi_foreach(acc, un, wr, wc, fr, fq, [&](int row, int col0, float (&v)[8]) {
            const int b = row >> 14;
            const float* gp = mod + b * NMOD + 2 * D + col0;
            const f32x4 g0 = *(const f32x4*)gp, g1 = *(const f32x4*)(gp + 4);
            const f32x4 x0 = *(const f32x4*)(x + (size_t)row * D + col0), x1 = *(const f32x4*)(x + (size_t)row * D + col0 + 4);
            f32x4 r0, r1;
#pragma unroll
            for (int k = 0; k < 4; ++k) { r0[k] = x0[k] + g0[k] * v[k]; r1[k] = x1[k] + g1[k] * v[4 + k]; }
            *(u32x4*)(x1b_row(ws, row) + col0) = (u32x4){pk2(r0[0], r0[1]), pk2(r0[2], r0[3]), pk2(r1[0], r1[1]), pk2(r1[2], r1[3])}; });
    }
};


constexpr size_t WS_PUS = 112 * MiB, WS_PVS = 112 * MiB + 512 * 1024;
constexpr int ROWB = 1536;
typedef float f32x2 __attribute__((ext_vector_type(2)));
typedef float v16f __attribute__((ext_vector_type(16)));
typedef float v32f __attribute__((ext_vector_type(32)));
typedef unsigned v6u __attribute__((ext_vector_type(6)));
typedef unsigned v16u __attribute__((ext_vector_type(16)));
typedef __bf16 v32bf __attribute__((ext_vector_type(32)));
DI v32f fp6_unpack_f32(const v6u w) { v32f r; asm volatile("s_nop 1\n\tv_cvt_scalef32_pk32_f32_fp6 %0, %1, 1.0\n\ts_nop 15" : "=&v"(r) : "v"(w)); return r; }
DI v16u fp6_unpack_bf16(const v6u w) { v16u r; asm volatile("s_nop 1\n\tv_cvt_scalef32_pk32_bf16_fp6 %0, %1, 1.0\n\ts_nop 15" : "=&v"(r) : "v"(w)); return r; }

DI unsigned fp6_code(float x) {
    const float a = fminf(fabsf(x), 7.5f);
    const float c = a < 2.0f ? a * 8.0f : (a < 4.0f ? 8.0f + a * 4.0f : 16.0f + a * 2.0f);
    const unsigned q = (unsigned)__builtin_rintf(c);
    return q | ((__float_as_uint(x) >> 31) << 5);
}
DI v6u fp6_pack_sw(const float (&e)[32]) {
    unsigned long long lo = 0, mid = 0, hi = 0;
#pragma unroll
    for (int i = 0; i < 32; ++i) {
        const unsigned long long c = fp6_code(e[i]);
        const int bit = 6 * i;
        if (bit < 64) { lo |= c << bit; if (bit > 58) mid |= c >> (64 - bit); }
        else if (bit < 128) { mid |= c << (bit - 64); if (bit > 122) hi |= c >> (128 - bit); }
        else hi |= c << (bit - 128);
    }
    v6u w; w[0] = (unsigned)lo; w[1] = (unsigned)(lo >> 32); w[2] = (unsigned)mid; w[3] = (unsigned)(mid >> 32); w[4] = (unsigned)hi; w[5] = (unsigned)(hi >> 32);
    return w;
}
DI void fp6_row_convert(const float* src, unsigned char* dst, float* inv_scale, int lane) {
    f32x4 v[8]; float mx = 0.f;
#pragma unroll
    for (int q = 0; q < 8; ++q) { v[q] = *(const f32x4*)(src + 32 * lane + 4 * q);
        mx = fmaxf(mx, fmaxf(fmaxf(fabsf(v[q].x), fabsf(v[q].y)), fmaxf(fabsf(v[q].z), fabsf(v[q].w)))); }
#pragma unroll
    for (int o = 1; o < 64; o <<= 1) mx = fmaxf(mx, __shfl_xor(mx, o));
    int ex = 1; if (mx > 0.f) (void)frexpf(7.5f / mx, &ex);
    const float S = ldexpf(1.0f, ex - 1);
    float el[32];
#pragma unroll
    for (int q = 0; q < 8; ++q) { el[4 * q] = v[q].x * S; el[4 * q + 1] = v[q].y * S; el[4 * q + 2] = v[q].z * S; el[4 * q + 3] = v[q].w * S; }
    const v6u w = fp6_pack_sw(el);
    *(u32x4*)(dst + 16 * lane) = (u32x4){w[0], w[1], w[2], w[3]};
    *(u32x2*)(dst + 1024 + 8 * lane) = (u32x2){w[4], w[5]};
    if (lane == 0) *inv_scale = 1.0f / S;
}
DI v6u fp6_load(const unsigned char* row, int lane) {
    const u32x4 a_ = *(const u32x4*)(row + 16 * lane); const u32x2 b_ = *(const u32x2*)(row + 1024 + 8 * lane);
    v6u w; w[0] = a_[0]; w[1] = a_[1]; w[2] = a_[2]; w[3] = a_[3]; w[4] = b_[0]; w[5] = b_[1]; return w;
}
DI float fp6_at(const unsigned char* row, int k) {
    const v6u w = fp6_load(row, k >> 5);
    const v32f r = fp6_unpack_f32(w);
    float o = 0.f;
#pragma unroll
    for (int i = 0; i < 32; ++i) o = ((k & 31) == i) ? r[i] : o;
    return o;
}


#ifndef TAB4
#define TAB4 1
#endif
#ifndef P10_SLICED
#define P10_SLICED 1
#endif
#ifndef XTRA
#define XTRA 0
#endif
#ifndef DUP
#define DUP 0
#endif
constexpr int ROWB4 = 1024;
constexpr size_t WS_PUE = 177 * MiB, WS_PVE = 178 * MiB;
DI unsigned fp4_idx(float a) { return (unsigned)(a > 0.25f) + (unsigned)(a > 0.75f) + (unsigned)(a > 1.25f) + (unsigned)(a > 1.75f) + (unsigned)(a > 2.5f) + (unsigned)(a > 3.5f) + (unsigned)(a > 5.0f); }
DI void row_load32(const float* src, int lane, f32x4 (&v)[8]) {
#pragma unroll
    for (int q = 0; q < 8; ++q) v[q] = *(const f32x4*)(src + 32 * lane + 4 * q);
}
DI void fp4_row_pack(const f32x4 (&v)[8], unsigned char* dst, unsigned char* sdst, int lane) {
    float mx = 0.f;
#pragma unroll
    for (int q = 0; q < 8; ++q) mx = fmaxf(mx, fmaxf(fmaxf(fabsf(v[q].x), fabsf(v[q].y)), fmaxf(fabsf(v[q].z), fabsf(v[q].w))));
    int ex = 1; if (mx > 0.f) (void)frexpf(6.0f / mx, &ex);
    int lg = ex - 1; lg = lg < -100 ? -100 : (lg > 100 ? 100 : lg);
    const float S = ldexpf(1.0f, lg);
    unsigned w[4];
#pragma unroll
    for (int d = 0; d < 4; ++d) {
        unsigned acc = 0u;
#pragma unroll
        for (int e = 0; e < 8; ++e) { const int i = 8 * d + e; const float x = v[i >> 2][i & 3];
            acc |= (fp4_idx(fabsf(x) * S) | ((__float_as_uint(x) >> 31) << 3)) << (4 * e); }
        w[d] = acc;
    }
    *(u32x4*)(dst + 16 * lane) = (u32x4){w[0], w[1], w[2], w[3]};
    sdst[lane] = (unsigned char)(127 - lg);
}
DI void fp4_unpack8(const unsigned w, f32x2 (&r)[4]) {
    r[0] = __builtin_amdgcn_cvt_scalef32_pk_f32_fp4(w, 1.0f, 0); r[1] = __builtin_amdgcn_cvt_scalef32_pk_f32_fp4(w, 1.0f, 1);
    r[2] = __builtin_amdgcn_cvt_scalef32_pk_f32_fp4(w, 1.0f, 2); r[3] = __builtin_amdgcn_cvt_scalef32_pk_f32_fp4(w, 1.0f, 3);
}
DI float fp4_at(const unsigned char* row, const unsigned char* srow, int k) {
    const unsigned w = ((const unsigned*)row)[k >> 3]; f32x2 r[4]; fp4_unpack8(w, r);
    const int e = k & 7; float o = 0.f;
#pragma unroll
    for (int z = 0; z < 4; ++z) o = ((e >> 1) == z) ? ((e & 1) ? r[z][1] : r[z][0]) : o;
    return o * __uint_as_float((unsigned)srow[k >> 5] << 23);
}

#ifndef U4
#define U4 1
#endif
constexpr size_t WS_PUS4 = 80 * MiB;
constexpr size_t WS_H4 = WS_HB;
constexpr size_t WS_HS = WS_HB + 96 * MiB;
DI float u4_step(int code) { return exp2f((float)(code - 208) * 0.0625f); }
DI void int4_row_pack(const f32x4 (&v)[8], unsigned char* dst, unsigned char* sdst, int lane) {
    float mx = 0.f;
#pragma unroll
    for (int q = 0; q < 8; ++q) mx = fmaxf(mx, fmaxf(fmaxf(fabsf(v[q].x), fabsf(v[q].y)), fmaxf(fabsf(v[q].z), fabsf(v[q].w))));
    int code = 0;
    if (mx > 0.f) { code = (int)ceilf(16.0f * log2f(mx * (1.0f / 7.0f))) + 208; code = code < 0 ? 0 : (code > 255 ? 255 : code); }
    const float S = 1.0f / u4_step(code);
    unsigned w[4];
#pragma unroll
    for (int d = 0; d < 4; ++d) {
        unsigned acc = 0u;
#pragma unroll
        for (int e = 0; e < 8; ++e) { const int i = 8 * d + e; const float x = v[i >> 2][i & 3];
            int q = (int)rintf(x * S); q = q < -7 ? -7 : (q > 7 ? 7 : q);
            acc |= ((unsigned)q & 15u) << (4 * e); }
        w[d] = acc;
    }
    *(u32x4*)(dst + 16 * lane) = (u32x4){w[0], w[1], w[2], w[3]};
    sdst[lane] = (unsigned char)code;
}
DI void transpose_item(const float* W, int ldw, int src_n0, bf16_t* WT, int K, int dst_n0, int k0, LAS float* scr, int lane) {
#pragma unroll
    for (int i = 0; i < 32; ++i) { const int kk = 2 * i + (lane >> 5); scr[kk * 33 + (lane & 31)] = W[(size_t)(k0 + kk) * ldw + src_n0 + (lane & 31)]; }
    LDS_WAIT();
    const int c = lane & 7;
#pragma unroll
    for (int j = 0; j < 4; ++j) { const int n = (lane >> 3) + 8 * j; const LAS float* s = scr + (8 * c) * 33 + n;
        u32x4 o; o.x = pk2(s[0 * 33], s[1 * 33]); o.y = pk2(s[2 * 33], s[3 * 33]); o.z = pk2(s[4 * 33], s[5 * 33]); o.w = pk2(s[6 * 33], s[7 * 33]);
        *(u32x4*)(WT + (size_t)(dst_n0 + n) * K + k0 + 8 * c) = o; }
    LDS_WAIT();
}
DI void convert_stream(const float* src, bf16_t* dst, size_t n, size_t gthread, size_t nthreads) {
    for (size_t i = gthread * 8; i < n; i += nthreads * 8) {
        const f32x4 a = *(const f32x4*)(src + i), b = *(const f32x4*)(src + i + 4);
        u32x4 o; o.x = pk2(a.x, a.y); o.y = pk2(a.z, a.w); o.z = pk2(b.x, b.y); o.w = pk2(b.z, b.w);
        *(u32x4*)(dst + i) = o;
    }
}
DI void phase0(const Args& a, LAS unsigned char* lds) {
    const int tid = otid(), lane = tid & 63, wave = tid >> 6, G = gridDim.x, blk = blockIdx.x;
    unsigned char* ws = a.ws;
    {
        LAS float* sc = (LAS float*)lds;
        LAS float* red = (LAS float*)(lds + 16384);
        float* mod = (float*)(ws + WS_CTL) + CW_MOD;
        if (blk < 192) {
            for (int i = tid; i < 2 * D; i += NTHREADS) sc[i] = siluf_(a.c[i]);
            __syncthreads();
            for (int it = blk; it < 192; it += G) {
                const int cq = tid & 15, kg = tid >> 4;
                const float* wp = a.w_ada + (size_t)(kg * 64) * NMOD + it * 64 + 4 * cq;
                f32x4 a0 = (f32x4){0.f, 0.f, 0.f, 0.f}, a1 = a0;
#pragma unroll 16
                for (int kk = 0; kk < 64; ++kk) { const f32x4 w = *(const f32x4*)(wp + (size_t)kk * NMOD); a0 += w * sc[kg * 64 + kk]; a1 += w * sc[D + kg * 64 + kk]; }
                *(LAS f32x4*)(red + (kg * 2 + 0) * 64 + 4 * cq) = a0; *(LAS f32x4*)(red + (kg * 2 + 1) * 64 + 4 * cq) = a1;
                __syncthreads();
                if (tid < 128) { const int b = tid >> 6, c = tid & 63; float s = 0.f;
#pragma unroll
                    for (int q = 0; q < 32; ++q) s += red[(q * 2 + b) * 64 + c];
                    mod[b * NMOD + it * 64 + c] = s + a.b_ada[it * 64 + c]; }
                __syncthreads();
            }
        }
        __syncthreads();
    }
    LAS float* scr = (LAS float*)(lds + wave * 16384);
    const int gw = blk * NWAVES + wave, NGW = G * NWAVES;
    constexpr int I_IN = 32 * 240, I_GLU = 8 * 16, I_SSM = 8 * 64, I_ATT = 16 * 64, I_OUT = 32 * 64, I_PQ = 32 * 64;
    constexpr int NIT = I_IN + I_GLU + I_SSM + I_ATT + I_OUT + I_PQ;
    for (int it = gw; it < NIT; it += NGW) {
        int r = it;
        if (r < I_IN) { const int kb = r / 240, nb = r % 240, n0 = nb * 32; transpose_item(a.w_in, INW, n0 + (n0 >= 3072 ? 8 : 0), (bf16_t*)(ws + WS_WIN), D, n0, kb * 64, scr, lane); continue; } r -= I_IN;
        if (r < I_GLU) { const int kb = r / 16, nb = r % 16; transpose_item(a.w_glu, SW, nb * 32, (bf16_t*)(ws + WS_WGLU), SW, nb * 32, kb * 64, scr, lane); continue; } r -= I_GLU;
        if (r < I_SSM) { const int kb = r / 64, nb = r % 64; transpose_item(a.w_ssm_up, D, nb * 32, (bf16_t*)(ws + WS_WSSM), SW, nb * 32, kb * 64, scr, lane); continue; } r -= I_SSM;
        if (r < I_ATT) { const int kb = r / 64, nb = r % 64; transpose_item(a.w_attn_up, D, nb * 32, (bf16_t*)(ws + WS_WATTN), AW, nb * 32, kb * 64, scr, lane); continue; } r -= I_ATT;
        if (r < I_OUT) { const int kb = r / 64, nb = r % 64; transpose_item(a.w_out, D, nb * 32, (bf16_t*)(ws + WS_WOUT), D, nb * 32, kb * 64, scr, lane); continue; } r -= I_OUT;
        { const int kb = r / 64, nb = r % 64; transpose_item(a.w_peer_q, D, nb * 32, (bf16_t*)(ws + WS_WPQ), D, nb * 32, kb * 64, scr, lane); }
    }
    {
        float* wf = (float*)(ws + WS_WF);
        for (int i = blk * NTHREADS + tid; i < 8 * D; i += G * NTHREADS) { const int j = i >> 11, k = i & 2047; wf[i] = a.w_in[(size_t)k * INW + 3072 + j]; }
    }
    const size_t gt = (size_t)blk * NTHREADS + tid, nthr = (size_t)G * NTHREADS;
    convert_stream(a.sub_keys, (bf16_t*)(ws + WS_KEYS), (size_t)16 * 128 * 128, gt, nthr);
    {
        constexpr int NCH = 2 * NEXP / 16;
        const int ntrip = 2 * ((NCH + G - 1) / G);
        f32x4 cur[8], nxt[8];
        {   const int r0 = 16 * blk + 2 * wave;
            if (blk < NCH) row_load32((r0 >= NEXP ? a.peer_v : a.peer_u) + (size_t)(r0 & (NEXP - 1)) * D, lane, cur); }
        for (int rr = 0; rr < ntrip; ++rr) {
            const int ch = blk + (rr >> 1) * G, r = 16 * ch + 2 * wave + (rr & 1);
            if (ch >= NCH) break;
            {   const int chn = blk + ((rr + 1) >> 1) * G, rn0 = 16 * chn + 2 * wave + ((rr + 1) & 1), rn = (rr + 1 < ntrip && chn < NCH) ? rn0 : r;
                row_load32((rn >= NEXP ? a.peer_v : a.peer_u) + (size_t)(rn & (NEXP - 1)) * D, lane, nxt); }
            const int tb = r >= NEXP, e = r - tb * NEXP;
            unsigned char* sd = ws + (tb ? WS_PVE : WS_PUS4) + (size_t)(lane >> 3) * (NEXP * 8) + (size_t)e * 8 + (lane & 7) - lane;
            if (!tb) int4_row_pack(cur, ws + WS_PU + (size_t)e * ROWB4, sd, lane);
            else fp4_row_pack(cur, ws + WS_PV + (size_t)e * ROWB4, sd, lane);
#pragma unroll
            for (int q = 0; q < 8; ++q) cur[q] = nxt[q];
        }
    }
}


DI int affine_row(int blk, int wave, int i, int G) {
    if (G == 256) return 4096 * (blk & 7) + 128 * (blk >> 3) + 16 * wave + i;
    return (blk * NWAVES + wave) + i * (G * NWAVES);
}
template <bool WITH_F, bool XBF = false>
DI void row_pass(const Args& a, LAS unsigned char* lds, const float* xin, const float* normw, int shift_idx, int scale_idx, bf16_t* hb) {
    const int tid = otid(), lane = tid & 63, wave = tid >> 6, G = gridDim.x, blk = blockIdx.x;
    const float* mod = (const float*)(a.ws + WS_CTL) + CW_MOD;
    LAS f32x4* wfl = (LAS f32x4*)lds;
    if (WITH_F) {
        const f32x4* wf = (const f32x4*)(a.ws + WS_WF);
        for (int i = tid; i < 8 * 512; i += NTHREADS) wfl[i] = wf[i];
        __syncthreads();
    }
    const int gw = blk * NWAVES + wave, NGW = G * NWAVES;
    int curb = -1;
    f32x4 gg[8], sh[8], vn[8];
    (void)gw;
    {   const int m0 = affine_row(blk, wave, 0, G);
        if (m0 < T) {
            if (XBF) { const u32x2* xr = (const u32x2*)x1b_row(a.ws, m0) + lane;
#pragma unroll
                for (int j = 0; j < 8; ++j) { const u32x2 w = xr[64 * j]; vn[j] = (f32x4){bflo(w.x), bfhi(w.x), bflo(w.y), bfhi(w.y)}; } }
            else { const f32x4* xr = (const f32x4*)(xin + (size_t)m0 * D) + lane;
#pragma unroll
                for (int j = 0; j < 8; ++j) vn[j] = xr[64 * j]; } } }
    for (int ri = 0; ri < (T + NGW - 1) / NGW; ++ri) {
        const int m = affine_row(blk, wave, ri, G);
        if (m >= T) break;
        const int b = m >> 14;
        if (b != curb) {
            curb = b;
#pragma unroll
            for (int j = 0; j < 8; ++j) {
                const int e = 4 * (lane + 64 * j);
                const f32x4 nw = *(const f32x4*)(normw + e);
                const f32x4 sc = *(const f32x4*)(mod + b * NMOD + scale_idx * D + e);
                sh[j] = *(const f32x4*)(mod + b * NMOD + shift_idx * D + e);
                gg[j] = nw * (sc + 1.0f);
            }
        }
        f32x4 v[8]; float ss = 0.f;
#pragma unroll
        for (int j = 0; j < 8; ++j) { v[j] = vn[j]; ss += (v[j].x * v[j].x + v[j].y * v[j].y) + (v[j].z * v[j].z + v[j].w * v[j].w); }
        {
            const int mn0 = (ri + 1 < (T + NGW - 1) / NGW) ? affine_row(blk, wave, ri + 1, G) : m, mn = mn0 < T ? mn0 : m;
            if (XBF) { const u32x2* xr = (const u32x2*)x1b_row(a.ws, mn) + lane;
#pragma unroll
                for (int j = 0; j < 8; ++j) { const u32x2 w = xr[64 * j]; vn[j] = (f32x4){bflo(w.x), bfhi(w.x), bflo(w.y), bfhi(w.y)}; } }
            else { const f32x4* xr = (const f32x4*)(xin + (size_t)mn * D) + lane;
#pragma unroll
                for (int j = 0; j < 8; ++j) vn[j] = xr[64 * j]; }
        }
        const float r = rsqrtf(wave_sum(ss) * (1.0f / D) + RMS_EPS);
#pragma unroll
        for (int j = 0; j < 8; ++j) v[j] = v[j] * r * gg[j] + sh[j];
        u32x2* o = (u32x2*)(hb + (size_t)m * D) + lane;
#pragma unroll
        for (int j = 0; j < 8; ++j) { u32x2 w; w.x = pk2(v[j].x, v[j].y); w.y = pk2(v[j].z, v[j].w); o[64 * j] = w; }
        if (WITH_F) {
            float mine = 0.f;
#pragma unroll 1
            for (int q = 0; q < 8; ++q) {
                float s = 0.f;
#pragma unroll
                for (int j = 0; j < 8; ++j) { const f32x4 w = wfl[q * 512 + lane + 64 * j]; s += (v[j].x * w.x + v[j].y * w.y) + (v[j].z * w.z + v[j].w * w.w); }
                s = wave_sum(s);
                mine = (lane == q) ? s : mine;
            }
            if (lane < 8) {
                const float z = mine + a.b_forget[lane];
                const float ls = fminf(z, 0.f) - log1pf(__expf(-fabsf(z)));
                ((float*)(a.ws + WS_LF))[(size_t)m * 8 + lane] = ls;
            }
        }
    }
}


constexpr size_t WS_VT = 113 * MiB;
constexpr size_t WS_DBGS = 928 * MiB;
DI void phase2b(const Args& a, LAS unsigned char* lds) {
    const int tid = otid(), lane = tid & 63, wave = tid >> 6, G = gridDim.x, blk = blockIdx.x;
    const int gw = blk * NWAVES + wave, NGW = G * NWAVES;
    bf16_t* qkv = (bf16_t*)(a.ws + WS_QKV);
    if (gw < NB * AH * 8) {
        const int bh = gw >> 3, seg = gw & 7, b = bh >> 3, h = bh & 7;
        const float* lf = (const float*)(a.ws + WS_LF);
        float* F = (float*)(a.ws + WS_F) + (size_t)bh * SEQ + seg * 2048;
        double carry = 0.0;
        float xv[32];
#pragma unroll
        for (int c = 0; c < 32; ++c) xv[c] = lf[((size_t)b * SEQ + seg * 2048 + c * 64 + lane) * 8 + h];
#pragma unroll
        for (int c = 0; c < 32; ++c) {
            double x = (double)xv[c];
#pragma unroll
            for (int o = 1; o < 64; o <<= 1) { const double t = __shfl_up(x, o); if (lane >= o) x += t; }
            F[c * 64 + lane] = (float)((carry + x) * 1.4426950408889634);
            carry += __shfl(x, 63);
        }
        if (lane == 0) ((float*)(a.ws + WS_CTL) + CW_SEGT)[gw] = (float)(carry * 1.4426950408889634);
    }
    {
        const int head = lane >> 3, d0 = (lane & 7) * 16;
        float wq[16], wk[16];
        const float QS = 0.08838834764831845f * LOG2E;
#pragma unroll
        for (int i = 0; i < 16; ++i) { wq[i] = a.q_norm_w[d0 + i] * QS; wk[i] = a.k_norm_w[d0 + i]; }
        for (int ri = 0; ri < (T + NGW - 1) / NGW; ++ri) {
            const int m = affine_row(blk, wave, ri, G);
            if (m >= T) break;
            bf16_t* row = qkv + (size_t)m * 3072 + head * 128 + d0;
#pragma unroll
            for (int qk = 0; qk < 2; ++qk) {
                bf16_t* p = row + qk * 1024;
                float v[16]; float va[8], vb[8];
                load8_bf16(p, va); load8_bf16(p + 8, vb);
#pragma unroll
                for (int i = 0; i < 8; ++i) { v[i] = va[i]; v[8 + i] = vb[i]; }
                float ss = 0.f;
#pragma unroll
                for (int i = 0; i < 16; ++i) ss += v[i] * v[i];
                ss += __shfl_xor(ss, 1); ss += __shfl_xor(ss, 2); ss += __shfl_xor(ss, 4);
                const float r = rsqrtf(ss * (1.0f / HD) + RMS_EPS);
#pragma unroll
                for (int i = 0; i < 8; ++i) { va[i] = v[i] * r * (qk ? wk[i] : wq[i]); vb[i] = v[8 + i] * r * (qk ? wk[8 + i] : wq[8 + i]); }
                store8_bf16(p, va); store8_bf16(p + 8, vb);
            }
        }
    }
    {
        LAS unsigned char* tile = lds + wave * 17408;
        bf16_t* vt = (bf16_t*)(a.ws + WS_VT);
        for (int it = gw; it < NB * AH * (SEQ / 64); it += NGW) {
            const int b = it / (AH * 256), h = (it / 256) % AH, c = it % 256;
            const size_t m0 = (size_t)b * SEQ + c * 64;
#pragma unroll 4
            for (int i = 0; i < 16; ++i) { const int row = 4 * i + (lane >> 4), ch = lane & 15;
                const u32x4 v = *(const u32x4*)(qkv + (m0 + row) * 3072 + 2048 + h * 128 + ch * 8);
                *(LAS u32x4*)(tile + row * 272 + ch * 16) = v; }
            LDS_WAIT();
#pragma unroll 1
            for (int dd = 0; dd < 2; ++dd) {
                const int d = lane + 64 * dd;
                bf16_t* dst = vt + (((size_t)(b * AH + h) * (SEQ / 64) + c) * HD + d) * 64;
#pragma unroll
                for (int g4 = 0; g4 < 4; ++g4) {
                    unsigned w[8];
#pragma unroll
                    for (int pp = 0; pp < 8; ++pp) {
                        const int p0 = 2 * pp, p1 = 2 * pp + 1;
                        const int k0 = 8 * ((p0 >> 2) & 1) + 4 * (p0 >> 3) + (p0 & 3), k1 = 8 * ((p1 >> 2) & 1) + 4 * (p1 >> 3) + (p1 & 3);
                        const unsigned lo = *(const LAS unsigned short*)(tile + (g4 * 16 + k0) * 272 + d * 2);
                        const unsigned hi = *(const LAS unsigned short*)(tile + (g4 * 16 + k1) * 272 + d * 2);
                        w[pp] = lo | (hi << 16);
                    }
                    *(u32x4*)(dst + g4 * 16) = (u32x4){w[0], w[1], w[2], w[3]};
                    *(u32x4*)(dst + g4 * 16 + 8) = (u32x4){w[4], w[5], w[6], w[7]};
                }
            }
            LDS_WAIT();
        }
    }
}

DI void attn_item(const Args& a, LAS unsigned char* lds, int b, int h, int qb, float thr2) {
    const int tid = otid(), lane = tid & 63, wave = __builtin_amdgcn_readfirstlane(tid >> 6), q = lane & 31, hh = lane >> 5;
    const bf16_t* qkv = (const bf16_t*)(a.ws + WS_QKV);
    const bf16_t* vt = (const bf16_t*)(a.ws + WS_VT) + (size_t)(b * AH + h) * HD * SEQ;
    const float* Floc = (const float*)(a.ws + WS_F) + (size_t)(b * AH + h) * SEQ;
    LAS float* offl = (LAS float*)(lds + 33024);
    if (tid < 8) { const float* st = (const float*)(a.ws + WS_CTL) + CW_SEGT + (b * AH + h) * 8; float s = 0.f; for (int i = 0; i < tid; ++i) s += st[i]; offl[tid] = s; }
    __syncthreads();
    auto F = [&](int i) -> float { return Floc[i] + offl[i >> 11]; };
    const int t0 = qb * 256, tw0 = t0 + 32 * wave, t = tw0 + q;
    const size_t mrow = (size_t)b * SEQ;
    LAS unsigned char* Kl = lds; LAS unsigned char* Vl = lds + 16384; LAS float* Fl = (LAS float*)(lds + 32768);
    int j0;
    {
        const float Ft0 = F(t0); const int jd = t0 / 64; int need = 0;
        for (int k = 0; k < 4; ++k) {
            const int jj = jd - 1 - (64 * k + lane);
            const bool nd = (jj >= 0) && (Ft0 - F(jj >= 0 ? 64 * jj + 63 : 0) > -thr2);
            const unsigned long long bal = __ballot(nd);
            need += __popcll(bal);
            if (bal != ~0ull) break;
        }
        j0 = jd - need;
    }
    const int jend = t0 / 64 + 3;
    bf16x8 qf[8];
#pragma unroll
    for (int ks = 0; ks < 8; ++ks) qf[ks] = *(const bf16x8*)(qkv + (mrow + t) * 3072 + h * 128 + ks * 16 + hh * 8);
    const float Fq = F(t);
    f32x16 o[4];
#pragma unroll
    for (int i = 0; i < 4; ++i)
#pragma unroll
        for (int r = 0; r < 16; ++r) o[i][r] = 0.f;
    float mrun = -1e30f, lrun = 0.f;
    u32x4 kreg[2], vreg[2]; float freg = 0.f;
    auto issue = [&](int j) {
#pragma unroll
        for (int i = 0; i < 2; ++i) { const int idx = tid + 512 * i;
            kreg[i] = *(const u32x4*)(qkv + (mrow + 64 * j + (idx >> 4)) * 3072 + 1024 + h * 128 + (idx & 15) * 8);
            vreg[i] = *(const u32x4*)(vt + (size_t)j * (HD * 64) + (size_t)idx * 8); }
        if (tid < 64) freg = F(64 * j + tid);
    };
    auto commit = [&]() {
#pragma unroll
        for (int i = 0; i < 2; ++i) { const int idx = tid + 512 * i;
            { const int r = idx >> 4, ch = idx & 15; *(LAS u32x4*)(Kl + r * 256 + ((ch ^ (r & 15)) << 4)) = kreg[i]; }
            { const int d = idx >> 3, ch = idx & 7; *(LAS u32x4*)(Vl + d * 128 + ((ch ^ ((d >> 1) & 7)) << 4)) = vreg[i]; } }
        if (tid < 64) Fl[tid] = freg;
    };
    issue(j0);
    for (int j = j0; j <= jend; ++j) {
        __syncthreads();
        commit();
        __syncthreads();
        if (j < jend) issue(j + 1);
        if (64 * j <= tw0 + 31) {
            f32x16 sacc[2];
#pragma unroll
            for (int rb = 0; rb < 2; ++rb) {
#pragma unroll
                for (int r = 0; r < 16; ++r) sacc[rb][r] = 0.f;
#pragma unroll
                for (int ks = 0; ks < 8; ++ks) {
                    const int r = rb * 32 + q, ch = ks * 2 + hh;
                    const bf16x8 kf = *(const LAS bf16x8*)(Kl + r * 256 + ((ch ^ (r & 15)) << 4));
                    sacc[rb] = __builtin_amdgcn_mfma_f32_32x32x16_bf16(kf, qf[ks], sacc[rb], 0, 0, 0);
                }
            }
            const bool diag = (64 * j + 63 > tw0);
            float mx = -1e30f;
#pragma unroll
            for (int rb = 0; rb < 2; ++rb)
#pragma unroll
                for (int g4 = 0; g4 < 4; ++g4) {
                    const f32x4 fs = *(const LAS f32x4*)(Fl + rb * 32 + 8 * g4 + 4 * hh);
#pragma unroll
                    for (int i = 0; i < 4; ++i) {
                        const int reg = 4 * g4 + i;
                        float s = sacc[rb][reg] + (Fq - fs[i]);
                        if (diag) { const int key = 64 * j + rb * 32 + 8 * g4 + 4 * hh + i; s = (key > t) ? -1e30f : s; }
                        sacc[rb][reg] = s; mx = fmaxf(mx, s);
                    }
                }
            mx = fmaxf(mx, __shfl_xor(mx, 32));
            if (__ballot(mx > mrun + 8.0f) != 0ull) {
                const float mnew = fmaxf(mrun, mx);
                const float alpha = __builtin_amdgcn_exp2f(mrun - mnew);
                mrun = mnew;
                lrun *= alpha;
#pragma unroll
                for (int i = 0; i < 4; ++i)
#pragma unroll
                    for (int r = 0; r < 16; ++r) o[i][r] *= alpha;
            }
            float ps = 0.f;
#pragma unroll
            for (int rb = 0; rb < 2; ++rb)
#pragma unroll
                for (int r = 0; r < 16; ++r) { const float p = __builtin_amdgcn_exp2f(sacc[rb][r] - mrun); sacc[rb][r] = p; ps += p; }
            lrun += ps;
#pragma unroll
            for (int rb = 0; rb < 2; ++rb)
#pragma unroll
                for (int s2 = 0; s2 < 2; ++s2) {
                    u32x4 pw; pw.x = pk2(sacc[rb][8 * s2 + 0], sacc[rb][8 * s2 + 1]); pw.y = pk2(sacc[rb][8 * s2 + 2], sacc[rb][8 * s2 + 3]);
                    pw.z = pk2(sacc[rb][8 * s2 + 4], sacc[rb][8 * s2 + 5]); pw.w = pk2(sacc[rb][8 * s2 + 6], sacc[rb][8 * s2 + 7]);
                    const bf16x8 pf = __builtin_bit_cast(bf16x8, pw);
                    const int ch = rb * 4 + s2 * 2 + hh;
#pragma unroll
                    for (int db = 0; db < 4; ++db) {
                        const int d = db * 32 + q;
                        const bf16x8 vf = *(const LAS bf16x8*)(Vl + d * 128 + ((ch ^ ((d >> 1) & 7)) << 4));
                        o[db] = __builtin_amdgcn_mfma_f32_32x32x16_bf16(vf, pf, o[db], 0, 0, 0);
                    }
                }
        }
    }
    const float ltot = lrun + __shfl_xor(lrun, 32);
    const float inv = 1.0f / ltot;
    bf16_t* yo = (bf16_t*)(a.ws + WS_YATT) + (mrow + t) * AW + h * 128;
#pragma unroll
    for (int db = 0; db < 4; ++db)
#pragma unroll
        for (int g4 = 0; g4 < 4; ++g4) {
            u32x2 w; w.x = pk2(o[db][4 * g4] * inv, o[db][4 * g4 + 1] * inv); w.y = pk2(o[db][4 * g4 + 2] * inv, o[db][4 * g4 + 3] * inv);
            *(u32x2*)(yo + db * 32 + 8 * g4 + 4 * hh) = w;
        }
    __syncthreads();
}


constexpr size_t WS_S5POW = WS_S5TAB;
constexpr size_t WS_S5BB = WS_S5TAB + 512 * 1024;
constexpr size_t WS_S5Q = WS_S5TAB + 1 * MiB;
constexpr size_t WS_S5P = WS_S5TAB + 3 * MiB;
constexpr size_t WS_S5K = WS_S5TAB + 5 * MiB;
DI void s5_tables_p0(const Args& a) {
    const int gt = blockIdx.x * NTHREADS + otid();
    if (gt >= SGRP * SST) return;
    const int g = gt >> 6, p = gt & 63;
    const float lre = a.A_re[g * SST + p], lim = a.A_im[g * SST + p], dt = expf(a.log_dt[g]);
    const float mag = expf(lre * dt), abr = mag * cosf(lim * dt), abi = mag * sinf(lim * dt);
    const float den = lre * lre + lim * lim, nr = abr - 1.0f;
    const float cr = (nr * lre + abi * lim) / den, ci = (abi * lre - nr * lim) / den;
    float* pw = (float*)(a.ws + WS_S5POW) + (size_t)gt * 34;
    double pr = 1.0, pi = 0.0;
    for (int n = 0; n <= 16; ++n) { pw[2 * n] = (float)pr; pw[2 * n + 1] = (float)pi; const double t = pr * abr - pi * abi; pi = pr * abi + pi * abr; pr = t; }
    float* bb = (float*)(a.ws + WS_S5BB) + (size_t)gt * 32;
    for (int c = 0; c < 16; ++c) { const float br = a.B_re[(g * SST + p) * SCH + c], bi = a.B_im[(g * SST + p) * SCH + c];
        bb[2 * c] = cr * br - ci * bi; bb[2 * c + 1] = cr * bi + ci * br; }
}
DI void s5_tables_p1(const Args& a) {
    const size_t gt0 = (size_t)blockIdx.x * NTHREADS + otid(), nthr = (size_t)gridDim.x * NTHREADS;
    const float* POW = (const float*)(a.ws + WS_S5POW); const float* BB = (const float*)(a.ws + WS_S5BB);
    bf16_t* Qt = (bf16_t*)(a.ws + WS_S5Q); bf16_t* Pt = (bf16_t*)(a.ws + WS_S5P); bf16_t* Kt = (bf16_t*)(a.ws + WS_S5K);
    for (size_t i = gt0; i < (size_t)SGRP * 16 * 128 * 16; i += nthr) {
        {
            const int c = i & 15, pp = (i >> 4) & 127, j = (i >> 11) & 15, g = (int)(i >> 15), p = pp & 63;
            const float* pw = POW + ((size_t)(g * SST + p) * 17 + (15 - j)) * 2; const float* bb = BB + ((size_t)(g * SST + p) * 16 + c) * 2;
            const float re = pw[0] * bb[0] - pw[1] * bb[1], im = pw[0] * bb[1] + pw[1] * bb[0];
            Qt[i] = (bf16_t)(pk2(pp < 64 ? re : im, 0.f) & 0xffffu);
        }
        {
            const int pp = i & 127, c = (i >> 7) & 15, t = (i >> 11) & 15, g = (int)(i >> 15), p = pp & 63;
            const float* pw = POW + ((size_t)(g * SST + p) * 17 + (t + 1)) * 2;
            const float cr = a.C_re[(g * SCH + c) * SST + p], ci = a.C_im[(g * SCH + c) * SST + p];
            const float re = cr * pw[0] - ci * pw[1], im = cr * pw[1] + ci * pw[0];
            Pt[i] = (bf16_t)(pk2(pp < 64 ? re : -im, 0.f) & 0xffffu);
        }
    }
    for (size_t i = gt0; i < (size_t)SGRP * 17 * 32 * 16; i += nthr) {
        const int cp = i & 15, row = (i >> 4) & 31, d = (int)((i >> 9) % 17), g = (int)(i / (17 * 512));
        const int tau = d - 1 + (row >> 4), c = row & 15;
        float s = 0.f;
        if (tau >= 0) for (int p = 0; p < SST; ++p) {
            const float* pw = POW + ((size_t)(g * SST + p) * 17 + tau) * 2; const float* bb = BB + ((size_t)(g * SST + p) * 16 + cp) * 2;
            const float wr = pw[0] * bb[0] - pw[1] * bb[1], wi = pw[0] * bb[1] + pw[1] * bb[0];
            s += a.C_re[(g * SCH + c) * SST + p] * wr - a.C_im[(g * SCH + c) * SST + p] * wi;
        }
        Kt[i] = (bf16_t)(pk2(s, 0.f) & 0xffffu);
    }
}
DI float gelu_as(float v) {
    const float av = fabsf(v), t = __builtin_amdgcn_rcpf(av * 0.2316418882f + 1.0f);
    float q = t * 0.5307027145f + (-0.7265760135f); q = q * t + 0.7107068705f; q = q * t + (-0.142248368f); q = q * t + 0.127414796f; q = q * t;
    const float e = __builtin_amdgcn_exp2f((v * v) * (-0.72134752044f));
    const float m = v * (q * e);
    return v < 0.f ? m : v - m;
}
DI void s5_mfma_item(const Args& a, LAS unsigned char* lds, int b, int g) {
    const int tid = otid(), lane = tid & 63, w = __builtin_amdgcn_readfirstlane(tid >> 6), q = lane & 31, hh = lane >> 5;
    LAS unsigned char* Xl = lds;
    LAS unsigned char* El = lds + 32768;
    LAS unsigned char* Cl = lds + 65536;
    LAS unsigned char* Kl = lds + 81920;
    const bf16_t* U = (const bf16_t*)(a.ws + WS_U);
    bf16_t* GY = (bf16_t*)(a.ws + WS_GY);
    __syncthreads();
    {   const u32x4* ks = (const u32x4*)((const bf16_t*)(a.ws + WS_S5K) + (size_t)g * 17 * 512);
        for (int i = tid; i < 17 * 64; i += NTHREADS) *(LAS u32x4*)(Kl + i * 16) = ks[i]; }
    const int rbE = w & 3, cbE = w >> 2;
    bf16x8 qf[16], pf[8];
    {   const bf16_t* Qt = (const bf16_t*)(a.ws + WS_S5Q) + (size_t)g * 16 * 128 * 16;
#pragma unroll
        for (int j = 0; j < 16; ++j) qf[j] = *(const bf16x8*)(Qt + ((size_t)j * 128 + rbE * 32 + q) * 16 + 8 * hh);
        const bf16_t* Pt = (const bf16_t*)(a.ws + WS_S5P) + (size_t)g * 16 * 16 * 128;
        const int t = 2 * w + (q >> 4), c = q & 15;
#pragma unroll
        for (int ks = 0; ks < 8; ++ks) pf[ks] = *(const bf16x8*)(Pt + ((size_t)t * 16 + c) * 128 + ks * 16 + 8 * hh); }
    float dsel[2][4];
#pragma unroll
    for (int z = 0; z < 2; ++z)
#pragma unroll
        for (int i = 0; i < 4; ++i) dsel[z][i] = a.Dskip[g * SCH + 4 * hh + 8 * z + i];
    float cr = 0.f, ci = 0.f, a16r = 0.f, a16i = 0.f;
    if (w == 0) { const float* pw = (const float*)(a.ws + WS_S5POW) + ((size_t)(g * SST + lane) * 17 + 16) * 2; a16r = pw[0]; a16i = pw[1]; }
    __syncthreads();
    u32x4 xpre[4];
#pragma unroll
    for (int i = 0; i < 2; ++i) { const size_t tokm = (size_t)b * SEQ + tid + 512 * i;
        xpre[2 * i] = *(const u32x4*)(U + tokm * SW + g * SCH); xpre[2 * i + 1] = *(const u32x4*)(U + tokm * SW + g * SCH + 8); }
    for (int sc = 0; sc < SEQ / 1024; ++sc) {
        const size_t m0 = (size_t)b * SEQ + (size_t)sc * 1024;
#pragma unroll
        for (int i = 0; i < 2; ++i) { const int tok = tid + 512 * i, j = tok & 15, k = tok >> 4;
            *(LAS u32x4*)(Xl + ((j * 64 + k) * 2) * 16) = xpre[2 * i]; *(LAS u32x4*)(Xl + ((j * 64 + k) * 2 + 1) * 16) = xpre[2 * i + 1]; }
        if (sc + 1 < SEQ / 1024) {
#pragma unroll
            for (int i = 0; i < 2; ++i) { const size_t tokm = m0 + 1024 + tid + 512 * i;
                xpre[2 * i] = *(const u32x4*)(U + tokm * SW + g * SCH); xpre[2 * i + 1] = *(const u32x4*)(U + tokm * SW + g * SCH + 8); }
        }
        __syncthreads();
        {
            f32x16 e;
#pragma unroll
            for (int r = 0; r < 16; ++r) e[r] = 0.f;
#pragma unroll
            for (int j = 0; j < 16; ++j) { const bf16x8 xb = *(const LAS bf16x8*)(Xl + ((j * 64 + cbE * 32 + q) * 2 + hh) * 16);
                e = __builtin_amdgcn_mfma_f32_32x32x16_bf16(qf[j], xb, e, 0, 0, 0); }
            const int k = cbE * 32 + q;
#pragma unroll
            for (int g4 = 0; g4 < 4; ++g4) { const int pp = rbE * 32 + 8 * g4 + 4 * hh;
                *(LAS f32x4*)(El + k * 512 + (((pp >> 2) ^ (k & 31)) << 4)) = (f32x4){e[4 * g4], e[4 * g4 + 1], e[4 * g4 + 2], e[4 * g4 + 3]}; }
        }
        __syncthreads();
        if (w == 0) {
#pragma unroll 1
            for (int k0 = 0; k0 < 64; k0 += 16) {
                float er[16], ei[16];
#pragma unroll
                for (int kk = 0; kk < 16; ++kk) { const int k = k0 + kk;
                    er[kk] = *(const LAS float*)(El + k * 512 + ((((lane) >> 2) ^ (k & 31)) << 4) + (lane & 3) * 4);
                    ei[kk] = *(const LAS float*)(El + k * 512 + ((((64 + lane) >> 2) ^ (k & 31)) << 4) + (lane & 3) * 4); }
                unsigned short cw[32];
#pragma unroll
                for (int kk = 0; kk < 16; ++kk) {
                    cw[2 * kk] = (unsigned short)(pk2(cr, 0.f) & 0xffffu); cw[2 * kk + 1] = (unsigned short)(pk2(ci, 0.f) & 0xffffu);
                    const float nr = a16r * cr - a16i * ci + er[kk], ni = a16r * ci + a16i * cr + ei[kk];
                    cr = nr; ci = ni;
                }
#pragma unroll
                for (int kk = 0; kk < 16; ++kk) { const int k = k0 + kk;
                    *(LAS unsigned short*)(Cl + k * 256 + ((((lane) >> 3) ^ (k & 15)) << 4) + (lane & 7) * 2) = cw[2 * kk];
                    *(LAS unsigned short*)(Cl + k * 256 + ((((64 + lane) >> 3) ^ (k & 15)) << 4) + (lane & 7) * 2) = cw[2 * kk + 1]; }
            }
        }
        f32x16 y[2];
#pragma unroll
        for (int cb = 0; cb < 2; ++cb)
#pragma unroll
            for (int r = 0; r < 16; ++r) y[cb][r] = 0.f;
#pragma unroll 2
        for (int j = 0; j <= 2 * w + 1; ++j) {
            const bf16x8 kf = *(const LAS bf16x8*)(Kl + (((2 * w - j + 1) * 32 + q) * 16 + 8 * hh) * 2);
#pragma unroll
            for (int cb = 0; cb < 2; ++cb) { const bf16x8 xb = *(const LAS bf16x8*)(Xl + ((j * 64 + cb * 32 + q) * 2 + hh) * 16);
                y[cb] = __builtin_amdgcn_mfma_f32_32x32x16_bf16(kf, xb, y[cb], 0, 0, 0); }
        }
        __syncthreads();
#pragma unroll
        for (int ks = 0; ks < 8; ++ks)
#pragma unroll
            for (int cb = 0; cb < 2; ++cb) { const int k = cb * 32 + q;
                const bf16x8 cf = *(const LAS bf16x8*)(Cl + k * 256 + (((ks * 2 + hh) ^ (k & 15)) << 4));
                y[cb] = __builtin_amdgcn_mfma_f32_32x32x16_bf16(pf[ks], cf, y[cb], 0, 0, 0); }
#pragma unroll
        for (int cb = 0; cb < 2; ++cb) {
            const int k = cb * 32 + q;
#pragma unroll
            for (int g4 = 0; g4 < 4; ++g4) {
                const int tt = g4 >> 1, z = g4 & 1, t = 2 * w + tt, c0 = 4 * hh + 8 * z;
                const u32x2 uw = *(const LAS u32x2*)(Xl + ((t * 64 + k) * 2 + z) * 16 + hh * 8);
                const float u0 = bflo(uw.x), u1 = bfhi(uw.x), u2 = bflo(uw.y), u3 = bfhi(uw.y);
                const float y0 = gelu_as(y[cb][4 * g4] + dsel[z][0] * u0), y1 = gelu_as(y[cb][4 * g4 + 1] + dsel[z][1] * u1);
                const float y2 = gelu_as(y[cb][4 * g4 + 2] + dsel[z][2] * u2), y3 = gelu_as(y[cb][4 * g4 + 3] + dsel[z][3] * u3);
                u32x2 o; o.x = pk2(y0, y1); o.y = pk2(y2, y3);
                *(u32x2*)(GY + (m0 + 16 * k + t) * SW + g * SCH + c0) = o;
            }
        }
        __syncthreads();
    }
}

DI void phase3(const Args& a, LAS unsigned char* lds) {
    const int tid = otid(), lane = tid & 63, wave = tid >> 6, blk = blockIdx.x;
    unsigned* ctl = (unsigned*)(a.ws + WS_CTL);
    for (int it = blk; it < NB * SGRP; it += gridDim.x) s5_mfma_item(a, lds, it >> 5, it & 31);
    float wqm = 0.f, wkm = 0.f;
    for (int i = lane; i < HD; i += 64) { wqm = fmaxf(wqm, fabsf(a.q_norm_w[i])); wkm = fmaxf(wkm, fabsf(a.k_norm_w[i])); }
#pragma unroll
    for (int o = 1; o < 64; o <<= 1) { wqm = fmaxf(wqm, __shfl_xor(wqm, o)); wkm = fmaxf(wkm, __shfl_xor(wkm, o)); }
    const float qkb2 = 11.313708499f * wqm * wkm * LOG2E * 1.02f;
    const float thr2 = 2.0f * qkb2 + 30.0f * LOG2E;
    LAS int* qi = (LAS int*)(lds + 40960);
    for (;;) {
        __syncthreads();
        if (tid == 0) *qi = (int)atomicAdd(ctl + CW_QUEUE, 1u);
        __syncthreads();
        const int it = *qi;
        if (it >= NB * AH * 64) break;
        attn_item(a, lds, it / (AH * 64), (it / 64) % AH, it % 64, thr2);
    }
}


constexpr size_t WS_H2B = WS_QKV;
constexpr size_t WS_QP = WS_GATES;
constexpr size_t WS_IDS = 992 * MiB;
constexpr size_t WS_GW = 1008 * MiB;
struct EpiPlain {
    static constexpr bool PERM = true;
    bf16_t* o; int ldc;
    DI void operator()(const f32x4 (&acc)[2][2][4][2], const pg8::Unit& un, int wr, int wc, int fr, int fq) const {
        epi_foreach(acc, un, wr, wc, fr, fq, [&](int row, int col0, float (&v)[8]) { store8_bf16(o + (size_t)row * ldc + col0, v); });
    }
};
DI unsigned enc_sortable(float f) { const unsigned u = __float_as_uint(f); return u ^ ((u >> 31) ? 0xffffffffu : 0x80000000u); }
DI float dec_sortable(unsigned s) { return __uint_as_float(s ^ ((s >> 31) ? 0x80000000u : 0xffffffffu)); }
#define TOPK_INSERT(L, x_) do { unsigned _x = (x_); _Pragma("unroll") for (int _k = 0; _k < 16; ++_k) { const unsigned _hi = max(L[_k], _x); _x = min(L[_k], _x); L[_k] = _hi; } } while (0)
DI void sort_bitonic16_desc(unsigned (&M)[16]) {
#pragma unroll
    for (int st = 8; st >= 1; st >>= 1)
#pragma unroll
        for (int i = 0; i < 16; ++i) if ((i & st) == 0) { const unsigned a_ = max(M[i], M[i + st]), b_ = min(M[i], M[i + st]); M[i] = a_; M[i + st] = b_; }
}
template <int N> DI void bitonic_sort_desc(unsigned (&v)[N]) {
#pragma unroll
    for (int k = 2; k <= N; k <<= 1)
#pragma unroll
        for (int j = k >> 1; j > 0; j >>= 1)
#pragma unroll
            for (int i = 0; i < N; ++i) { const int l = i ^ j;
                if (l > i) { const bool desc = (i & k) == 0; const unsigned hi_ = max(v[i], v[l]), lo_ = min(v[i], v[l]); v[i] = desc ? hi_ : lo_; v[l] = desc ? lo_ : hi_; } }
}
DI void merge_top16(unsigned (&A)[16], const unsigned (&B)[16]) {
#pragma unroll
    for (int k = 0; k < 16; ++k) A[k] = max(A[k], B[15 - k]);
    sort_bitonic16_desc(A);
}
DI void peer_select_item(const Args& a, LAS unsigned char* lds, int h, int tile) {
    const int tid = otid(), lane = tid & 63, wave = tid >> 6, q = lane & 31, hh = lane >> 5;
    const bf16_t* keys = (const bf16_t*)(a.ws + WS_KEYS) + (size_t)h * 2 * NKEYS * 128;
    __syncthreads();
    for (int i = tid; i < 2 * NKEYS * 16; i += NTHREADS) {
        const int r = i >> 4, ch = i & 15;
        *(LAS u32x4*)(lds + r * 256 + ((ch ^ (r & 15)) << 4)) = *(const u32x4*)(keys + (size_t)r * 128 + ch * 8);
    }
    __syncthreads();
    const size_t m = (size_t)tile * 256 + wave * 32 + q;
    const bf16_t* qp = (const bf16_t*)(a.ws + WS_QP) + m * D + h * 256;
    unsigned S[2][16];
#pragma unroll
    for (int p = 0; p < 2; ++p) {
        bf16x8 qf[8];
#pragma unroll
        for (int ks = 0; ks < 8; ++ks) qf[ks] = *(const bf16x8*)(qp + p * 128 + ks * 16 + hh * 8);
        f32x16 acc[4];
#pragma unroll
        for (int rb = 0; rb < 4; ++rb) {
#pragma unroll
            for (int r = 0; r < 16; ++r) acc[rb][r] = 0.f;
#pragma unroll
            for (int ks = 0; ks < 8; ++ks) {
                const int r = p * 128 + rb * 32 + q, ch = ks * 2 + hh;
                const bf16x8 kf = *(const LAS bf16x8*)(lds + r * 256 + ((ch ^ (r & 15)) << 4));
                acc[rb] = __builtin_amdgcn_mfma_f32_32x32x16_bf16(kf, qf[ks], acc[rb], 0, 0, 0);
            }
        }
        unsigned K0[16], K1[16], K2[16], K3[16];
#pragma unroll
        for (int r = 0; r < 16; ++r) {
            const unsigned n = (r & 3) + 8 * (r >> 2) + 4 * hh;
            K0[r] = (enc_sortable(acc[0][r]) & ~0x7Fu) | n; K1[r] = (enc_sortable(acc[1][r]) & ~0x7Fu) | (32 + n);
            K2[r] = (enc_sortable(acc[2][r]) & ~0x7Fu) | (64 + n); K3[r] = (enc_sortable(acc[3][r]) & ~0x7Fu) | (96 + n);
        }
        bitonic_sort_desc<16>(K0); bitonic_sort_desc<16>(K1); bitonic_sort_desc<16>(K2); bitonic_sort_desc<16>(K3);
        merge_top16(K0, K1); merge_top16(K2, K3); merge_top16(K0, K2);
        unsigned M[16];
#pragma unroll
        for (int k = 0; k < 16; ++k) { const unsigned pl = __shfl_xor(K0[15 - k], 32); M[k] = max(K0[k], pl); }
        sort_bitonic16_desc(M);
#pragma unroll
        for (int k = 0; k < 16; ++k) S[p][k] = M[k];
    }
    float f0[16], f1[16];
#pragma unroll
    for (int k = 0; k < 16; ++k) { f0[k] = dec_sortable(S[0][k] & ~0x7Fu); f1[k] = dec_sortable(S[1][k] & ~0x7Fu); }
    unsigned R[16], X[32], X2[2];
#pragma unroll
    for (int c = 0; c < 16; ++c) R[c] = (enc_sortable(f0[0] + f1[c]) & ~0xFFu) | (unsigned)c;
    {   int idx = 0;
#pragma unroll
        for (int p = 1; p < 16; ++p)
#pragma unroll
            for (int c = 0; c < 16; ++c) if ((p + 1) * (c + 1) <= 16) {
                const unsigned key = (enc_sortable(f0[p] + f1[c]) & ~0xFFu) | (unsigned)(p * 16 + c);
                if (idx < 32) X[idx] = key; else X2[idx - 32] = key;
                ++idx;
            }
    }
    bitonic_sort_desc<16>(R); bitonic_sort_desc<32>(X);
    {   unsigned XT[16];
#pragma unroll
        for (int k = 0; k < 16; ++k) XT[k] = X[k];
        merge_top16(R, XT); }
    TOPK_INSERT(R, X2[0]); TOPK_INSERT(R, X2[1]);
    unsigned pk0[4] = {0, 0, 0, 0}, pk1[4] = {0, 0, 0, 0};
#pragma unroll
    for (int k = 0; k < 16; ++k) { pk0[k >> 2] |= (S[0][k] & 0x7Fu) << (8 * (k & 3)); pk1[k >> 2] |= (S[1][k] & 0x7Fu) << (8 * (k & 3)); }
    int eid[16]; float ew[16]; float esum = 0.f;
    const float tv0 = dec_sortable(R[0] & ~0xFFu);
#pragma unroll
    for (int r = 0; r < 16; ++r) {
        const unsigned pq = R[r] & 0xFFu, p = pq >> 4, c = pq & 15u;
        unsigned w0 = pk0[0], w1 = pk1[0];
        w0 = (p >> 2) == 1 ? pk0[1] : w0; w0 = (p >> 2) == 2 ? pk0[2] : w0; w0 = (p >> 2) == 3 ? pk0[3] : w0;
        w1 = (c >> 2) == 1 ? pk1[1] : w1; w1 = (c >> 2) == 2 ? pk1[2] : w1; w1 = (c >> 2) == 3 ? pk1[3] : w1;
        const unsigned i0 = (w0 >> (8 * (p & 3))) & 0x7Fu, i1 = (w1 >> (8 * (c & 3))) & 0x7Fu;
        eid[r] = (int)(i0 * NKEYS + i1);
        ew[r] = __expf(dec_sortable(R[r] & ~0xFFu) - tv0); esum += ew[r];
    }
    const float inv = 1.0f / esum;
    if (hh == 0) {
        unsigned short* o = (unsigned short*)(a.ws + WS_IDS) + m * NSEL + h * 16;
#pragma unroll
        for (int r = 0; r < 16; r += 8) *(u32x4*)(o + r) = (u32x4){(unsigned)eid[r] | ((unsigned)eid[r + 1] << 16), (unsigned)eid[r + 2] | ((unsigned)eid[r + 3] << 16),
                                                                   (unsigned)eid[r + 4] | ((unsigned)eid[r + 5] << 16), (unsigned)eid[r + 6] | ((unsigned)eid[r + 7] << 16)};
    } else {
        float* o = (float*)(a.ws + WS_GW) + m * NSEL + h * 16;
#pragma unroll
        for (int r = 0; r < 16; r += 4) *(f32x4*)(o + r) = (f32x4){ew[r] * inv, ew[r + 1] * inv, ew[r + 2] * inv, ew[r + 3] * inv};
    }
}
DI void phase9(const Args& a, LAS unsigned char* lds) {
    if (gridDim.x == 256) {
        const int c = blockIdx.x, tile = 16 * (c & 7) + ((c >> 3) & 15), h0 = 4 * (c >> 7);
        for (int hh = 0; hh < 4; ++hh) peer_select_item(a, lds, h0 + hh, tile);
    } else
        for (int it = blockIdx.x; it < PH * (T / 256); it += gridDim.x) peer_select_item(a, lds, it / (T / 256), it % (T / 256));
}

#ifndef EPB
#define EPB 16
#endif
#ifndef EPB2
#define EPB2 8
#endif
DI void phase10(const Args& a) {
    const int tid = otid(), lane = tid & 63, wave = tid >> 6;
    const int gw = blockIdx.x * NWAVES + wave, NGW = gridDim.x * NWAVES;
    const unsigned char* PU = a.ws + WS_PU; const unsigned char* PV = a.ws + WS_PV;
    const float* PUS = (const float*)(a.ws + WS_PUS); const float* PVS = (const float*)(a.ws + WS_PVS);
    const float* mod = (const float*)(a.ws + WS_CTL) + CW_MOD;
    (void)gw;
    for (int ri = 0; ri < (T + NGW - 1) / NGW; ++ri) {
        const int m = affine_row(blockIdx.x, wave, ri, gridDim.x);
        if (m >= T) break;
        const int b = m >> 14;
        const int* ids = (const int*)(a.ws + WS_IDS) + (size_t)m * NSEL; const float* gwp = (const float*)(a.ws + WS_GW) + (size_t)m * NSEL;
        const int idA = ids[lane], idB = ids[64 + lane];
        const float gA = gwp[lane] * PVS[idA], gB = gwp[64 + lane] * PVS[idB];
        const float suA = PUS[idA], suB = PUS[idB];
        const bf16_t* hrow = (const bf16_t*)(a.ws + WS_H2B) + (size_t)m * D + 32 * lane;
        unsigned hp[16];
#pragma unroll
        for (int q = 0; q < 4; ++q) { const u32x4 t4 = *(const u32x4*)(hrow + 8 * q); hp[4 * q] = t4[0]; hp[4 * q + 1] = t4[1]; hp[4 * q + 2] = t4[2]; hp[4 * q + 3] = t4[3]; }
        float cf[4];
#pragma unroll
        for (int bt = 0; bt < 4; ++bt) {
            float part[32];
#pragma unroll
            for (int i0 = 0; i0 < 32; i0 += EPB) {
                v6u uw[EPB];
#pragma unroll
                for (int i = 0; i < EPB; ++i) {
                    const int id = __builtin_amdgcn_readlane(bt < 2 ? idA : idB, (bt & 1) * 32 + i0 + i);
                    uw[i] = fp6_load(PU + (size_t)id * ROWB, lane);
                }
#pragma unroll
                for (int i = 0; i < EPB; ++i) {
                    const v16u rp = fp6_unpack_bf16(uw[i]);
                    float s = 0.f;
#pragma unroll
                    for (int k = 0; k < 16; ++k) { const unsigned pu = rp[k], ph = hp[k];
                        s = __builtin_amdgcn_fdot2_f32_bf16(__builtin_bit_cast(bf16x2_t, ph), __builtin_bit_cast(bf16x2_t, pu), s, false); }
                    part[i0 + i] = s;
                }
                __builtin_amdgcn_sched_barrier(0);
            }
            float p16[16], p8[8], p4[4], p2[2], p1;
            { const bool hi = lane & 32;
#pragma unroll
              for (int i = 0; i < 16; ++i) { const float snd = hi ? part[i] : part[i + 16], kp = hi ? part[i + 16] : part[i]; p16[i] = kp + __shfl_xor(snd, 32); } }
            { const bool hi = lane & 16;
#pragma unroll
              for (int i = 0; i < 8; ++i) { const float snd = hi ? p16[i] : p16[i + 8], kp = hi ? p16[i + 8] : p16[i]; p8[i] = kp + __shfl_xor(snd, 16); } }
            { const bool hi = lane & 8;
#pragma unroll
              for (int i = 0; i < 4; ++i) { const float snd = hi ? p8[i] : p8[i + 4], kp = hi ? p8[i + 4] : p8[i]; p4[i] = kp + __shfl_xor(snd, 8); } }
            { const bool hi = lane & 4;
#pragma unroll
              for (int i = 0; i < 2; ++i) { const float snd = hi ? p4[i] : p4[i + 2], kp = hi ? p4[i + 2] : p4[i]; p2[i] = kp + __shfl_xor(snd, 4); } }
            { const bool hi = lane & 2; const float snd = hi ? p2[0] : p2[1], kp = hi ? p2[1] : p2[0]; p1 = kp + __shfl_xor(snd, 2); }
            p1 += __shfl_xor(p1, 1);
            const int src_lane = (bt & 1) * 32 + (lane >> 1);
            const float g = __shfl(bt < 2 ? gA : gB, src_lane), su = __shfl(bt < 2 ? suA : suB, src_lane);
            cf[bt] = geluf_(p1 * su) * g;
        }
        f32x2 acc[16];
#pragma unroll
        for (int k = 0; k < 16; ++k) acc[k] = (f32x2){0.f, 0.f};
#pragma unroll
        for (int bt = 0; bt < 4; ++bt) {
#pragma unroll 1
            for (int i0 = 0; i0 < 32; i0 += EPB2) {
                __builtin_amdgcn_sched_barrier(0);
                v6u vw[EPB2]; float cs[EPB2];
#pragma unroll
                for (int i = 0; i < EPB2; ++i) {
                    const int id = __builtin_amdgcn_readlane(bt < 2 ? idA : idB, (bt & 1) * 32 + i0 + i);
                    cs[i] = __uint_as_float((unsigned)__builtin_amdgcn_readlane((int)__float_as_uint(cf[bt]), 2 * (i0 + i)));
                    vw[i] = fp6_load(PV + (size_t)id * ROWB, lane);
                }
#pragma unroll
                for (int i = 0; i < EPB2; ++i) {
                    const v32f r = fp6_unpack_f32(vw[i]);
                    const f32x2 c2 = (f32x2){cs[i], cs[i]};
#pragma unroll
                    for (int k = 0; k < 16; ++k) acc[k] = __builtin_elementwise_fma(c2, (f32x2){r[2 * k], r[2 * k + 1]}, acc[k]);
                }
            }
        }
        float* orow = a.out + (size_t)m * D + 32 * lane;
        const float* gp = mod + b * NMOD + 5 * D + 32 * lane;
#pragma unroll
        for (int k4 = 0; k4 < 8; ++k4) {
            const f32x4 g2 = *(const f32x4*)(gp + 4 * k4);
            f32x4 xv = *(const f32x4*)(orow + 4 * k4);
#pragma unroll
            for (int k = 0; k < 4; ++k) xv[k] += g2[k] * acc[2 * k4 + (k >> 1)][k & 1];
            *(f32x4*)(orow + 4 * k4) = xv;
        }
    }
}


DI void phase10_fp4(const Args& a) {
    const int tid = otid(), lane = tid & 63, wave = tid >> 6;
    const int gw = blockIdx.x * NWAVES + wave, NGW = gridDim.x * NWAVES;
    const unsigned char* PU = a.ws + WS_PU; const unsigned char* PV = a.ws + WS_PV; const unsigned char* PUE = a.ws + WS_PUE; const unsigned char* PVE = a.ws + WS_PVE;
    const float* mod = (const float*)(a.ws + WS_CTL) + CW_MOD;
    (void)gw;
    for (int ri = 0; ri < (T + NGW - 1) / NGW; ++ri) {
        const int m = affine_row(blockIdx.x, wave, ri, gridDim.x);
        if (m >= T) break;
        const int b = m >> 14;
        const int* ids = (const int*)(a.ws + WS_IDS) + (size_t)m * NSEL; const float* gwp = (const float*)(a.ws + WS_GW) + (size_t)m * NSEL;
        const int idA = ids[lane], idB = ids[64 + lane];
        const float gA = gwp[lane], gB = gwp[64 + lane];
        const bf16_t* hrow = (const bf16_t*)(a.ws + WS_H2B) + (size_t)m * D + 32 * lane;
        f32x2 hf[16];
#pragma unroll
        for (int q = 0; q < 4; ++q) { const u32x4 t4 = *(const u32x4*)(hrow + 8 * q);
#pragma unroll
            for (int z = 0; z < 4; ++z) { const unsigned pw = t4[z]; hf[4 * q + z] = (f32x2){bflo(pw), bfhi(pw)}; } }
        float cf[4];
#pragma unroll
        for (int bt = 0; bt < 4; ++bt) {
            float part[32];
#pragma unroll
            for (int i0 = 0; i0 < 32; i0 += EPB) {
                u32x4 uw[EPB]; unsigned ue[EPB];
#pragma unroll
                for (int i = 0; i < EPB; ++i) {
                    const int id = __builtin_amdgcn_readlane(bt < 2 ? idA : idB, (bt & 1) * 32 + i0 + i);
                    uw[i] = *(const u32x4*)(PU + (size_t)id * ROWB4 + 16 * lane); ue[i] = PUE[(size_t)id * 64 + lane];
                }
#pragma unroll
                for (int i = 0; i < EPB; ++i) {
                    f32x2 s2 = (f32x2){0.f, 0.f};
#pragma unroll
                    for (int d = 0; d < 4; ++d) { f32x2 r[4]; const unsigned wd = uw[i][d]; fp4_unpack8(wd, r);
#pragma unroll
                        for (int z = 0; z < 4; ++z) s2 = __builtin_elementwise_fma(hf[4 * d + z], r[z], s2); }
                    part[i0 + i] = (s2[0] + s2[1]) * __uint_as_float(ue[i] << 23);
                }
                __builtin_amdgcn_sched_barrier(0);
            }
            float p16[16], p8[8], p4[4], p2[2], p1;
            { const bool hi = lane & 32;
#pragma unroll
              for (int i = 0; i < 16; ++i) { const float snd = hi ? part[i] : part[i + 16], kp = hi ? part[i + 16] : part[i]; p16[i] = kp + __shfl_xor(snd, 32); } }
            { const bool hi = lane & 16;
#pragma unroll
              for (int i = 0; i < 8; ++i) { const float snd = hi ? p16[i] : p16[i + 8], kp = hi ? p16[i + 8] : p16[i]; p8[i] = kp + __shfl_xor(snd, 16); } }
            { const bool hi = lane & 8;
#pragma unroll
              for (int i = 0; i < 4; ++i) { const float snd = hi ? p8[i] : p8[i + 4], kp = hi ? p8[i + 4] : p8[i]; p4[i] = kp + __shfl_xor(snd, 8); } }
            { const bool hi = lane & 4;
#pragma unroll
              for (int i = 0; i < 2; ++i) { const float snd = hi ? p4[i] : p4[i + 2], kp = hi ? p4[i + 2] : p4[i]; p2[i] = kp + __shfl_xor(snd, 4); } }
            { const bool hi = lane & 2; const float snd = hi ? p2[0] : p2[1], kp = hi ? p2[1] : p2[0]; p1 = kp + __shfl_xor(snd, 2); }
            p1 += __shfl_xor(p1, 1);
            const float g = __shfl(bt < 2 ? gA : gB, (bt & 1) * 32 + (lane >> 1));
            cf[bt] = geluf_(p1) * g;
        }
        f32x2 acc[16];
#pragma unroll
        for (int k = 0; k < 16; ++k) acc[k] = (f32x2){0.f, 0.f};
#pragma unroll
        for (int bt = 0; bt < 4; ++bt) {
#pragma unroll 1
            for (int i0 = 0; i0 < 32; i0 += EPB2) {
                __builtin_amdgcn_sched_barrier(0);
                u32x4 vw[EPB2]; unsigned ve[EPB2]; float cs[EPB2];
#pragma unroll
                for (int i = 0; i < EPB2; ++i) {
                    const int id = __builtin_amdgcn_readlane(bt < 2 ? idA : idB, (bt & 1) * 32 + i0 + i);
                    cs[i] = __uint_as_float((unsigned)__builtin_amdgcn_readlane((int)__float_as_uint(cf[bt]), 2 * (i0 + i)));
                    vw[i] = *(const u32x4*)(PV + (size_t)id * ROWB4 + 16 * lane); ve[i] = PVE[(size_t)id * 64 + lane];
                }
#pragma unroll
                for (int i = 0; i < EPB2; ++i) {
                    const float cl = cs[i] * __uint_as_float(ve[i] << 23);
                    const f32x2 c2 = (f32x2){cl, cl};
#pragma unroll
                    for (int d = 0; d < 4; ++d) { f32x2 r[4]; const unsigned wd = vw[i][d]; fp4_unpack8(wd, r);
#pragma unroll
                        for (int z = 0; z < 4; ++z) acc[4 * d + z] = __builtin_elementwise_fma(c2, r[z], acc[4 * d + z]); }
                }
            }
        }
        float* orow = a.out + (size_t)m * D + 32 * lane;
        const float* gp = mod + b * NMOD + 5 * D + 32 * lane;
#pragma unroll
        for (int k4 = 0; k4 < 8; ++k4) {
            const f32x4 g2 = *(const f32x4*)(gp + 4 * k4);
            f32x4 xv = *(const f32x4*)(orow + 4 * k4);
#pragma unroll
            for (int k = 0; k < 4; ++k) xv[k] += g2[k] * acc[2 * k4 + (k >> 1)][k & 1];
            *(f32x4*)(orow + 4 * k4) = xv;
        }
    }
}

constexpr size_t WS_SP = WS_GATES + 128 * MiB;
constexpr size_t WS_CF = WS_U;
struct SliceMap { int NS, grp, wv, nwv; };
DI SliceMap slice_map(int blk, int wave, int G) {
    SliceMap s; s.NS = G < 8 ? G : 8; s.grp = blk % s.NS; s.wv = (blk / s.NS) * NWAVES + wave; s.nwv = ((G - s.grp + s.NS - 1) / s.NS) * NWAVES; return s;
}
template <int CTRL> DI float dppf(float x) { return __builtin_bit_cast(float, __builtin_amdgcn_mov_dpp(__builtin_bit_cast(int, x), CTRL, 0xf, 0xf, true)); }
constexpr int DPP_XOR1 = 0xB1, DPP_XOR2 = 0x4E, DPP_MIR8 = 0x141, DPP_XOR8 = 0x128;
DI void hdigits_pass(const Args& a) {
    const int tid = otid(), lane = tid & 63, wave = tid >> 6;
    const int NGW = gridDim.x * NWAVES;
    for (int ri = 0; ri < (T + NGW - 1) / NGW; ++ri) {
        const int m = affine_row(blockIdx.x, wave, ri, gridDim.x);
        if (m >= T) break;
        const bf16_t* hrow = (const bf16_t*)(a.ws + WS_H2B) + (size_t)m * D + 32 * lane;
        u32x4 t4[4]; float mx = 0.f;
#pragma unroll
        for (int q = 0; q < 4; ++q) { t4[q] = *(const u32x4*)(hrow + 8 * q);
#pragma unroll
            for (int z = 0; z < 4; ++z) mx = fmaxf(mx, fmaxf(fabsf(bflo(t4[q][z])), fabsf(bfhi(t4[q][z])))); }
        mx = fmaxf(mx, dppf<DPP_XOR1>(mx)); mx = fmaxf(mx, dppf<DPP_XOR2>(mx)); mx = fmaxf(mx, dppf<DPP_MIR8>(mx));
        const float step = mx * (1.0f / 119.0f), S = mx > 0.f ? 119.0f / mx : 0.f;
        unsigned p0[4], p1[4];
#pragma unroll
        for (int d = 0; d < 4; ++d) {
            unsigned a0 = 0u, a1 = 0u;
#pragma unroll
            for (int e = 0; e < 8; ++e) {
                const unsigned pw = t4[d][e >> 1]; const float x = (e & 1) ? bfhi(pw) : bflo(pw);
                const int q = (int)rintf(x * S), q1 = (q + 8) >> 4;
                a0 |= ((unsigned)q & 15u) << (4 * e); a1 |= ((unsigned)q1 & 15u) << (4 * e);
            }
            p0[d] = a0; p1[d] = a1;
        }
        u32x4* dst = (u32x4*)(a.ws + WS_H4) + ((size_t)m * 64 + lane) * 2;
        dst[0] = (u32x4){p0[0], p0[1], p0[2], p0[3]}; dst[1] = (u32x4){p1[0], p1[1], p1[2], p1[3]};
        if ((lane & 7) == 0) ((float*)(a.ws + WS_HS))[(size_t)m * 8 + (lane >> 3)] = step;
    }
}
DI void p10a_issue(const unsigned char* pu, LAS unsigned char* lds, int idv, int gl, unsigned lo16, unsigned lo1, u32x4 (&uw)[8], unsigned (&uc)[8]) {
#pragma unroll
    for (int j = 0; j < 8; ++j) {
        const unsigned id = (unsigned)__shfl(idv, gl | j);
        uw[j] = *(const u32x4*)(pu + ((id << 10) + lo16)); uc[j] = lds[(id << 3) + lo1];
    }
}
DI float p10a_math(const u32x4 (&uw)[8], const unsigned (&uc)[8], LAS unsigned char* lds, const u32x4& c0, const u32x4& c1, int i) {
    float o = 0.f;
    float us[8];
#pragma unroll
    for (int j = 0; j < 8; ++j) us[j] = ((LAS float*)(lds + NEXP * 8))[uc[j]];
#pragma unroll
    for (int j = 0; j < 8; ++j) {
        int acc;
        asm("v_dot8_i32_i4 %0, %1, %2, 0" : "=v"(acc) : "v"(uw[j][0]), "v"(c1[0]));
#pragma unroll
        for (int d = 1; d < 4; ++d) acc = __builtin_amdgcn_sdot8((int)uw[j][d], (int)c1[d], acc, false);
        acc <<= 4;
#pragma unroll
        for (int d = 0; d < 4; ++d) acc = __builtin_amdgcn_sdot8((int)uw[j][d], (int)c0[d], acc, false);
        float v = (float)acc * us[j];
        asm("" : "+v"(v));
        v += dppf<DPP_XOR1>(v); v += dppf<DPP_XOR2>(v); v += dppf<DPP_MIR8>(v);
        o = (i == j) ? v : o;
    }
    return o;
}
DI void phase10a_u4(const Args& a, LAS unsigned char* lds) {
    const int tid = otid(), lane = tid & 63, wave = tid >> 6;
    const SliceMap sm = slice_map(blockIdx.x, wave, gridDim.x);
    const int g = lane >> 3, i = lane & 7, gl = lane & 56;
    const unsigned lo16 = 16u * i, lo1 = (unsigned)i;
    for (int x = sm.grp; x < 8; x += sm.NS) {
        const unsigned char* pu = a.ws + WS_PU + 128 * x;
        {
            __syncthreads();
            const u32x4* s4 = (const u32x4*)(a.ws + WS_PUS4 + (size_t)x * (NEXP * 8));
            for (int q = tid; q < NEXP * 8 / 16; q += NTHREADS) *(LAS u32x4*)(lds + 16 * q) = s4[q];
            if (tid < 256) ((LAS float*)(lds + NEXP * 8))[tid] = u4_step(tid);
            __syncthreads();
        }
        bf16_t* sp = (bf16_t*)(a.ws + WS_SP) + (size_t)x * T * NSEL + 16 * g + i;
        const unsigned short* idb = (const unsigned short*)(a.ws + WS_IDS) + 16 * g + i;
        const u32x4* h4 = (const u32x4*)(a.ws + WS_H4) + (size_t)(8 * x + i) * 2;
        const float* hsb = (const float*)(a.ws + WS_HS) + x;
        int t = sm.wv;
        if (t >= T) continue;
        int idlo = idb[(size_t)t * NSEL], idhi = idb[(size_t)t * NSEL + 8];
        u32x4 hp0 = h4[(size_t)t * 128], hp1 = h4[(size_t)t * 128 + 1];
        float hs = hsb[(size_t)t * 8];
        u32x4 uwA[8], uwB[8]; unsigned usA[8], usB[8];
        p10a_issue(pu, lds, idlo, gl, lo16, lo1, uwA, usA);
#pragma unroll 1
        for (; t < T; t += sm.nwv) {
            __builtin_amdgcn_sched_barrier(0);
            const u32x4 c0 = hp0, c1 = hp1; const float chs = hs; const int cidhi = idhi;
            {   const int tn = (t + sm.nwv < T) ? t + sm.nwv : t;
                idlo = idb[(size_t)tn * NSEL]; idhi = idb[(size_t)tn * NSEL + 8];
                hp0 = h4[(size_t)tn * 128]; hp1 = h4[(size_t)tn * 128 + 1]; hs = hsb[(size_t)tn * 8];
            }
            p10a_issue(pu, lds, cidhi, gl, lo16, lo1, uwB, usB);
            __builtin_amdgcn_sched_barrier(0);
            const float olo = p10a_math(uwA, usA, lds, c0, c1, i);
            __builtin_amdgcn_sched_barrier(0);
            p10a_issue(pu, lds, idlo, gl, lo16, lo1, uwA, usA);
            __builtin_amdgcn_sched_barrier(0);
            const float ohi = p10a_math(uwB, usB, lds, c0, c1, i);
            { const unsigned pw = pk2(olo * chs, ohi * chs); sp[(size_t)t * NSEL] = (bf16_t)(pw & 0xffffu); sp[(size_t)t * NSEL + 8] = (bf16_t)(pw >> 16); }
        }
    }
}
DI void phase10a_fp4(const Args& a) {
    const int tid = otid(), lane = tid & 63, wave = tid >> 6;
    const SliceMap sm = slice_map(blockIdx.x, wave, gridDim.x);
    const int g = lane >> 3, i = lane & 7, gl = lane & 56;
    for (int x = sm.grp; x < 8; x += sm.NS) {
        const unsigned char* pu = a.ws + WS_PU + 128 * x + 16 * i; const unsigned char* pe = a.ws + WS_PUE + 8 * x + i;
        float* sp = (float*)(a.ws + WS_SP) + (size_t)x * T * NSEL + 16 * g + i;
        const int* idb = (const int*)(a.ws + WS_IDS) + 16 * g + i;
        const bf16_t* hb = (const bf16_t*)(a.ws + WS_H2B) + 256 * x + 32 * i;
        int t = sm.wv;
        if (t >= T) continue;
        int idlo = idb[(size_t)t * NSEL], idhi = idb[(size_t)t * NSEL + 8];
        u32x4 hr[4];
#pragma unroll
        for (int q = 0; q < 4; ++q) hr[q] = *(const u32x4*)(hb + (size_t)t * D + 8 * q);
#pragma unroll 1
        for (; t < T; t += sm.nwv) {
            __builtin_amdgcn_sched_barrier(0);
            u32x4 uw[16]; unsigned ue[16];
#pragma unroll
            for (int j = 0; j < 16; ++j) {
                const int id = __shfl(j < 8 ? idlo : idhi, gl | (j & 7));
                uw[j] = *(const u32x4*)(pu + (size_t)id * ROWB4); ue[j] = pe[(size_t)id * 64];
            }
            f32x2 hf[16];
#pragma unroll
            for (int q = 0; q < 4; ++q) {
#pragma unroll
                for (int z = 0; z < 4; ++z) { const unsigned pw = hr[q][z]; hf[4 * q + z] = (f32x2){bflo(pw), bfhi(pw)}; } }
            {   const int tn = (t + sm.nwv < T) ? t + sm.nwv : t;
                idlo = idb[(size_t)tn * NSEL]; idhi = idb[(size_t)tn * NSEL + 8];
#pragma unroll
                for (int q = 0; q < 4; ++q) hr[q] = *(const u32x4*)(hb + (size_t)tn * D + 8 * q);
            }
            __builtin_amdgcn_sched_barrier(0);
            float olo = 0.f, ohi = 0.f;
#pragma unroll
            for (int j = 0; j < 16; ++j) {
                f32x2 s2 = (f32x2){0.f, 0.f};
#if XTRA == 2
                f32x2 s3 = (f32x2){1.f, 1.f};
#endif
#pragma unroll
                for (int d = 0; d < 4; ++d) { f32x2 r[4]; const unsigned wd = uw[j][d]; fp4_unpack8(wd, r);
#if XTRA == 1
                    { unsigned wd2 = wd; asm volatile("" : "+v"(wd2)); f32x2 r2[4]; fp4_unpack8(wd2, r2); asm volatile("" :: "v"(r2[0]), "v"(r2[1]), "v"(r2[2]), "v"(r2[3])); }
#endif
#if XTRA == 2
#pragma unroll
                    for (int z = 0; z < 4; ++z) s3 = __builtin_elementwise_fma(hf[4 * d + z], r[z], s3);
#endif
#pragma unroll
                    for (int z = 0; z < 4; ++z) s2 = __builtin_elementwise_fma(hf[4 * d + z], r[z], s2); }
#if XTRA == 2
                asm volatile("" :: "v"(s3));
#endif
                float v = (s2[0] + s2[1]) * __uint_as_float(ue[j] << 23);
                v += __shfl_xor(v, 1); v += __shfl_xor(v, 2); v += __shfl_xor(v, 4);
                if (j < 8) olo = (i == j) ? v : olo; else ohi = (i == j - 8) ? v : ohi;
            }
            sp[(size_t)t * NSEL] = olo; sp[(size_t)t * NSEL + 8] = ohi;
        }
    }
}
DI void phase10b(const Args& a) {
    const int gt = blockIdx.x * NTHREADS + otid(), NT = gridDim.x * NTHREADS;
    const u32x2* sp = (const u32x2*)(a.ws + WS_SP); const f32x4* gw = (const f32x4*)(a.ws + WS_GW); u32x2* cf = (u32x2*)(a.ws + WS_CF);
    constexpr int N4 = T * NSEL / 4;
    for (int q = gt; q < N4; q += NT) {
        f32x4 s = (f32x4){0.f, 0.f, 0.f, 0.f};
#pragma unroll
        for (int x = 0; x < 8; ++x) { const u32x2 w = sp[(size_t)x * N4 + q]; s += (f32x4){bflo(w.x), bfhi(w.x), bflo(w.y), bfhi(w.y)}; }
        const f32x4 gg = gw[q];
        f32x4 o;
#pragma unroll
        for (int k = 0; k < 4; ++k) o[k] = geluf_(s[k]) * gg[k];
        cf[q] = (u32x2){pk2(o[0], o[1]), pk2(o[2], o[3])};
    }
}
DI void phase10c_fp4(const Args& a, LAS unsigned char* lds) {
    const int tid = otid(), lane = tid & 63, wave = tid >> 6;
    const SliceMap sm = slice_map(blockIdx.x, wave, gridDim.x);
    const int g = lane >> 3, i = lane & 7, gl = lane & 56;
    const float* mod = (const float*)(a.ws + WS_CTL) + CW_MOD;
    for (int x = sm.grp; x < 8; x += sm.NS) {
        const unsigned char* pv = a.ws + WS_PV + 128 * x;
        const unsigned lo16 = 16u * i, lo1 = (unsigned)i;
        {
            __syncthreads();
            const u32x4* s4 = (const u32x4*)(a.ws + WS_PVE + (size_t)x * (NEXP * 8));
            for (int q = tid; q < NEXP * 8 / 16; q += NTHREADS) *(LAS u32x4*)(lds + 16 * q) = s4[q];
            __syncthreads();
        }
        const unsigned short* idb = (const unsigned short*)(a.ws + WS_IDS) + 16 * g + i;
        const bf16_t* cfb = (const bf16_t*)(a.ws + WS_CF) + 16 * g + i;
        const int col = 256 * x + 32 * i + 16 * ((lane >> 5) & 1) + 8 * ((lane >> 4) & 1) + 4 * ((lane >> 3) & 1);
        int t = sm.wv;
        if (t >= T) continue;
        int idlo = idb[(size_t)t * NSEL], idhi = idb[(size_t)t * NSEL + 8];
        float clo = bf2f(cfb[(size_t)t * NSEL]), chi = bf2f(cfb[(size_t)t * NSEL + 8]);
#pragma unroll 1
        for (; t < T; t += sm.nwv) {
            __builtin_amdgcn_sched_barrier(0);
            u32x4 vw[16]; unsigned ve[16]; float cs[16];
#pragma unroll
            for (int j = 0; j < 16; ++j) {
                const unsigned id = (unsigned)__shfl(j < 8 ? idlo : idhi, gl | (j & 7));
                cs[j] = __shfl(j < 8 ? clo : chi, gl | (j & 7));
                vw[j] = *(const u32x4*)(pv + ((id << 10) + lo16)); ve[j] = lds[(id << 3) + lo1];
            }
            {   const int tn = (t + sm.nwv < T) ? t + sm.nwv : t;
                idlo = idb[(size_t)tn * NSEL]; idhi = idb[(size_t)tn * NSEL + 8];
                clo = bf2f(cfb[(size_t)tn * NSEL]); chi = bf2f(cfb[(size_t)tn * NSEL + 8]);
            }
            float* orow = a.out + (size_t)t * D + col;
            const u32x2 xw = *(const u32x2*)(x1b_row(a.ws, t) + col);
            f32x4 xv = (f32x4){bflo(xw.x), bfhi(xw.x), bflo(xw.y), bfhi(xw.y)};
            const f32x4 g2 = *(const f32x4*)(mod + (t >> 14) * NMOD + 5 * D + col);
            __builtin_amdgcn_sched_barrier(0);
            f32x2 acc[16];
#pragma unroll
            for (int k = 0; k < 16; ++k) acc[k] = (f32x2){0.f, 0.f};
#pragma unroll
            for (int j = 0; j < 16; ++j) {
                const float bs = __uint_as_float(ve[j] << 23);
                const f32x2 c2 = (f32x2){cs[j], cs[j]};
#pragma unroll
                for (int d = 0; d < 4; ++d) { f32x2 r[4]; const unsigned wd = vw[j][d];
                    r[0] = __builtin_amdgcn_cvt_scalef32_pk_f32_fp4(wd, bs, 0); r[1] = __builtin_amdgcn_cvt_scalef32_pk_f32_fp4(wd, bs, 1);
                    r[2] = __builtin_amdgcn_cvt_scalef32_pk_f32_fp4(wd, bs, 2); r[3] = __builtin_amdgcn_cvt_scalef32_pk_f32_fp4(wd, bs, 3);
#pragma unroll
                    for (int z = 0; z < 4; ++z) acc[4 * d + z] = __builtin_elementwise_fma(c2, r[z], acc[4 * d + z]); }
            }
            f32x2 q8[8], q4[4], q2[2];
#pragma unroll
            for (int k = 0; k < 8; ++k) {
#pragma unroll
                for (int c = 0; c < 2; ++c) { const auto r = __builtin_amdgcn_permlane32_swap(__float_as_uint(acc[k][c]), __float_as_uint(acc[8 + k][c]), false, false);
                    q8[k][c] = __uint_as_float(r[0]) + __uint_as_float(r[1]); } }
#pragma unroll
            for (int k = 0; k < 4; ++k) {
#pragma unroll
                for (int c = 0; c < 2; ++c) { const auto r = __builtin_amdgcn_permlane16_swap(__float_as_uint(q8[k][c]), __float_as_uint(q8[4 + k][c]), false, false);
                    q4[k][c] = __uint_as_float(r[0]) + __uint_as_float(r[1]); } }
            { const bool hi = lane & 8;
#pragma unroll
              for (int k = 0; k < 2; ++k) {
#pragma unroll
                  for (int c = 0; c < 2; ++c) { const float kp = hi ? q4[2 + k][c] : q4[k][c], sd = hi ? q4[k][c] : q4[2 + k][c]; q2[k][c] = kp + dppf<DPP_XOR8>(sd); } } }
            xv[0] += g2[0] * q2[0][0]; xv[1] += g2[1] * q2[0][1]; xv[2] += g2[2] * q2[1][0]; xv[3] += g2[3] * q2[1][1];
            *(f32x4*)orow = xv;
        }
    }
}

#if DBG
DI float naive_mod(const Args& a, int b, int n) {
    float s = a.b_ada[n];
    for (int k = 0; k < D; ++k) s += siluf_(a.c[b * D + k]) * a.w_ada[(size_t)k * NMOD + n];
    return s;
}
DI void check_p0(const Args& a) {
    unsigned* ctl = (unsigned*)(a.ws + WS_CTL);
    const int gt = blockIdx.x * NTHREADS + otid();
    const float* mod = (const float*)ctl + CW_MOD;
    if (gt < 256) { const int b = gt & 1, n = (gt * 97 + 13) % NMOD; const float ref = naive_mod(a, b, n); dbg_report(ctl, 0, relerr(mod[b * NMOD + n], ref, 0.02f)); }
    else if (gt < 1280) {
        const int i = gt - 256; const unsigned h = (unsigned)i * 2654435761u;
        {   const int n = h % NPROJ, k = (h >> 13) % D; const int nsrc = n < 3072 ? n : n + 8;
            dbg_report(ctl, 1, relerr(bf2f(((const bf16_t*)(a.ws + WS_WIN))[(size_t)n * D + k]), a.w_in[(size_t)k * INW + nsrc], 1e-3f) * 0.5f); }
        {   const int n = h % D, k = (h >> 12) % SW; dbg_report(ctl, 1, relerr(bf2f(((const bf16_t*)(a.ws + WS_WSSM))[(size_t)n * SW + k]), a.w_ssm_up[(size_t)k * D + n], 1e-3f) * 0.5f); }
        {   const int n = h % D, k = (h >> 12) % AW; dbg_report(ctl, 1, relerr(bf2f(((const bf16_t*)(a.ws + WS_WATTN))[(size_t)n * AW + k]), a.w_attn_up[(size_t)k * D + n], 1e-3f) * 0.5f); }
        {   const int n = h % D, k = (h >> 12) % D; dbg_report(ctl, 1, relerr(bf2f(((const bf16_t*)(a.ws + WS_WOUT))[(size_t)n * D + k]), a.w_out[(size_t)k * D + n], 1e-3f) * 0.5f);
            dbg_report(ctl, 1, relerr(bf2f(((const bf16_t*)(a.ws + WS_WPQ))[(size_t)n * D + k]), a.w_peer_q[(size_t)k * D + n], 1e-3f) * 0.5f); }
        {   const int n = h % SW, k = (h >> 12) % SW; dbg_report(ctl, 1, relerr(bf2f(((const bf16_t*)(a.ws + WS_WGLU))[(size_t)n * SW + k]), a.w_glu[(size_t)k * SW + n], 1e-3f) * 0.5f); }
        {   const size_t e = ((size_t)h * 8191u + i) % ((size_t)NEXP * D); const int er = (int)(e >> 11), ek = (int)(e & 2047);
#if TAB4
            dbg_report(ctl, 1, relerr(fp4_at(a.ws + WS_PU + (size_t)er * ROWB4, a.ws + WS_PUE + (size_t)er * 64, ek), a.peer_u[e], 5e-2f) * 0.012f);
            dbg_report(ctl, 1, relerr(fp4_at(a.ws + WS_PV + (size_t)er * ROWB4, a.ws + WS_PVE + (size_t)er * 64, ek), a.peer_v[e], 6e-1f) * 0.012f); }
#else
            dbg_report(ctl, 1, relerr(fp6_at(a.ws + WS_PU + (size_t)er * ROWB, ek) * ((const float*)(a.ws + WS_PUS))[er], a.peer_u[e], 5e-2f) * 0.05f);
            dbg_report(ctl, 1, relerr(fp6_at(a.ws + WS_PV + (size_t)er * ROWB, ek) * ((const float*)(a.ws + WS_PVS))[er], a.peer_v[e], 6e-1f) * 0.05f); }
#endif
        {   const size_t e = (size_t)h % (16 * 128 * 128); dbg_report(ctl, 1, relerr(bf2f(((const bf16_t*)(a.ws + WS_KEYS))[e]), a.sub_keys[e], 1e-3f) * 0.5f); }
    }
}
DI void check_p1(const Args& a) {
    unsigned* ctl = (unsigned*)(a.ws + WS_CTL);
    const int tid_ = otid(); const int lane = tid_ & 63, gw = blockIdx.x * NWAVES + (tid_ >> 6);
    if (gw >= 64) return;
    const int m = (int)(((unsigned)gw * 2654435761u) % T), b = m >> 14;
    const float* mod = (const float*)ctl + CW_MOD;
    const float* xr = a.x + (size_t)m * D;
    float ss = 0.f;
    for (int k = lane; k < D; k += 64) ss += xr[k] * xr[k];
    const float r = rsqrtf(wave_sum(ss) / D + RMS_EPS);
    float f[8] = {0, 0, 0, 0, 0, 0, 0, 0};
    const bf16_t* hb = (const bf16_t*)(a.ws + WS_HB) + (size_t)m * D;
    for (int k = lane; k < D; k += 64) {
        const float sc = mod[b * NMOD + 1 * D + k], shv = mod[b * NMOD + k];
        const float h = xr[k] * r * a.norm1_w[k] * (1.0f + sc) + shv;
        dbg_report(ctl, 2, relerr(bf2f(hb[k]), h, 0.05f));
        for (int j = 0; j < 8; ++j) f[j] += h * a.w_in[(size_t)k * INW + 3072 + j];
    }
    for (int j = 0; j < 8; ++j) {
        const float z = wave_sum(f[j]) + a.b_forget[j];
        const float ref = -log1pf(expf(-z));
        if (lane == 0) dbg_report(ctl, 3, relerr(((const float*)(a.ws + WS_LF))[(size_t)m * 8 + j], ref, 0.01f));
    }
}
DI void check_p2(const Args& a) {
    unsigned* ctl = (unsigned*)(a.ws + WS_CTL);
    const int gt = blockIdx.x * NTHREADS + otid();
    if (gt >= 4096) return;
    const unsigned h = (unsigned)gt * 2654435761u;
    const int m = (h >> 7) % T, n = (h % 977 + gt * 7) % NPROJ;
    const bf16_t* hb = (const bf16_t*)(a.ws + WS_HB) + (size_t)m * D; const bf16_t* w = (const bf16_t*)(a.ws + WS_WIN) + (size_t)n * D;
    float s = 0.f;
    for (int k = 0; k < D; ++k) s += bf2f(hb[k]) * bf2f(w[k]);
    float got;
    if (n < 3072) got = bf2f(((const bf16_t*)(a.ws + WS_QKV))[(size_t)m * 3072 + n]);
    else if (n < 3584) got = bf2f(((const bf16_t*)(a.ws + WS_U))[(size_t)m * 512 + n - 3072]);
    else { got = bf2f(((const bf16_t*)(a.ws + WS_GATES))[(size_t)m * 4096 + n - 3584]); s = sigmoidf_(s); }
    dbg_report(ctl, 4, relerr(got, s, 0.05f));
}

DI void check_p3(const Args& a) {
    unsigned* ctl = (unsigned*)(a.ws + WS_CTL);
    const int tid_ = otid(); const int lane = tid_ & 63, gw = blockIdx.x * NWAVES + (tid_ >> 6);
    if (gw >= 48) return;
    const unsigned hsh = (unsigned)(gw + 1) * 2654435761u;
    const int b = gw & 1, h = (gw >> 1) & 7, t = (gw < 16) ? (gw * 37) : (int)(hsh % SEQ);
    const bf16_t* qkv = (const bf16_t*)(a.ws + WS_QKV);
    const bf16_t* vt = (const bf16_t*)(a.ws + WS_VT) + (size_t)(b * AH + h) * HD * SEQ;
    const float* Floc = (const float*)(a.ws + WS_F) + (size_t)(b * AH + h) * SEQ; const float* segt = (const float*)(a.ws + WS_CTL) + CW_SEGT + (b * AH + h) * 8;
    auto F = [&](int i) -> float { float o_ = 0.f; for (int z = 0; z < (i >> 11); ++z) o_ += segt[z]; return Floc[i] + o_; };
    float* scr = (float*)(a.ws + WS_DBGS) + (size_t)gw * SEQ;
    const size_t mrow = (size_t)b * SEQ;
    const bf16_t* qp = qkv + (mrow + t) * 3072 + h * 128;
    float mx = -1e30f;
    for (int s = lane; s <= t; s += 64) {
        const bf16_t* kp = qkv + (mrow + s) * 3072 + 1024 + h * 128;
        float d = 0.f;
        for (int k = 0; k < HD; ++k) d += bf2f(qp[k]) * bf2f(kp[k]);
        d += F(t) - F(s);
        scr[s] = d; mx = fmaxf(mx, d);
    }
    for (int o = 1; o < 64; o <<= 1) mx = fmaxf(mx, __shfl_xor(mx, o));
    float l = 0.f;
    for (int s = lane; s <= t; s += 64) { const float p = exp2f(scr[s] - mx); scr[s] = p; l += p; }
    l = wave_sum(l);
    __builtin_amdgcn_fence(__ATOMIC_RELEASE, "agent"); __builtin_amdgcn_fence(__ATOMIC_ACQUIRE, "agent");
    const bf16_t* yo = (const bf16_t*)(a.ws + WS_YATT) + (mrow + t) * AW + h * 128;
    for (int dd = 0; dd < 2; ++dd) {
        const int d = lane + 64 * dd;
        float acc = 0.f;
        for (int s = 0; s <= t; ++s) {
            const int pos = (s & ~15) + 8 * ((s >> 2) & 1) + 4 * ((s >> 3) & 1) + (s & 3);
            acc += scr[s] * bf2f(vt[((size_t)(pos >> 6) * HD + d) * 64 + (pos & 63)]);
        }
        dbg_report(ctl, 5, relerr(bf2f(yo[d]), acc / l, 0.5f));
    }
}


DI void check_p2b(const Args& a) {
    unsigned* ctl = (unsigned*)(a.ws + WS_CTL);
    const int tid_ = otid(); const int lane = tid_ & 63, gw = blockIdx.x * NWAVES + (tid_ >> 6);
    if (gw < 32) {
        const unsigned hsh = (unsigned)(gw + 3) * 2654435761u;
        const int m = 16384 + (hsh % 16384), h = (hsh >> 20) & 7, qk = gw & 1;
        const bf16_t* hb = (const bf16_t*)(a.ws + WS_HB) + (size_t)m * D;
        float raw[2], ss = 0.f;
        for (int dd = 0; dd < 2; ++dd) {
            const int d = lane + 64 * dd;
            const bf16_t* w = (const bf16_t*)(a.ws + WS_WIN) + (size_t)(qk * 1024 + h * 128 + d) * D;
            float s = 0.f;
            for (int k = 0; k < D; ++k) s += bf2f(hb[k]) * bf2f(w[k]);
            raw[dd] = s; ss += s * s;
        }
        ss = wave_sum(ss);
        const float r = rsqrtf(ss / HD + RMS_EPS);
        for (int dd = 0; dd < 2; ++dd) {
            const int d = lane + 64 * dd;
            const float ref = raw[dd] * r * (qk ? a.k_norm_w[d] : a.q_norm_w[d] * 0.08838834764831845f * LOG2E);
            dbg_report(ctl, 6, relerr(bf2f(((const bf16_t*)(a.ws + WS_QKV))[(size_t)m * 3072 + qk * 1024 + h * 128 + d]), ref, 0.05f));
        }
    } else if (gw < 48 && lane == 0) {
        const int bh = gw - 32, b = bh >> 3, h = bh & 7;
        const float* lf = (const float*)(a.ws + WS_LF); const float* F = (const float*)(a.ws + WS_F) + (size_t)bh * SEQ;
        double c = 0.0;
        const float* segt = (const float*)(a.ws + WS_CTL) + CW_SEGT + bh * 8;
        for (int s = 0; s < 3000; ++s) { c += (double)lf[((size_t)b * SEQ + s) * 8 + h]; if (s % 499 == 0) dbg_report(ctl, 7, relerr(F[s] + (s >= 2048 ? segt[0] : 0.f), (float)(c * 1.4426950408889634), 0.01f)); }
    }
}


DI void check_p456(const Args& a, int which) {
    unsigned* ctl = (unsigned*)(a.ws + WS_CTL);
    const int gt = blockIdx.x * NTHREADS + otid();
    if (gt >= 2048) return;
    const unsigned h = (unsigned)(gt + 11) * 2654435761u;
    const int m = (h >> 7) % T;
    if (which == 0) {
        const int n = h % SW;
        const bf16_t* g = (const bf16_t*)(a.ws + WS_GY) + (size_t)m * SW; const bf16_t* w = (const bf16_t*)(a.ws + WS_WGLU) + (size_t)n * SW;
        float s = a.b_glu[n];
        for (int k = 0; k < SW; ++k) s += bf2f(g[k]) * bf2f(w[k]);
        dbg_report(ctl, 8, relerr(bf2f(((const bf16_t*)(a.ws + WS_YG))[(size_t)m * SW + n]), bf2f(g[n]) * sigmoidf_(s), 0.2f));
    } else if (which == 1) {
        const int n = h % D;
        const bf16_t* yg = (const bf16_t*)(a.ws + WS_YG) + (size_t)m * SW; const bf16_t* w1 = (const bf16_t*)(a.ws + WS_WSSM) + (size_t)n * SW;
        const bf16_t* ya = (const bf16_t*)(a.ws + WS_YATT) + (size_t)m * AW; const bf16_t* w2 = (const bf16_t*)(a.ws + WS_WATTN) + (size_t)n * AW;
        float s1 = 0.f, s2 = 0.f;
        for (int k = 0; k < SW; ++k) s1 += bf2f(yg[k]) * bf2f(w1[k]);
        for (int k = 0; k < AW; ++k) s2 += bf2f(ya[k]) * bf2f(w2[k]);
        const bf16_t* gt_ = (const bf16_t*)(a.ws + WS_GATES) + (size_t)m * 4096;
        const float ref = bf2f(gt_[n]) * s1 + bf2f(gt_[2048 + n]) * s2;
        dbg_report(ctl, 9, relerr(bf2f(((const bf16_t*)(a.ws + WS_MRG))[(size_t)m * D + n]), ref, 0.3f));
    } else {
        const int n = h % D, b = m >> 14;
        const bf16_t* mr = (const bf16_t*)(a.ws + WS_MRG) + (size_t)m * D; const bf16_t* w = (const bf16_t*)(a.ws + WS_WOUT) + (size_t)n * D;
        float s = 0.f;
        for (int k = 0; k < D; ++k) s += bf2f(mr[k]) * bf2f(w[k]);
        const float g1 = ((const float*)ctl + CW_MOD)[b * NMOD + 2 * D + n];
        dbg_report(ctl, 10, relerr(a.out[(size_t)m * D + n], a.x[(size_t)m * D + n] + g1 * s, 1.0f) * 10.f);
    }
}


DI void check_p8(const Args& a) {
    unsigned* ctl = (unsigned*)(a.ws + WS_CTL);
    const int gt = blockIdx.x * NTHREADS + otid();
    if (gt >= 2048) return;
    const unsigned h = (unsigned)(gt + 5) * 2654435761u;
    const int m = (h >> 7) % T, n = h % D;
    const bf16_t* hr = (const bf16_t*)(a.ws + WS_H2B) + (size_t)m * D; const bf16_t* w = (const bf16_t*)(a.ws + WS_WPQ) + (size_t)n * D;
    float s = 0.f;
    for (int k = 0; k < D; ++k) s += bf2f(hr[k]) * bf2f(w[k]);
    dbg_report(ctl, 11, relerr(bf2f(((const bf16_t*)(a.ws + WS_QP))[(size_t)m * D + n]), s, 0.3f));
}
DI void check_p9(const Args& a) {
    unsigned* ctl = (unsigned*)(a.ws + WS_CTL);
    const int tid_ = otid(); const int lane = tid_ & 63, gw = blockIdx.x * NWAVES + (tid_ >> 6);
    if (gw >= 64) return;
    const unsigned hsh = (unsigned)(gw + 7) * 2654435761u;
    const int m = (hsh >> 5) % T, h = gw & 7;
    const bf16_t* qp = (const bf16_t*)(a.ws + WS_QP) + (size_t)m * D + h * 256;
    const bf16_t* keys = (const bf16_t*)(a.ws + WS_KEYS) + (size_t)h * 2 * NKEYS * 128;
    float* scr = (float*)(a.ws + WS_DBGS) + (size_t)gw * 256;
    for (int r = lane; r < 256; r += 64) {
        const int p = r >> 7; float s = 0.f;
        for (int k = 0; k < 128; ++k) s += bf2f(qp[p * 128 + k]) * bf2f(keys[(size_t)r * 128 + k]);
        scr[r] = s;
    }
    __builtin_amdgcn_fence(__ATOMIC_RELEASE, "agent"); __builtin_amdgcn_fence(__ATOMIC_ACQUIRE, "agent");
    const int* ids = (const int*)(a.ws + WS_IDS) + (size_t)m * NSEL + h * 16; const float* gwp = (const float*)(a.ws + WS_GW) + (size_t)m * NSEL + h * 16;
    float tv[16]; int te[16]; unsigned long long takenlo[4] = {0, 0, 0, 0};
    for (int r = 0; r < 16; ++r) {
        float best = -1e30f; int be = -1;
        for (int c = 0; c < 256; ++c) { const int e = lane * 256 + c; if ((takenlo[c >> 6] >> (c & 63)) & 1ull) continue; const float v = scr[e >> 7] + scr[128 + (e & 127)]; if (v > best) { best = v; be = e; } }
        float wb = best; for (int o = 1; o < 64; o <<= 1) wb = fmaxf(wb, __shfl_xor(wb, o));
        const unsigned long long bal = __ballot(best == wb); const int wl = __ffsll((long long)bal) - 1;
        const int we = __shfl(be, wl);
        if (lane == wl) { const int c = we - lane * 256; takenlo[c >> 6] |= 1ull << (c & 63); }
        tv[r] = wb; te[r] = we;
    }
    float es = 0.f; for (int r = 0; r < 16; ++r) es += expf(tv[r] - tv[0]);
    float err = 0.f;
    for (int r = 0; r < 16; ++r) {
        bool found = false;
        for (int k = 0; k < 16; ++k) if (ids[k] == te[r]) { found = true; err += fabsf(gwp[k] - expf(tv[r] - tv[0]) / es); }
        if (!found) err += expf(tv[r] - tv[0]) / es;
    }
    if (lane == 0) dbg_report(ctl, 12, err);
}
DI void check_p10(const Args& a) {
    unsigned* ctl = (unsigned*)(a.ws + WS_CTL);
    const int tid_ = otid(); const int lane = tid_ & 63, gw = blockIdx.x * NWAVES + (tid_ >> 6);
    if (gw >= 32) return;
    const unsigned hsh = (unsigned)(gw + 17) * 2654435761u;
    const int m = (hsh >> 5) % T, b = m >> 14;
    const bf16_t* hrow = (const bf16_t*)(a.ws + WS_H2B) + (size_t)m * D;
    const int* ids = (const int*)(a.ws + WS_IDS) + (size_t)m * NSEL; const float* gwp = (const float*)(a.ws + WS_GW) + (size_t)m * NSEL;
    const unsigned char* PU = a.ws + WS_PU; const unsigned char* PV = a.ws + WS_PV;
    float* scr = (float*)(a.ws + WS_DBGS) + 65536 + (size_t)gw * 128;
    for (int e = 0; e < NSEL; ++e) {
        float s = 0.f;
#if TAB4
        for (int k = lane; k < D; k += 64) s += bf2f(hrow[k]) * fp4_at(PU + (size_t)ids[e] * ROWB4, a.ws + WS_PUE + (size_t)ids[e] * 64, k);
        s = wave_sum(s);
        if (lane == 0) scr[e] = geluf_(s) * gwp[e];
#else
        for (int k = lane; k < D; k += 64) s += bf2f(hrow[k]) * fp6_at(PU + (size_t)ids[e] * ROWB, k);
        s = wave_sum(s) * ((const float*)(a.ws + WS_PUS))[ids[e]];
        if (lane == 0) scr[e] = geluf_(s) * gwp[e] * ((const float*)(a.ws + WS_PVS))[ids[e]];
#endif
    }
    __builtin_amdgcn_fence(__ATOMIC_RELEASE, "agent"); __builtin_amdgcn_fence(__ATOMIC_ACQUIRE, "agent");
    const float* mod = (const float*)ctl + CW_MOD;
    for (int c = 0; c < 8; ++c) {
        const int n = (hsh >> (c + 2)) % D;
        float pe = 0.f;
#if TAB4
        for (int e = lane; e < NSEL; e += 64) pe += scr[e] * fp4_at(PV + (size_t)ids[e] * ROWB4, a.ws + WS_PVE + (size_t)ids[e] * 64, n);
#else
        for (int e = lane; e < NSEL; e += 64) pe += scr[e] * fp6_at(PV + (size_t)ids[e] * ROWB, n);
#endif
        pe = wave_sum(pe);
        const bf16_t* mr = (const bf16_t*)(a.ws + WS_MRG) + (size_t)m * D; const bf16_t* w = (const bf16_t*)(a.ws + WS_WOUT) + (size_t)n * D;
        float s = 0.f;
        for (int k = lane; k < D; k += 64) s += bf2f(mr[k]) * bf2f(w[k]);
        s = wave_sum(s);
        const float g1 = mod[b * NMOD + 2 * D + n], g2 = mod[b * NMOD + 5 * D + n];
        const float ref = a.x[(size_t)m * D + n] + g1 * s + g2 * pe;
        if (lane == 0) dbg_report(ctl, 13, relerr(a.out[(size_t)m * D + n], ref, 1.0f) * 10.f);
    }
}


DI void check_fp6(const Args& a) {
    unsigned* ctl = (unsigned*)(a.ws + WS_CTL);
    if (blockIdx.x != 0 || otid() >= 64) return;
    bool ok = true;
#pragma unroll 1
    for (int rnd = 0; rnd < 2; ++rnd) {
        float e[32];
#pragma unroll
        for (int i = 0; i < 32; ++i) { const int c = (i * 7 + 3) & 31;
            const float mag = c < 16 ? 0.125f * c : (c < 24 ? 2.0f + 0.25f * (c - 16) : 4.0f + 0.5f * (c - 24));
            e[i] = (rnd ^ (i & 1)) ? -mag : mag; }
        const v6u w = fp6_pack_sw(e);
        const v32f r = fp6_unpack_f32(w);
#pragma unroll
        for (int i = 0; i < 32; ++i) ok = ok && (r[i] == e[i]);
    }
    dbg_report(ctl, 14, ok ? 1.f : 2.f);
}

__constant__ float dbg_tol[16] = {1e-3f, 4e-3f, 1e-2f, 1e-3f, 2e-2f, 2e-2f, 2e-2f, 2e-2f, 2e-2f, 2e-2f, 2e-2f, 2e-2f, 1e-1f, 2e-2f, 2e-2f, 2e-2f};
#endif


#define XB_TMO      128
#define XB_XCNT(j)  (256  + 64 * (j))
#define XB_XSUB(j)  (1280 + 64 * (j))
#define XB_XGEN(j)  (2304 + 64 * (j))
#define XB_TOP      3328
#define XB_TOPGEN   3392
#define XCD_BAR_WORDS 3456
#define XB_SPIN_CAP (1u << 18)
constexpr int CW_BAR = 4096;
DI unsigned xb_ld(unsigned* p)              { return __hip_atomic_load(p, __ATOMIC_RELAXED, __HIP_MEMORY_SCOPE_AGENT); }
DI unsigned xb_add(unsigned* p, unsigned v) { return __hip_atomic_fetch_add(p, v, __ATOMIC_RELAXED, __HIP_MEMORY_SCOPE_AGENT); }
DI unsigned xb_xcc_id() { return (unsigned)__builtin_amdgcn_s_getreg((3 << 11) | 20) & 0xFu; }
#define XB_SPIN(cond, bar) do { unsigned _sp = 0; while (cond) { __builtin_amdgcn_s_sleep(1); \
    if ((++_sp & 255u) == 0u) { if (xb_ld(&(bar)[XB_TMO])) break; if (_sp > XB_SPIN_CAP) { atomicAdd(&(bar)[XB_TMO], 1u); break; } } } } while (0)
struct XcdBarrier { unsigned* bar; unsigned x; volatile LAS unsigned* st; };
DI XcdBarrier xcd_barrier_post(unsigned* bar, volatile LAS unsigned* st) {
    XcdBarrier b; b.bar = bar; b.x = xb_xcc_id(); b.st = st;
    if (threadIdx.x == 0) (void)xb_add(&bar[XB_XCNT(b.x)], 1u);
    return b;
}
DI void xcd_barrier_complete(unsigned* bar, unsigned x, unsigned& nloc, unsigned& nx) {
    const unsigned G = gridDim.x * gridDim.y * gridDim.z;
    unsigned sum, cnt, mine, sp = 0u;
    for (;;) {
        sum = 0u; cnt = 0u; mine = 0u;
#pragma unroll
        for (unsigned j = 0; j < 16; ++j) { const unsigned c = xb_ld(&bar[XB_XCNT(j)]); sum += c; cnt += (c > 0u) ? 1u : 0u; mine = (j == x) ? c : mine; }
        if (sum == G) break;
        __builtin_amdgcn_s_sleep(1);
        if ((++sp & 255u) == 0u) { if (xb_ld(&bar[XB_TMO])) break; if (sp > XB_SPIN_CAP) { atomicAdd(&bar[XB_TMO], 1u); break; } }
    }
    nloc = mine > 0u ? mine : 1u; nx = cnt > 0u ? cnt : 1u;
}
#ifndef BAR_SCOPE
#define BAR_SCOPE ""
#endif
DI void xcd_barrier(const XcdBarrier& b) {
    asm volatile("s_waitcnt vmcnt(0)" ::: "memory");
    __syncthreads();
    if (threadIdx.x == 0) {
        unsigned* bar = b.bar;
        __builtin_amdgcn_s_waitcnt(0);
        unsigned nloc = b.st[0], nx = b.st[1];
        if (nloc == 0u) { xcd_barrier_complete(bar, b.x, nloc, nx); b.st[0] = nloc; b.st[1] = nx; }
        const unsigned old = xb_add(&bar[XB_XSUB(b.x)], 1u);
        const unsigned gen = old / nloc;
        if (old + 1u == (gen + 1u) * nloc) {
            __builtin_amdgcn_fence(__ATOMIC_RELEASE, BAR_SCOPE);
            asm volatile("s_waitcnt vmcnt(0)" ::: "memory");
            const unsigned og = xb_add(&bar[XB_TOP], 1u);
            const unsigned tg = og / nx;
            if (og + 1u == (tg + 1u) * nx) xb_add(&bar[XB_TOPGEN], 1u);
            else XB_SPIN(xb_ld(&bar[XB_TOPGEN]) == tg, bar);
            __builtin_amdgcn_fence(__ATOMIC_ACQUIRE, BAR_SCOPE);
            xb_add(&bar[XB_XGEN(b.x)], 1u);
            asm volatile("s_waitcnt vmcnt(0)" ::: "memory");
        } else {
            XB_SPIN(xb_ld(&bar[XB_XGEN(b.x)]) == gen, bar);
            __builtin_amdgcn_fence(__ATOMIC_ACQUIRE, BAR_SCOPE);
            asm volatile("s_waitcnt vmcnt(0)" ::: "memory");
        }
    }
    __syncthreads();
}


#ifndef TUNIT
#define TUNIT 50000
#endif
#ifndef TIMING
#define TIMING 0
#endif
__global__ void __launch_bounds__(NTHREADS, 2) mk_fwd(Args a) {
    extern __shared__ __attribute__((aligned(16))) unsigned char lds_raw[];
    LAS unsigned char* lds = (LAS unsigned char*)lds_raw;
    cg::grid_group grid = cg::this_grid();
    const int G = gridDim.x, blk = blockIdx.x;
    unsigned char* ws = a.ws;
    unsigned* ctl = (unsigned*)(ws + WS_CTL);
    unsigned long long* ts = (unsigned long long*)(ctl + 512);
#define STAMP(k) do { if (TIMING && blk == 0 && threadIdx.x == 0) ts[k] = __builtin_amdgcn_s_memrealtime(); } while (0)
#ifndef USE_XB
#define USE_XB 1
#endif
#define SYNC(k) do { if (USE_XB && (k) != 1) xcd_barrier(xbar); else { grid.sync(); if (threadIdx.x == 0) { __builtin_amdgcn_fence(__ATOMIC_ACQUIRE, BAR_SCOPE); asm volatile("s_waitcnt vmcnt(0)" ::: "memory"); } __syncthreads(); } STAMP(k); } while (0)
#if DBG
#define CHECK(stop, call) do { if (DBG_STOP > (stop)) call; grid.sync(); } while (0)
#else
#define CHECK(stop, call) do { } while (0)
#endif
    volatile LAS unsigned* xst = (volatile LAS unsigned*)(lds + LDS_BYTES - 64);
    if (threadIdx.x < 2) xst[threadIdx.x] = 0u;
    __syncthreads();
    XcdBarrier xbar = xcd_barrier_post(ctl + CW_BAR, xst);
    STAMP(0);
    phase0(a, lds);
    s5_tables_p0(a);
    SYNC(1);
#if DUP == 1
    phase0(a, lds); s5_tables_p0(a); SYNC(15);
#endif
    CHECK(0, check_p0(a));
    CHECK(0, check_fp6(a));
    if (DBG_STOP > 1) { s5_tables_p1(a); row_pass<true>(a, lds, a.x, a.norm1_w, 0, 1, (bf16_t*)(ws + WS_HB)); }
    SYNC(2);
#if DUP == 2
    s5_tables_p1(a); row_pass<true>(a, lds, a.x, a.norm1_w, 0, 1, (bf16_t*)(ws + WS_HB)); SYNC(15);
#endif
    CHECK(1, check_p1(a));
    if (DBG_STOP > 2) {
        pg8::Gemm g{(const bf16_t*)(ws + WS_HB), (const bf16_t*)(ws + WS_WIN), T, NPROJ, D};
        pg8::StaticOrder S; S.init(T, NPROJ, G, blk);
        EpiProj E{(bf16_t*)(ws + WS_QKV), (bf16_t*)(ws + WS_U), ws + WS_GATES};
        pg8::gemm_phase<EpiProj, pg8::StaticOrder, G_ALIGN, G_SP2>(lds, g, S, E);
    }
    SYNC(3);
    CHECK(2, check_p2(a));
    if (DBG_STOP > 3) phase2b(a, lds);
    SYNC(4);
    CHECK(3, check_p2b(a));
    if (DBG_STOP > 4) phase3(a, lds);
    SYNC(5);
    CHECK(4, check_p3(a));
    if (DBG_STOP > 5) {
        pg8::Gemm g{(const bf16_t*)(ws + WS_GY), (const bf16_t*)(ws + WS_WGLU), T, SW, SW};
        pg8::StaticOrder S; S.init(T, SW, G, blk);
        EpiGlu E{(const bf16_t*)(ws + WS_GY), a.b_glu, (bf16_t*)(ws + WS_YG)};
        pg8::gemm_phase<EpiGlu, pg8::StaticOrder, G_ALIGN, G_SP2>(lds, g, S, E);
    }
    SYNC(6);
    CHECK(5, check_p456(a, 0));
    for (int dup = 0; dup < (DUP == 5 ? 2 : 1); ++dup) {
        if (dup) SYNC(15);
        { pg8::Gemm g{(const bf16_t*)(ws + WS_YG), (const bf16_t*)(ws + WS_WSSM), T, D, SW};
          pg8::StaticOrder S; S.init(T, D, G, blk);
          EpiSsmUp E{ws + WS_GATES, (bf16_t*)(ws + WS_MRG)};
          pg8::gemm_phase<EpiSsmUp, pg8::StaticOrder, G_ALIGN, G_SP2>(lds, g, S, E); }
        { pg8::Gemm g{(const bf16_t*)(ws + WS_YATT), (const bf16_t*)(ws + WS_WATTN), T, D, AW};
          pg8::StaticOrder S; S.init(T, D, G, blk);
          EpiAttnUp E{ws + WS_GATES, (bf16_t*)(ws + WS_MRG)};
          pg8::gemm_phase<EpiAttnUp, pg8::StaticOrder, G_ALIGN, G_SP2>(lds, g, S, E); }
    }
    SYNC(7);
    CHECK(6, check_p456(a, 1));
    if (DBG_STOP > 7) {
        pg8::Gemm g{(const bf16_t*)(ws + WS_MRG), (const bf16_t*)(ws + WS_WOUT), T, D, D};
        pg8::StaticOrder S; S.init(T, D, G, blk);
        EpiOut E{a.x, (const float*)ctl + CW_MOD, a.b_ada, ws};
        pg8::gemm_phase<EpiOut, pg8::StaticOrder, G_ALIGN, G_SP2>(lds, g, S, E);
    }
    SYNC(8);
    CHECK(7, check_p456(a, 2));
    if (DBG_STOP > 8) row_pass<false, true>(a, lds, nullptr, a.norm2_w, 3, 4, (bf16_t*)(ws + WS_H2B));
    SYNC(9);
    if (DBG_STOP > 9) {
        pg8::Gemm g{(const bf16_t*)(ws + WS_H2B), (const bf16_t*)(ws + WS_WPQ), T, D, D};
        pg8::StaticOrder S; S.init(T, D, G, blk);
        EpiPlain E{(bf16_t*)(ws + WS_QP), D};
        pg8::gemm_phase<EpiPlain, pg8::StaticOrder, G_ALIGN, G_SP2>(lds, g, S, E);
    }
    SYNC(10);
    CHECK(9, check_p8(a));
    for (int dup = 0; dup < (DUP == 9 ? 2 : 1); ++dup) { if (dup) SYNC(15); phase9(a, lds);
#if TAB4 && P10_SLICED && U4
        hdigits_pass(a);
#endif
    }
    SYNC(11);
    CHECK(10, check_p9(a));
#if PROBE == 14
#elif TAB4 && P10_SLICED
#if U4
    if (DBG_STOP > 11) { phase10a_u4(a, lds); SYNC(13);
#if DUP == 10
        phase10a_u4(a, lds); SYNC(15);
#endif
        phase10b(a); SYNC(14);
#if DUP == 11
        phase10b(a); SYNC(15);
#endif
        phase10c_fp4(a, lds); }
#else
    if (DBG_STOP > 11) { phase10a_fp4(a); SYNC(13); phase10b(a); SYNC(14); phase10c_fp4(a, lds); }
#endif
#elif TAB4
    if (DBG_STOP > 11) phase10_fp4(a);
#else
    if (DBG_STOP > 11) phase10(a);
#endif
#if DBG || TIMING
    SYNC(12);
#endif
    CHECK(11, check_p10(a));
#if DBG
    if (DBG_STOP <= 7) {
        const f32x4* x4 = (const f32x4*)a.x; f32x4* o4 = (f32x4*)a.out;
        const size_t n4 = (size_t)T * D / 4;
        for (size_t i = (size_t)blk * NTHREADS + threadIdx.x; i < n4; i += (size_t)G * NTHREADS) o4[i] = x4[i];
    }
    grid.sync();
    {
        int code = 0;
        for (int i = 15; i >= 0; --i) { const float e = __uint_as_float(__hip_atomic_load(ctl + CW_DBG + i, __ATOMIC_RELAXED, __HIP_MEMORY_SCOPE_AGENT));
            if (e > dbg_tol[i]) { if (i >= DBG_LO && i < DBG_LO + 4) code |= 1 << (i - DBG_LO); else if (i < DBG_LO) code = 20 + i; } }
#ifdef DBG_MAG
        code = 1;
#endif
        if (code) {
#ifdef DBG_MAG
            const float s = 1.0f + fminf(__uint_as_float(__hip_atomic_load(ctl + CW_DBG + DBG_MAG, __ATOMIC_RELAXED, __HIP_MEMORY_SCOPE_AGENT)), 1000.f);
#else
            const float s = 1.0f + (float)code;
#endif
            f32x4* o4 = (f32x4*)a.out; const size_t n4 = (size_t)T * D / 4;
            for (size_t i = (size_t)blk * NTHREADS + threadIdx.x; i < n4; i += (size_t)G * NTHREADS) o4[i] = o4[i] * s;
        }
    }
#endif
#ifndef PROBE
#define PROBE 0
#endif
#if PROBE
    {
        SYNC(17);
        float* o = a.out; const size_t n = (size_t)T * D;
        for (size_t i = (size_t)blk * NTHREADS + threadIdx.x; i < n; i += (size_t)G * NTHREADS) {
            float v = 0.f;
            if (PROBE == 1) { if (i < (size_t)T * NSEL) v = ((const float*)(ws + WS_GW))[i]; }
            if (PROBE == 2) { if (i < (size_t)T * NSEL) v = (float)((const int*)(ws + WS_IDS))[i]; }
            if (PROBE == 3) { v = bf2f(((const bf16_t*)(ws + WS_H2B))[i]); }
            if (PROBE == 5) { v = bf2f(((const bf16_t*)(ws + WS_QP))[i]); }
            if (PROBE == 7) { v = bf2f(((const bf16_t*)(ws + WS_MRG))[i]); }
            if (PROBE == 8) { if (i < (size_t)T * SW) v = bf2f(((const bf16_t*)(ws + WS_GY))[i]); else if (i < (size_t)T * SW + (size_t)T * AW) v = bf2f(((const bf16_t*)(ws + WS_YATT))[i - (size_t)T * SW]); }
            if (PROBE == 9) { if (i < (size_t)T * SW) v = bf2f(((const bf16_t*)(ws + WS_YG))[i]); }
            if (PROBE == 15) { if (i < (size_t)NEXP * ROWB4 / 4) v = (float)(((const unsigned*)(ws + WS_PU))[i] >> 8); else if (i < (size_t)NEXP * ROWB4 / 2) v = (float)(((const unsigned*)(ws + WS_PV))[i - (size_t)NEXP * ROWB4 / 4] >> 8); }
            if (PROBE != 14) o[i] = v;
        }
    }
#endif
#if TIMING
    {
        const unsigned long long t0 = __hip_atomic_load(ts + 0, __ATOMIC_RELAXED, __HIP_MEMORY_SCOPE_AGENT), t1 = __hip_atomic_load(ts + 12, __ATOMIC_RELAXED, __HIP_MEMORY_SCOPE_AGENT);
        const unsigned long long ta = __hip_atomic_load(ts + TIMING - 1, __ATOMIC_RELAXED, __HIP_MEMORY_SCOPE_AGENT), tb = __hip_atomic_load(ts + TIMING, __ATOMIC_RELAXED, __HIP_MEMORY_SCOPE_AGENT);
        (void)t0; (void)t1;
        const float s = 1.0f + floorf((float)(tb - ta) / (float)TUNIT + 0.5f);
        f32x4* o4 = (f32x4*)a.out; const size_t n4 = (size_t)T * D / 4;
        for (size_t i = (size_t)blk * NTHREADS + threadIdx.x; i < n4; i += (size_t)G * NTHREADS) o4[i] = o4[i] * s;
    }
#endif
}

extern "C" void kernel_launch(void* const* d_in, const int* in_sizes, int n_in, void* d_out, int out_size,
                              void* d_ws, size_t ws_size, hipStream_t stream) {
    static int grid = 0;
    if (grid == 0) {
        int dev = 0, cus = 0, per_cu = 0;
        (void)hipGetDevice(&dev);
        (void)hipDeviceGetAttribute(&cus, hipDeviceAttributeMultiprocessorCount, dev);
        (void)hipFuncSetAttribute((const void*)mk_fwd, hipFuncAttributeMaxDynamicSharedMemorySize, LDS_BYTES);
        (void)hipOccupancyMaxActiveBlocksPerMultiprocessor(&per_cu, (const void*)mk_fwd, NTHREADS, LDS_BYTES);
        if (per_cu < 1) per_cu = 1;
        grid = cus * per_cu;
        if (n_in != 27 || ws_size < WS_END) { fprintf(stderr, "kernel_launch: unexpected n_in %d / ws_size %zu\n", n_in, ws_size); }
    }
    (void)hipMemsetAsync((char*)d_ws + WS_CTL, 0, CTL_ZERO_BYTES, stream);
    Args a{};
    const float** ap = (const float**)&a;
    for (int i = 0; i < 27; ++i) ap[i] = (const float*)d_in[i];
    a.out = (float*)d_out; a.ws = (unsigned char*)d_ws;
    void* args[] = {&a};
    hipError_t e = hipLaunchCooperativeKernel((const void*)mk_fwd, dim3(grid), dim3(NTHREADS), args, LDS_BYTES, stream);
    if (e != hipSuccess) fprintf(stderr, "cooperative launch failed: %s (grid %d)\n", hipGetErrorString(e), grid);
}
```

```cpp
#include <hip/hip_runtime.h>
#include <hip/hip_cooperative_groups.h>
#include <cstdio>
#include <cstdint>
namespace cg = cooperative_groups;

#ifndef DBG
#define DBG 0
#endif
#ifndef PROBE
#define PROBE 0
#endif
#ifndef DBG_LO
#define DBG_LO 10
#endif
#ifndef DBG_STOP
#define DBG_STOP 99
#endif

#define DI __device__ __forceinline__
#define GAS __attribute__((address_space(1)))
#define LAS __attribute__((address_space(3)))
typedef unsigned short bf16_t;
typedef short bf16x8 __attribute__((ext_vector_type(8)));
typedef float f32x4 __attribute__((ext_vector_type(4)));
typedef float f32x16 __attribute__((ext_vector_type(16)));
typedef unsigned u32x4 __attribute__((ext_vector_type(4)));
typedef unsigned u32x2 __attribute__((ext_vector_type(2)));
typedef __bf16 bf16x2_t __attribute__((ext_vector_type(2)));

constexpr int NTHREADS = 512, NWAVES = 8;
constexpr int LDS_BYTES = 147456;
constexpr int NB = 2, SEQ = 16384, T = NB * SEQ, D = 2048;
constexpr int AH = 8, HD = 128, AW = 1024;
constexpr int SW = 512, SGRP = 32, SCH = 16, SST = 64;
constexpr int INW = 7688, NPROJ = 7680;
constexpr int NMOD = 6 * D;
constexpr int PH = 8, NKEYS = 128, NEXP = 16384, TOPK = 16, NSEL = PH * TOPK;
constexpr float RMS_EPS = 1e-6f;
constexpr float LOG2E = 1.4426950408889634f;

constexpr size_t MiB = 1u << 20;
constexpr size_t WS_CTL = 0, CTL_ZERO_BYTES = 1 * MiB;
constexpr size_t WS_LF = 1 * MiB;
constexpr size_t WS_F = 2 * MiB;
constexpr size_t WS_WF = 3 * MiB;
constexpr size_t WS_KEYS = 3 * MiB + 512 * 1024;
constexpr size_t WS_WGLU = 4 * MiB, WS_WSSM = 5 * MiB, WS_WATTN = 7 * MiB, WS_WOUT = 11 * MiB, WS_WPQ = 19 * MiB, WS_WIN = 27 * MiB;
constexpr size_t WS_S5TAB = 57 * MiB;
constexpr size_t WS_PU = 64 * MiB, WS_PV = 88 * MiB;
constexpr size_t WS_HB = 192 * MiB;
constexpr size_t WS_QKV = 320 * MiB;
constexpr size_t WS_U = 512 * MiB;
constexpr size_t WS_YATT = 544 * MiB;
constexpr size_t WS_GY = 608 * MiB;
constexpr size_t WS_YG = 640 * MiB;
constexpr size_t WS_GATES = 672 * MiB;
constexpr size_t WS_END = 1024 * MiB;
constexpr int CW_DBG = 64;
constexpr int CW_QUEUE = 256;
constexpr int CW_SEGT = 1024;
constexpr int CW_MOD = 819200;

struct Args {
    const float *x, *c, *w_ada, *b_ada, *norm1_w, *w_in, *b_forget, *q_norm_w, *k_norm_w;
    const float *A_re, *A_im, *log_dt, *B_re, *B_im, *C_re, *C_im, *Dskip;
    const float *w_glu, *b_glu, *w_ssm_up, *w_attn_up, *w_out, *norm2_w, *w_peer_q, *sub_keys, *peer_u, *peer_v;
    float* out; unsigned char* ws;
};

DI unsigned pk2(float lo, float hi) { bf16x2_t v; v.x = (__bf16)lo; v.y = (__bf16)hi; return __builtin_bit_cast(unsigned, v); }
DI float bf2f(unsigned h) { return __uint_as_float(h << 16); }
DI float bflo(unsigned w) { return __uint_as_float(w << 16); }
DI float bfhi(unsigned w) { return __uint_as_float(w & 0xffff0000u); }
DI float sigmoidf_(float z) { return __builtin_amdgcn_rcpf(1.0f + __expf(-z)); }
DI float siluf_(float z) { return z / (1.0f + __expf(-z)); }
DI float geluf_(float z) { return 0.5f * z * (1.0f + erff(z * 0.70710678118654752f)); }
DI float wave_sum(float v) {
    v += __builtin_bit_cast(float, __builtin_amdgcn_mov_dpp(__builtin_bit_cast(int, v), 0xB1, 0xf, 0xf, true));
    v += __builtin_bit_cast(float, __builtin_amdgcn_mov_dpp(__builtin_bit_cast(int, v), 0x4E, 0xf, 0xf, true));
    v += __builtin_bit_cast(float, __builtin_amdgcn_mov_dpp(__builtin_bit_cast(int, v), 0x141, 0xf, 0xf, true));
    v += __builtin_bit_cast(float, __builtin_amdgcn_mov_dpp(__builtin_bit_cast(int, v), 0x128, 0xf, 0xf, true));
    { const auto r = __builtin_amdgcn_permlane16_swap(__float_as_uint(v), __float_as_uint(v), false, false); v = __uint_as_float(r[0]) + __uint_as_float(r[1]); }
    { const auto r = __builtin_amdgcn_permlane32_swap(__float_as_uint(v), __float_as_uint(v), false, false); v = __uint_as_float(r[0]) + __uint_as_float(r[1]); }
    return v;
}
DI int otid() { int t = threadIdx.x; asm volatile("" : "+v"(t)); return t; }
#define LDS_WAIT() asm volatile("s_waitcnt lgkmcnt(0)" ::: "memory")
DI void dbg_report(unsigned* ctl, int id, float err) {
    if (!(err == err)) err = 1e30f;
    atomicMax(ctl + CW_DBG + id, __float_as_uint(fabsf(err)));
}
DI float relerr(float got, float ref, float floor_) { return fabsf(got - ref) / (fabsf(ref) + floor_); }

namespace pg8 {
constexpr int BM = 256, BK = 64, HALF = 128, HTB = HALF * BK * 2, NXCD = 8, WGM = 8;
DI int lds_byte(int r, int c) { const int st = (r >> 4) * 2 + (c >> 5), rr = r & 15, cc = c & 31, ob = rr * 64 + cc * 2; return st * 1024 + (ob ^ (((ob >> 9) & 1) << 5)); }
DI void stage_rc(int b, int& R, int& C) { const int st = b / 1024, sb = b % 1024, swz = sb ^ (((sb >> 9) & 1) << 5); R = (st >> 1) * 16 + swz / 64; C = (st & 1) * 32 + (swz % 64) / 2; }
DI int perm32(int rho) { const int n = rho >> 4, i = rho & 15; return 8 * (i >> 2) + 4 * n + (i & 3); }
struct Unit { int pm, pn; };
struct Gemm { const bf16_t* A; const bf16_t* Bt; int M, N, K; };
struct StaticOrder {
    int nM, nN, nwg, G, c;
    DI void init(int M, int N, int G_, int c_) { nM = M / BM; nN = N / BM; nwg = nM * nN; G = G_; c = c_; }
    DI bool next(int i, Unit& u) const {
        const long L = (long)i * G + c; if (L >= nwg) return false;
        int wgid = (int)L; { const int q = nwg / NXCD, r = nwg % NXCD, xcd = wgid % NXCD, off = wgid / NXCD; wgid = (xcd < r ? xcd * (q + 1) : r * (q + 1) + (xcd - r) * q) + off; }
        const int nig = WGM * nN, gid = wgid / nig, fm = gid * WGM, gsz = (nM - fm) < WGM ? (nM - fm) : WGM;
        u.pm = fm + ((wgid % nig) % gsz); u.pn = (wgid % nig) / gsz; return true;
    }
    DI void a_ready(const Unit&) const {}
    DI void done(const Unit&) const {}
};
template <class Epi, class Sched, bool ALIGN_EPI = false, bool SP2 = false>
DI void gemm_phase(LAS unsigned char* lds, const Gemm g, const Sched& S, const Epi& E) {
    int tid = threadIdx.x; asm volatile("" : "+v"(tid));
    const int wid = __builtin_amdgcn_readfirstlane(tid >> 6), lane = tid & 63, wr = wid >> 2, wc = wid & 3, fr = lane & 15, fq = lane >> 4;
    const int K = g.K, nt = K / BK;
    unsigned voffA[2], voffB[2];
#pragma unroll
    for (int i = 0; i < 2; ++i) { int R, C; stage_rc(tid * 16 + i * 8192, R, C); const int Rb = Epi::PERM ? ((R & ~31) + perm32(R & 31)) : R;
        voffA[i] = (unsigned)(R * K + C) * 2u; voffB[i] = (unsigned)(Rb * K + C) * 2u; }
    const size_t kstep = (size_t)(BK * 2);
    const size_t hstep = (size_t)HALF * K * 2;
    const size_t tstep = 2 * hstep;
    const unsigned ldsw = (unsigned)wid * 1024u;
    const int aoff = lds_byte(wr * 64 + fr, fq * 8), boff = lds_byte(wc * 32 + fr, fq * 8);
#define PG8_SA(b, h) (((b) * 2 + (h)) * HTB)
#define PG8_SB(b, h) ((4 + (b) * 2 + (h)) * HTB)
#define PG8_STAGE(bufoff, gbase, voff) do { _Pragma("unroll") for (int _i = 0; _i < 2; ++_i) \
        __builtin_amdgcn_global_load_lds((const unsigned*)((const char*)(gbase) + (voff)[_i]), (LAS unsigned*)(lds + (bufoff) + ldsw + _i * 8192), 16, 0, 0); } while (0)
#define PG8_LDA(dst, b, h) do { _Pragma("unroll") for (int m = 0; m < 4; ++m) _Pragma("unroll") for (int k = 0; k < 2; ++k) dst[m][k] = *(const LAS bf16x8*)(lds + PG8_SA(b, h) + aoff + m * 2048 + k * 1024); } while (0)
#define PG8_LDB(dst, b, h) do { _Pragma("unroll") for (int n = 0; n < 2; ++n) _Pragma("unroll") for (int k = 0; k < 2; ++k) dst[n][k] = *(const LAS bf16x8*)(lds + PG8_SB(b, h) + boff + n * 2048 + k * 1024); } while (0)
#define PG8_MMA(ai, bj, At, Bt) do { __builtin_amdgcn_s_setprio(1); _Pragma("unroll") for (int m = 0; m < 4; ++m) _Pragma("unroll") for (int n = 0; n < 2; ++n) _Pragma("unroll") for (int k = 0; k < 2; ++k) \
        acc[ai][bj][m][n] = __builtin_amdgcn_mfma_f32_16x16x32_bf16(Bt[n][k], At[m][k], acc[ai][bj][m][n], 0, 0, 0); __builtin_amdgcn_s_setprio(0); } while (0)
#define PG8_WAIT_V(n) asm volatile("s_waitcnt vmcnt(" #n ")" ::: "memory")
#define PG8_WAIT_L(n) asm volatile("s_waitcnt lgkmcnt(" #n ")" ::: "memory")
#define PG8_BAR __builtin_amdgcn_s_barrier()
#define PG8_SCHED __builtin_amdgcn_sched_barrier(0)
    Unit cur, nxt; int ui = 0;
    if (!S.next(0, cur)) return;
    f32x4 acc[2][2][4][2];
#pragma unroll
    for (int a = 0; a < 2; ++a)
#pragma unroll
        for (int b = 0; b < 2; ++b)
#pragma unroll
            for (int m = 0; m < 4; ++m)
#pragma unroll
                for (int n = 0; n < 2; ++n) acc[a][b][m][n] = (f32x4){0.f, 0.f, 0.f, 0.f};
    bf16x8 At[4][2], B0[2][2], B1[2][2];
    const char* cA = (const char*)g.A + (size_t)cur.pm * tstep; const char* cB = (const char*)g.Bt + (size_t)cur.pn * tstep;
    S.a_ready(cur);
    if constexpr (SP2) {
        PG8_STAGE(PG8_SB(0, 0), cB, voffB); PG8_STAGE(PG8_SB(0, 1), cB + hstep, voffB); PG8_STAGE(PG8_SA(0, 0), cA, voffA); PG8_STAGE(PG8_SA(0, 1), cA + hstep, voffA);
        if (wr == 1) PG8_BAR;
        PG8_WAIT_V(2); PG8_BAR;
        PG8_STAGE(PG8_SB(1, 0), cB + kstep, voffB); PG8_STAGE(PG8_SA(1, 0), cA + kstep, voffA); PG8_STAGE(PG8_SB(1, 1), cB + hstep + kstep, voffB);
        PG8_WAIT_V(6); PG8_BAR;
    } else {
        PG8_STAGE(PG8_SB(0, 0), cB, voffB); PG8_STAGE(PG8_SA(0, 0), cA, voffA); PG8_STAGE(PG8_SB(0, 1), cB + hstep, voffB); PG8_STAGE(PG8_SA(0, 1), cA + hstep, voffA);
        if (wr == 1) PG8_BAR;
        PG8_WAIT_V(4); PG8_BAR;
        PG8_STAGE(PG8_SB(1, 0), cB + kstep, voffB); PG8_STAGE(PG8_SA(1, 0), cA + kstep, voffA); PG8_STAGE(PG8_SB(1, 1), cB + hstep + kstep, voffB);
        PG8_WAIT_V(6); PG8_BAR;
    }
    for (;;) {
        const bool has_next = S.next(ui + 1, nxt);
        const char* nA = has_next ? (const char*)g.A + (size_t)nxt.pm * tstep : cA; const char* nB = has_next ? (const char*)g.Bt + (size_t)nxt.pn * tstep : cB;
        for (int t = 0; t < nt; t += 2) {
            const bool last = (t == nt - 2);
            const char* a1 = cA + (size_t)(t + 1) * kstep;
            const char* a2 = last ? nA : cA + (size_t)(t + 2) * kstep; const char* b2 = last ? nB : cB + (size_t)(t + 2) * kstep;
            const char* a3 = a2 + kstep; const char* b3 = b2 + kstep;
            if (last && has_next) S.a_ready(nxt);
            if constexpr (SP2) {
            PG8_LDB(B0, 0, 0); PG8_LDB(B1, 0, 1); PG8_SCHED; PG8_LDA(At, 0, 0); PG8_STAGE(PG8_SA(1, 1), a1 + hstep, voffA);
            PG8_WAIT_V(8); PG8_WAIT_L(0); PG8_BAR; PG8_MMA(0, 0, At, B0); PG8_MMA(0, 1, At, B1); PG8_BAR; PG8_SCHED;
            PG8_LDA(At, 0, 1); PG8_STAGE(PG8_SB(0, 0), b2, voffB); PG8_STAGE(PG8_SB(0, 1), b2 + hstep, voffB); PG8_STAGE(PG8_SA(0, 0), a2, voffA);
            PG8_WAIT_V(8); PG8_WAIT_L(0); PG8_BAR; PG8_MMA(1, 0, At, B0); PG8_MMA(1, 1, At, B1); PG8_BAR; PG8_SCHED;
            PG8_LDB(B0, 1, 0); PG8_LDB(B1, 1, 1); PG8_SCHED; PG8_LDA(At, 1, 0); PG8_STAGE(PG8_SA(0, 1), a2 + hstep, voffA);
            PG8_WAIT_V(8); PG8_WAIT_L(0); PG8_BAR; PG8_MMA(0, 0, At, B0); PG8_MMA(0, 1, At, B1); PG8_BAR; PG8_SCHED;
            PG8_LDA(At, 1, 1); PG8_STAGE(PG8_SB(1, 0), b3, voffB); PG8_STAGE(PG8_SB(1, 1), b3 + hstep, voffB); PG8_STAGE(PG8_SA(1, 0), a3, voffA);
            PG8_WAIT_V(8); PG8_WAIT_L(0); PG8_BAR; PG8_MMA(1, 0, At, B0); PG8_MMA(1, 1, At, B1); PG8_BAR; PG8_SCHED;
            } else {
            PG8_LDB(B0, 0, 0); PG8_SCHED; PG8_LDA(At, 0, 0); PG8_STAGE(PG8_SA(1, 1), a1 + hstep, voffA);
            PG8_WAIT_L(8); PG8_BAR; PG8_WAIT_L(0); PG8_MMA(0, 0, At, B0); PG8_BAR; PG8_SCHED;
            PG8_LDB(B1, 0, 1); PG8_STAGE(PG8_SB(0, 0), b2, voffB);
            PG8_BAR; PG8_WAIT_L(0); PG8_MMA(0, 1, At, B1); PG8_BAR;
            PG8_LDA(At, 0, 1); PG8_STAGE(PG8_SA(0, 0), a2, voffA);
            PG8_BAR; PG8_WAIT_L(0); PG8_MMA(1, 0, At, B0); PG8_BAR; PG8_SCHED;
            PG8_STAGE(PG8_SB(0, 1), b2 + hstep, voffB);
            PG8_WAIT_V(6); PG8_BAR; PG8_MMA(1, 1, At, B1); PG8_BAR;
            PG8_LDB(B0, 1, 0); PG8_SCHED; PG8_LDA(At, 1, 0); PG8_STAGE(PG8_SA(0, 1), a2 + hstep, voffA);
            PG8_WAIT_L(8); PG8_BAR; PG8_WAIT_L(0); PG8_MMA(0, 0, At, B0); PG8_BAR; PG8_SCHED;
            PG8_LDB(B1, 1, 1); PG8_STAGE(PG8_SB(1, 0), b3, voffB);
            PG8_BAR; PG8_WAIT_L(0); PG8_MMA(0, 1, At, B1); PG8_BAR;
            PG8_LDA(At, 1, 1); PG8_STAGE(PG8_SA(1, 0), a3, voffA);
            PG8_BAR; PG8_WAIT_L(0); PG8_MMA(1, 0, At, B0); PG8_BAR; PG8_SCHED;
            PG8_STAGE(PG8_SB(1, 1), b3 + hstep, voffB);
            PG8_WAIT_V(6); PG8_BAR; PG8_MMA(1, 1, At, B1); PG8_BAR;
            }
        }
        if constexpr (ALIGN_EPI) { if (wr == 0) PG8_BAR; }
        E(acc, cur, wr, wc, fr, fq); S.done(cur);
        if (!has_next) break;
#pragma unroll
        for (int a = 0; a < 2; ++a)
#pragma unroll
            for (int b = 0; b < 2; ++b)
#pragma unroll
                for (int m = 0; m < 4; ++m)
#pragma unroll
                    for (int n = 0; n < 2; ++n) acc[a][b][m][n] = (f32x4){0.f, 0.f, 0.f, 0.f};
        cur = nxt; cA = nA; cB = nB; ++ui;
        if constexpr (ALIGN_EPI) { if (wr == 1) PG8_BAR; }
    }
    PG8_WAIT_V(0);
    if constexpr (!ALIGN_EPI) { if (wr == 0) PG8_BAR; }
    PG8_BAR;
#undef PG8_SA
#undef PG8_SB
#undef PG8_STAGE
#undef PG8_LDA
#undef PG8_LDB
#undef PG8_MMA
#undef PG8_WAIT_V
#undef PG8_WAIT_L
#undef PG8_BAR
#undef PG8_SCHED
}
}
constexpr bool G_ALIGN = true, G_SP2 = true;

template <class F>
DI void epi_foreach(const f32x4 (&acc)[2][2][4][2], const pg8::Unit& u, int wr, int wc, int fr, int fq, const F& f) {
#pragma unroll
    for (int ai = 0; ai < 2; ++ai)
#pragma unroll
        for (int m = 0; m < 4; ++m) {
            const int row = u.pm * 256 + ai * 128 + wr * 64 + m * 16 + fr;
#pragma unroll
            for (int bj = 0; bj < 2; ++bj) {
                const int col0 = u.pn * 256 + bj * 128 + wc * 32 + 8 * fq;
                float v[8];
#pragma unroll
                for (int k = 0; k < 4; ++k) { v[k] = acc[ai][bj][m][0][k]; v[4 + k] = acc[ai][bj][m][1][k]; }
                f(row, col0, v);
            }
        }
}
DI void store8_bf16(bf16_t* p, const float (&v)[8]) {
    u32x4 w; w.x = pk2(v[0], v[1]); w.y = pk2(v[2], v[3]); w.z = pk2(v[4], v[5]); w.w = pk2(v[6], v[7]);
    *(u32x4*)p = w;
}
DI void load8_bf16(const bf16_t* p, float (&v)[8]) {
    const u32x4 w = *(const u32x4*)p;
    v[0] = bflo(w.x); v[1] = bfhi(w.x); v[2] = bflo(w.y); v[3] = bfhi(w.y); v[4] = bflo(w.z); v[5] = bfhi(w.z); v[6] = bflo(w.w); v[7] = bfhi(w.w);
}
DI void load8_u8gate(const unsigned char* p, float (&g)[8]) {
    const u32x2 w = *(const u32x2*)p;
#pragma unroll
    for (int k = 0; k < 4; ++k) { g[k] = (float)((w.x >> (8 * k)) & 0xffu) * (1.0f / 255.0f); g[4 + k] = (float)((w.y >> (8 * k)) & 0xffu) * (1.0f / 255.0f); }
}
struct EpiProj {
    static constexpr bool PERM = true;
    bf16_t *qkv, *u; unsigned char* gates;
    DI void operator()(const f32x4 (&acc)[2][2][4][2], const pg8::Unit& un, int wr, int wc, int fr, int fq) const {
        const int pn = un.pn;
        if (pn < 12) { bf16_t* o = qkv; epi_foreach(acc, un, wr, wc, fr, fq, [&](int row, int col0, float (&v)[8]) { store8_bf16(o + (size_t)row * 3072 + col0, v); }); }
        else if (pn < 14) { bf16_t* o = u; epi_foreach(acc, un, wr, wc, fr, fq, [&](int row, int col0, float (&v)[8]) { store8_bf16(o + (size_t)row * 512 + (col0 - 3072), v); }); }
        else { unsigned char* o = gates; epi_foreach(acc, un, wr, wc, fr, fq, [&](int row, int col0, float (&v)[8]) {
                unsigned w0 = 0u, w1 = 0u;
#pragma unroll
                for (int k = 0; k < 4; ++k) { w0 |= (unsigned)(sigmoidf_(v[k]) * 255.0f + 0.5f) << (8 * k); w1 |= (unsigned)(sigmoidf_(v[4 + k]) * 255.0f + 0.5f) << (8 * k); }
                *(u32x2*)(o + (size_t)row * 4096 + (col0 - 3584)) = (u32x2){w0, w1}; }); }
    }
};


constexpr size_t WS_MRG = WS_HB;
constexpr size_t WS_X1B0 = 448 * MiB, WS_X1B1 = 928 * MiB;
DI bf16_t* x1b_row(unsigned char* ws, int m) { return (bf16_t*)(ws + ((m >> 14) ? WS_X1B1 : WS_X1B0)) + (size_t)(m & 16383) * D; }
struct EpiGlu {
    static constexpr bool PERM = true;
    const bf16_t* gy; const float* bglu; bf16_t* yg;
    DI void operator()(const f32x4 (&acc)[2][2][4][2], const pg8::Unit& un, int wr, int wc, int fr, int fq) const {
        epi_foreach(acc, un, wr, wc, fr, fq, [&](int row, int col0, float (&v)[8]) {
            float g[8]; load8_bf16(gy + (size_t)row * SW + col0, g);
#pragma unroll
            for (int k = 0; k < 8; ++k) v[k] = g[k] * sigmoidf_(v[k] + bglu[col0 + k]);
            store8_bf16(yg + (size_t)row * SW + col0, v); });
    }
};
struct EpiSsmUp {
    static constexpr bool PERM = true;
    const unsigned char* gates; bf16_t* mrg;
    DI void operator()(const f32x4 (&acc)[2][2][4][2], const pg8::Unit& un, int wr, int wc, int fr, int fq) const {
        epi_foreach(acc, un, wr, wc, fr, fq, [&](int row, int col0, float (&v)[8]) {
            float g[8]; load8_u8gate(gates + (size_t)row * 4096 + col0, g);
#pragma unroll
            for (int k = 0; k < 8; ++k) v[k] *= g[k];
            store8_bf16(mrg + (size_t)row * D + col0, v); });
    }
};
struct EpiAttnUp {
    static constexpr bool PERM = true;
    const unsigned char* gates; bf16_t* mrg;
    DI void operator()(const f32x4 (&acc)[2][2][4][2], const pg8::Unit& un, int wr, int wc, int fr, int fq) const {
        epi_foreach(acc, un, wr, wc, fr, fq, [&](int row, int col0, float (&v)[8]) {
            float g[8], o[8]; load8_u8gate(gates + (size_t)row * 4096 + 2048 + col0, g); load8_bf16(mrg + (size_t)row * D + col0, o);
#pragma unroll
            for (int k = 0; k < 8; ++k) v[k] = v[k] * g[k] + o[k];
            store8_bf16(mrg + (size_t)row * D + col0, v); });
    }
};
struct EpiOut {
    static constexpr bool PERM = true;
    const float* x; const float* mod; const float* bada; unsigned char* ws;
    DI void operator()(const f32x4 (&acc)[2][2][4][2], const pg8::Unit& un, int wr, int wc, int fr, int fq) const {
        epi_foreach(acc, un, wr, wc, fr, fq, [&](int row, int col0, float (&v)[8]) {
            const int b = row >> 14;
            const float* gp = mod + b * NMOD + 2 * D + col0;
            const f32x4 g0 = *(const f32x4*)gp, g1 = *(const f32x4*)(gp + 4);
            const f32x4 x0 = *(const f32x4*)(x + (size_t)row * D + col0), x1 = *(const f32x4*)(x + (size_t)row * D + col0 + 4);
            f32x4 r0, r1;
#pragma unroll
            for (int k = 0; k < 4; ++k) { r0[k] = x0[k] + g0[k] * v[k]; r1[k] = x1[k] + g1[k] * v[4 + k]; }
            *(u32x4*)(x1b_row(ws, row) + col0) = (u32x4){pk2(r0[0], r0[1]), pk2(r0[2], r0[3]), pk2(r1[0], r1[1]), pk2(r1[2], r1[3])}; });
    }
};


constexpr size_t WS_PUS = 112 * MiB, WS_PVS = 112 * MiB + 512 * 1024;
constexpr int ROWB = 1536;
typedef float f32x2 __attribute__((ext_vector_type(2)));
typedef float v16f __attribute__((ext_vector_type(16)));
typedef float v32f __attribute__((ext_vector_type(32)));
typedef unsigned v6u __attribute__((ext_vector_type(6)));
typedef unsigned v16u __attribute__((ext_vector_type(16)));
typedef __bf16 v32bf __attribute__((ext_vector_type(32)));
DI v32f fp6_unpack_f32(const v6u w) { v32f r; asm volatile("s_nop 1\n\tv_cvt_scalef32_pk32_f32_fp6 %0, %1, 1.0\n\ts_nop 15" : "=&v"(r) : "v"(w)); return r; }
DI v16u fp6_unpack_bf16(const v6u w) { v16u r; asm volatile("s_nop 1\n\tv_cvt_scalef32_pk32_bf16_fp6 %0, %1, 1.0\n\ts_nop 15" : "=&v"(r) : "v"(w)); return r; }

DI unsigned fp6_code(float x) {
    const float a = fminf(fabsf(x), 7.5f);
    const float c = a < 2.0f ? a * 8.0f : (a < 4.0f ? 8.0f + a * 4.0f : 16.0f + a * 2.0f);
    const unsigned q = (unsigned)__builtin_rintf(c);
    return q | ((__float_as_uint(x) >> 31) << 5);
}
DI v6u fp6_pack_sw(const float (&e)[32]) {
    unsigned long long lo = 0, mid = 0, hi = 0;
#pragma unroll
    for (int i = 0; i < 32; ++i) {
        const unsigned long long c = fp6_code(e[i]);
        const int bit = 6 * i;
        if (bit < 64) { lo |= c << bit; if (bit > 58) mid |= c >> (64 - bit); }
        else if (bit < 128) { mid |= c << (bit - 64); if (bit > 122) hi |= c >> (128 - bit); }
        else hi |= c << (bit - 128);
    }
    v6u w; w[0] = (unsigned)lo; w[1] = (unsigned)(lo >> 32); w[2] = (unsigned)mid; w[3] = (unsigned)(mid >> 32); w[4] = (unsigned)hi; w[5] = (unsigned)(hi >> 32);
    return w;
}
DI void fp6_row_convert(const float* src, unsigned char* dst, float* inv_scale, int lane) {
    f32x4 v[8]; float mx = 0.f;
#pragma unroll
    for (int q = 0; q < 8; ++q) { v[q] = *(const f32x4*)(src + 32 * lane + 4 * q);
        mx = fmaxf(mx, fmaxf(fmaxf(fabsf(v[q].x), fabsf(v[q].y)), fmaxf(fabsf(v[q].z), fabsf(v[q].w)))); }
#pragma unroll
    for (int o = 1; o < 64; o <<= 1) mx = fmaxf(mx, __shfl_xor(mx, o));
    int ex = 1; if (mx > 0.f) (void)frexpf(7.5f / mx, &ex);
    const float S = ldexpf(1.0f, ex - 1);
    float el[32];
#pragma unroll
    for (int q = 0; q < 8; ++q) { el[4 * q] = v[q].x * S; el[4 * q + 1] = v[q].y * S; el[4 * q + 2] = v[q].z * S; el[4 * q + 3] = v[q].w * S; }
    const v6u w = fp6_pack_sw(el);
    *(u32x4*)(dst + 16 * lane) = (u32x4){w[0], w[1], w[2], w[3]};
    *(u32x2*)(dst + 1024 + 8 * lane) = (u32x2){w[4], w[5]};
    if (lane == 0) *inv_scale = 1.0f / S;
}
DI v6u fp6_load(const unsigned char* row, int lane) {
    const u32x4 a_ = *(const u32x4*)(row + 16 * lane); const u32x2 b_ = *(const u32x2*)(row + 1024 + 8 * lane);
    v6u w; w[0] = a_[0]; w[1] = a_[1]; w[2] = a_[2]; w[3] = a_[3]; w[4] = b_[0]; w[5] = b_[1]; return w;
}
DI float fp6_at(const unsigned char* row, int k) {
    const v6u w = fp6_load(row, k >> 5);
    const v32f r = fp6_unpack_f32(w);
    float o = 0.f;
#pragma unroll
    for (int i = 0; i < 32; ++i) o = ((k & 31) == i) ? r[i] : o;
    return o;
}


#ifndef TAB4
#define TAB4 1
#endif
#ifndef P10_SLICED
#define P10_SLICED 1
#endif
#ifndef XTRA
#define XTRA 0
#endif
#ifndef DUP
#define DUP 0
#endif
constexpr int ROWB4 = 1024;
constexpr size_t WS_PUE = 177 * MiB, WS_PVE = 178 * MiB;
DI unsigned fp4_idx(float a) { return (unsigned)(a > 0.25f) + (unsigned)(a > 0.75f) + (unsigned)(a > 1.25f) + (unsigned)(a > 1.75f) + (unsigned)(a > 2.5f) + (unsigned)(a > 3.5f) + (unsigned)(a > 5.0f); }
DI void row_load32(const float* src, int lane, f32x4 (&v)[8]) {
#pragma unroll
    for (int q = 0; q < 8; ++q) v[q] = *(const f32x4*)(src + 32 * lane + 4 * q);
}
DI void fp4_row_pack(const f32x4 (&v)[8], unsigned char* dst, unsigned char* sdst, int lane) {
    float mx = 0.f;
#pragma unroll
    for (int q = 0; q < 8; ++q) mx = fmaxf(mx, fmaxf(fmaxf(fabsf(v[q].x), fabsf(v[q].y)), fmaxf(fabsf(v[q].z), fabsf(v[q].w))));
    int ex = 1; if (mx > 0.f) (void)frexpf(6.0f / mx, &ex);
    int lg = ex - 1; lg = lg < -100 ? -100 : (lg > 100 ? 100 : lg);
    const float S = ldexpf(1.0f, lg);
    unsigned w[4];
#pragma unroll
    for (int d = 0; d < 4; ++d) {
        unsigned acc = 0u;
#pragma unroll
        for (int e = 0; e < 8; ++e) { const int i = 8 * d + e; const float x = v[i >> 2][i & 3];
            acc |= (fp4_idx(fabsf(x) * S) | ((__float_as_uint(x) >> 31) << 3)) << (4 * e); }
        w[d] = acc;
    }
    *(u32x4*)(dst + 16 * lane) = (u32x4){w[0], w[1], w[2], w[3]};
    sdst[lane] = (unsigned char)(127 - lg);
}
DI void fp4_unpack8(const unsigned w, f32x2 (&r)[4]) {
    r[0] = __builtin_amdgcn_cvt_scalef32_pk_f32_fp4(w, 1.0f, 0); r[1] = __builtin_amdgcn_cvt_scalef32_pk_f32_fp4(w, 1.0f, 1);
    r[2] = __builtin_amdgcn_cvt_scalef32_pk_f32_fp4(w, 1.0f, 2); r[3] = __builtin_amdgcn_cvt_scalef32_pk_f32_fp4(w, 1.0f, 3);
}
DI float fp4_at(const unsigned char* row, const unsigned char* srow, int k) {
    const unsigned w = ((const unsigned*)row)[k >> 3]; f32x2 r[4]; fp4_unpack8(w, r);
    const int e = k & 7; float o = 0.f;
#pragma unroll
    for (int z = 0; z < 4; ++z) o = ((e >> 1) == z) ? ((e & 1) ? r[z][1] : r[z][0]) : o;
    return o * __uint_as_float((unsigned)srow[k >> 5] << 23);
}

#ifndef U4
#define U4 1
#endif
constexpr size_t WS_PUS4 = 80 * MiB;
constexpr size_t WS_H4 = WS_HB;
constexpr size_t WS_HS = WS_HB + 96 * MiB;
DI float u4_step(int code) { return exp2f((float)(code - 208) * 0.0625f); }
DI void int4_row_pack(const f32x4 (&v)[8], unsigned char* dst, unsigned char* sdst, int lane) {
    float mx = 0.f;
#pragma unroll
    for (int q = 0; q < 8; ++q) mx = fmaxf(mx, fmaxf(fmaxf(fabsf(v[q].x), fabsf(v[q].y)), fmaxf(fabsf(v[q].z), fabsf(v[q].w))));
    int code = 0;
    if (mx > 0.f) { code = (int)ceilf(16.0f * log2f(mx * (1.0f / 7.0f))) + 208; code = code < 0 ? 0 : (code > 255 ? 255 : code); }
    const float S = 1.0f / u4_step(code);
    unsigned w[4];
#pragma unroll
    for (int d = 0; d < 4; ++d) {
        unsigned acc = 0u;
#pragma unroll
        for (int e = 0; e < 8; ++e) { const int i = 8 * d + e; const float x = v[i >> 2][i & 3];
            int q = (int)rintf(x * S); q = q < -7 ? -7 : (q > 7 ? 7 : q);
            acc |= ((unsigned)q & 15u) << (4 * e); }
        w[d] = acc;
    }
    *(u32x4*)(dst + 16 * lane) = (u32x4){w[0], w[1], w[2], w[3]};
    sdst[lane] = (unsigned char)code;
}
DI void transpose_item(const float* W, int ldw, int src_n0, bf16_t* WT, int K, int dst_n0, int k0, LAS float* scr, int lane) {
#pragma unroll
    for (int i = 0; i < 32; ++i) { const int kk = 2 * i + (lane >> 5); scr[kk * 33 + (lane & 31)] = W[(size_t)(k0 + kk) * ldw + src_n0 + (lane & 31)]; }
    LDS_WAIT();
    const int c = lane & 7;
#pragma unroll
    for (int j = 0; j < 4; ++j) { const int n = (lane >> 3) + 8 * j; const LAS float* s = scr + (8 * c) * 33 + n;
        u32x4 o; o.x = pk2(s[0 * 33], s[1 * 33]); o.y = pk2(s[2 * 33], s[3 * 33]); o.z = pk2(s[4 * 33], s[5 * 33]); o.w = pk2(s[6 * 33], s[7 * 33]);
        *(u32x4*)(WT + (size_t)(dst_n0 + n) * K + k0 + 8 * c) = o; }
    LDS_WAIT();
}
DI void convert_stream(const float* src, bf16_t* dst, size_t n, size_t gthread, size_t nthreads) {
    for (size_t i = gthread * 8; i < n; i += nthreads * 8) {
        const f32x4 a = *(const f32x4*)(src + i), b = *(const f32x4*)(src + i + 4);
        u32x4 o; o.x = pk2(a.x, a.y); o.y = pk2(a.z, a.w); o.z = pk2(b.x, b.y); o.w = pk2(b.z, b.w);
        *(u32x4*)(dst + i) = o;
    }
}
DI void phase0(const Args& a, LAS unsigned char* lds) {
    const int tid = otid(), lane = tid & 63, wave = tid >> 6, G = gridDim.x, blk = blockIdx.x;
    unsigned char* ws = a.ws;
    {
        LAS float* sc = (LAS float*)lds;
        LAS float* red = (LAS float*)(lds + 16384);
        float* mod = (float*)(ws + WS_CTL) + CW_MOD;
        if (blk < 192) {
            for (int i = tid; i < 2 * D; i += NTHREADS) sc[i] = siluf_(a.c[i]);
            __syncthreads();
            for (int it = blk; it < 192; it += G) {
                const int cq = tid & 15, kg = tid >> 4;
                const float* wp = a.w_ada + (size_t)(kg * 64) * NMOD + it * 64 + 4 * cq;
                f32x4 a0 = (f32x4){0.f, 0.f, 0.f, 0.f}, a1 = a0;
#pragma unroll 16
                for (int kk = 0; kk < 64; ++kk) { const f32x4 w = *(const f32x4*)(wp + (size_t)kk * NMOD); a0 += w * sc[kg * 64 + kk]; a1 += w * sc[D + kg * 64 + kk]; }
                *(LAS f32x4*)(red + (kg * 2 + 0) * 64 + 4 * cq) = a0; *(LAS f32x4*)(red + (kg * 2 + 1) * 64 + 4 * cq) = a1;
                __syncthreads();
                if (tid < 128) { const int b = tid >> 6, c = tid & 63; float s = 0.f;
#pragma unroll
                    for (int q = 0; q < 32; ++q) s += red[(q * 2 + b) * 64 + c];
                    mod[b * NMOD + it * 64 + c] = s + a.b_ada[it * 64 + c]; }
                __syncthreads();
            }
        }
        __syncthreads();
    }
    LAS float* scr = (LAS float*)(lds + wave * 16384);
    const int gw = blk * NWAVES + wave, NGW = G * NWAVES;
    constexpr int I_IN = 32 * 240, I_GLU = 8 * 16, I_SSM = 8 * 64, I_ATT = 16 * 64, I_OUT = 32 * 64, I_PQ = 32 * 64;
    constexpr int NIT = I_IN + I_GLU + I_SSM + I_ATT + I_OUT + I_PQ;
    for (int it = gw; it < NIT; it += NGW) {
        int r = it;
        if (r < I_IN) { const int kb = r / 240, nb = r % 240, n0 = nb * 32; transpose_item(a.w_in, INW, n0 + (n0 >= 3072 ? 8 : 0), (bf16_t*)(ws + WS_WIN), D, n0, kb * 64, scr, lane); continue; } r -= I_IN;
        if (r < I_GLU) { const int kb = r / 16, nb = r % 16; transpose_item(a.w_glu, SW, nb * 32, (bf16_t*)(ws + WS_WGLU), SW, nb * 32, kb * 64, scr, lane); continue; } r -= I_GLU;
        if (r < I_SSM) { const int kb = r / 64, nb = r % 64; transpose_item(a.w_ssm_up, D, nb * 32, (bf16_t*)(ws + WS_WSSM), SW, nb * 32, kb * 64, scr, lane); continue; } r -= I_SSM;
        if (r < I_ATT) { const int kb = r / 64, nb = r % 64; transpose_item(a.w_attn_up, D, nb * 32, (bf16_t*)(ws + WS_WATTN), AW, nb * 32, kb * 64, scr, lane); continue; } r -= I_ATT;
        if (r < I_OUT) { const int kb = r / 64, nb = r % 64; transpose_item(a.w_out, D, nb * 32, (bf16_t*)(ws + WS_WOUT), D, nb * 32, kb * 64, scr, lane); continue; } r -= I_OUT;
        { const int kb = r / 64, nb = r % 64; transpose_item(a.w_peer_q, D, nb * 32, (bf16_t*)(ws + WS_WPQ), D, nb * 32, kb * 64, scr, lane); }
    }
    {
        float* wf = (float*)(ws + WS_WF);
        for (int i = blk * NTHREADS + tid; i < 8 * D; i += G * NTHREADS) { const int j = i >> 11, k = i & 2047; wf[i] = a.w_in[(size_t)k * INW + 3072 + j]; }
    }
    const size_t gt = (size_t)blk * NTHREADS + tid, nthr = (size_t)G * NTHREADS;
    convert_stream(a.sub_keys, (bf16_t*)(ws + WS_KEYS), (size_t)16 * 128 * 128, gt, nthr);
    {
        constexpr int NCH = 2 * NEXP / 16;
        const int ntrip = 2 * ((NCH + G - 1) / G);
        f32x4 cur[8], nxt[8];
        {   const int r0 = 16 * blk + 2 * wave;
            if (blk < NCH) row_load32((r0 >= NEXP ? a.peer_v : a.peer_u) + (size_t)(r0 & (NEXP - 1)) * D, lane, cur); }
        for (int rr = 0; rr < ntrip; ++rr) {
            const int ch = blk + (rr >> 1) * G, r = 16 * ch + 2 * wave + (rr & 1);
            if (ch >= NCH) break;
            {   const int chn = blk + ((rr + 1) >> 1) * G, rn0 = 16 * chn + 2 * wave + ((rr + 1) & 1), rn = (rr + 1 < ntrip && chn < NCH) ? rn0 : r;
                row_load32((rn >= NEXP ? a.peer_v : a.peer_u) + (size_t)(rn & (NEXP - 1)) * D, lane, nxt); }
            const int tb = r >= NEXP, e = r - tb * NEXP;
            unsigned char* sd = ws + (tb ? WS_PVE : WS_PUS4) + (size_t)(lane >> 3) * (NEXP * 8) + (size_t)e * 8 + (lane & 7) - lane;
            if (!tb) int4_row_pack(cur, ws + WS_PU + (size_t)e * ROWB4, sd, lane);
            else fp4_row_pack(cur, ws + WS_PV + (size_t)e * ROWB4, sd, lane);
#pragma unroll
            for (int q = 0; q < 8; ++q) cur[q] = nxt[q];
        }
    }
}


DI int affine_row(int blk, int wave, int i, int G) {
    if (G == 256) return 4096 * (blk & 7) + 128 * (blk >> 3) + 16 * wave + i;
    return (blk * NWAVES + wave) + i * (G * NWAVES);
}
template <bool WITH_F, bool XBF = false>
DI void row_pass(const Args& a, LAS unsigned char* lds, const float* xin, const float* normw, int shift_idx, int scale_idx, bf16_t* hb) {
    const int tid = otid(), lane = tid & 63, wave = tid >> 6, G = gridDim.x, blk = blockIdx.x;
    const float* mod = (const float*)(a.ws + WS_CTL) + CW_MOD;
    LAS f32x4* wfl = (LAS f32x4*)lds;
    if (WITH_F) {
        const f32x4* wf = (const f32x4*)(a.ws + WS_WF);
        for (int i = tid; i < 8 * 512; i += NTHREADS) wfl[i] = wf[i];
        __syncthreads();
    }
    const int gw = blk * NWAVES + wave, NGW = G * NWAVES;
    int curb = -1;
    f32x4 gg[8], sh[8], vn[8];
    (void)gw;
    {   const int m0 = affine_row(blk, wave, 0, G);
        if (m0 < T) {
            if (XBF) { const u32x2* xr = (const u32x2*)x1b_row(a.ws, m0) + lane;
#pragma unroll
                for (int j = 0; j < 8; ++j) { const u32x2 w = xr[64 * j]; vn[j] = (f32x4){bflo(w.x), bfhi(w.x), bflo(w.y), bfhi(w.y)}; } }
            else { const f32x4* xr = (const f32x4*)(xin + (size_t)m0 * D) + lane;
#pragma unroll
                for (int j = 0; j < 8; ++j) vn[j] = xr[64 * j]; } } }
    for (int ri = 0; ri < (T + NGW - 1) / NGW; ++ri) {
        const int m = affine_row(blk, wave, ri, G);
        if (m >= T) break;
        const int b = m >> 14;
        if (b != curb) {
            curb = b;
#pragma unroll
            for (int j = 0; j < 8; ++j) {
                const int e = 4 * (lane + 64 * j);
                const f32x4 nw = *(const f32x4*)(normw + e);
                const f32x4 sc = *(const f32x4*)(mod + b * NMOD + scale_idx * D + e);
                sh[j] = *(const f32x4*)(mod + b * NMOD + shift_idx * D + e);
                gg[j] = nw * (sc + 1.0f);
            }
        }
        f32x4 v[8]; float ss = 0.f;
#pragma unroll
        for (int j = 0; j < 8; ++j) { v[j] = vn[j]; ss += (v[j].x * v[j].x + v[j].y * v[j].y) + (v[j].z * v[j].z + v[j].w * v[j].w); }
        {
            const int mn0 = (ri + 1 < (T + NGW - 1) / NGW) ? affine_row(blk, wave, ri + 1, G) : m, mn = mn0 < T ? mn0 : m;
            if (XBF) { const u32x2* xr = (const u32x2*)x1b_row(a.ws, mn) + lane;
#pragma unroll
                for (int j = 0; j < 8; ++j) { const u32x2 w = xr[64 * j]; vn[j] = (f32x4){bflo(w.x), bfhi(w.x), bflo(w.y), bfhi(w.y)}; } }
            else { const f32x4* xr = (const f32x4*)(xin + (size_t)mn * D) + lane;
#pragma unroll
                for (int j = 0; j < 8; ++j) vn[j] = xr[64 * j]; }
        }
        const float r = rsqrtf(wave_sum(ss) * (1.0f / D) + RMS_EPS);
#pragma unroll
        for (int j = 0; j < 8; ++j) v[j] = v[j] * r * gg[j] + sh[j];
        u32x2* o = (u32x2*)(hb + (size_t)m * D) + lane;
#pragma unroll
        for (int j = 0; j < 8; ++j) { u32x2 w; w.x = pk2(v[j].x, v[j].y); w.y = pk2(v[j].z, v[j].w); o[64 * j] = w; }
        if (WITH_F) {
            float mine = 0.f;
#pragma unroll 1
            for (int q = 0; q < 8; q += 2) {
                float s0 = 0.f, s1 = 0.f;
#pragma unroll
                for (int j = 0; j < 8; ++j) { const f32x4 w0 = wfl[q * 512 + lane + 64 * j], w1 = wfl[(q + 1) * 512 + lane + 64 * j];
                    s0 += (v[j].x * w0.x + v[j].y * w0.y) + (v[j].z * w0.z + v[j].w * w0.w); s1 += (v[j].x * w1.x + v[j].y * w1.y) + (v[j].z * w1.z + v[j].w * w1.w); }
                s0 = wave_sum(s0); s1 = wave_sum(s1);
                mine = (lane == q) ? s0 : mine; mine = (lane == q + 1) ? s1 : mine;
            }
            if (lane < 8) {
                const float z = mine + a.b_forget[lane];
                const float ls = fminf(z, 0.f) - log1pf(__expf(-fabsf(z)));
                ((float*)(a.ws + WS_LF))[(size_t)m * 8 + lane] = ls;
            }
        }
    }
}


constexpr size_t WS_VT = 113 * MiB;
constexpr size_t WS_DBGS = 928 * MiB;
DI void phase2b(const Args& a, LAS unsigned char* lds) {
    const int tid = otid(), lane = tid & 63, wave = tid >> 6, G = gridDim.x, blk = blockIdx.x;
    const int gw = blk * NWAVES + wave, NGW = G * NWAVES;
    bf16_t* qkv = (bf16_t*)(a.ws + WS_QKV);
    if (gw < NB * AH * 8) {
        const int bh = gw >> 3, seg = gw & 7, b = bh >> 3, h = bh & 7;
        const float* lf = (const float*)(a.ws + WS_LF);
        float* F = (float*)(a.ws + WS_F) + (size_t)bh * SEQ + seg * 2048;
        double carry = 0.0;
        float xv[32];
#pragma unroll
        for (int c = 0; c < 32; ++c) xv[c] = lf[((size_t)b * SEQ + seg * 2048 + c * 64 + lane) * 8 + h];
#pragma unroll
        for (int c = 0; c < 32; ++c) {
            double x = (double)xv[c];
#pragma unroll
            for (int o = 1; o < 64; o <<= 1) { const double t = __shfl_up(x, o); if (lane >= o) x += t; }
            F[c * 64 + lane] = (float)((carry + x) * 1.4426950408889634);
            carry += __shfl(x, 63);
        }
        if (lane == 0) ((float*)(a.ws + WS_CTL) + CW_SEGT)[gw] = (float)(carry * 1.4426950408889634);
    }
    {
        const int head = lane >> 3, d0 = (lane & 7) * 16;
        float wq[16], wk[16];
        const float QS = 0.08838834764831845f * LOG2E;
#pragma unroll
        for (int i = 0; i < 16; ++i) { wq[i] = a.q_norm_w[d0 + i] * QS; wk[i] = a.k_norm_w[d0 + i]; }
        for (int ri = 0; ri < (T + NGW - 1) / NGW; ++ri) {
            const int m = affine_row(blk, wave, ri, G);
            if (m >= T) break;
            bf16_t* row = qkv + (size_t)m * 3072 + head * 128 + d0;
#pragma unroll
            for (int qk = 0; qk < 2; ++qk) {
                bf16_t* p = row + qk * 1024;
                float v[16]; float va[8], vb[8];
                load8_bf16(p, va); load8_bf16(p + 8, vb);
#pragma unroll
                for (int i = 0; i < 8; ++i) { v[i] = va[i]; v[8 + i] = vb[i]; }
                float ss = 0.f;
#pragma unroll
                for (int i = 0; i < 16; ++i) ss += v[i] * v[i];
                ss += __shfl_xor(ss, 1); ss += __shfl_xor(ss, 2); ss += __shfl_xor(ss, 4);
                const float r = rsqrtf(ss * (1.0f / HD) + RMS_EPS);
#pragma unroll
                for (int i = 0; i < 8; ++i) { va[i] = v[i] * r * (qk ? wk[i] : wq[i]); vb[i] = v[8 + i] * r * (qk ? wk[8 + i] : wq[8 + i]); }
                store8_bf16(p, va); store8_bf16(p + 8, vb);
            }
        }
    }
    {
        LAS unsigned char* tile = lds + wave * 17408;
        bf16_t* vt = (bf16_t*)(a.ws + WS_VT);
        for (int it = gw; it < NB * AH * (SEQ / 64); it += NGW) {
            const int b = it / (AH * 256), h = (it / 256) % AH, c = it % 256;
            const size_t m0 = (size_t)b * SEQ + c * 64;
#pragma unroll 4
            for (int i = 0; i < 16; ++i) { const int row = 4 * i + (lane >> 4), ch = lane & 15;
                const u32x4 v = *(const u32x4*)(qkv + (m0 + row) * 3072 + 2048 + h * 128 + ch * 8);
                *(LAS u32x4*)(tile + row * 272 + ch * 16) = v; }
            LDS_WAIT();
#pragma unroll 1
            for (int dd = 0; dd < 2; ++dd) {
                const int d = lane + 64 * dd;
                bf16_t* dst = vt + (((size_t)(b * AH + h) * (SEQ / 64) + c) * HD + d) * 64;
#pragma unroll
                for (int g4 = 0; g4 < 4; ++g4) {
                    unsigned w[8];
#pragma unroll
                    for (int pp = 0; pp < 8; ++pp) {
                        const int p0 = 2 * pp, p1 = 2 * pp + 1;
                        const int k0 = 8 * ((p0 >> 2) & 1) + 4 * (p0 >> 3) + (p0 & 3), k1 = 8 * ((p1 >> 2) & 1) + 4 * (p1 >> 3) + (p1 & 3);
                        const unsigned lo = *(const LAS unsigned short*)(tile + (g4 * 16 + k0) * 272 + d * 2);
                        const unsigned hi = *(const LAS unsigned short*)(tile + (g4 * 16 + k1) * 272 + d * 2);
                        w[pp] = lo | (hi << 16);
                    }
                    *(u32x4*)(dst + g4 * 16) = (u32x4){w[0], w[1], w[2], w[3]};
                    *(u32x4*)(dst + g4 * 16 + 8) = (u32x4){w[4], w[5], w[6], w[7]};
                }
            }
            LDS_WAIT();
        }
    }
}

DI void attn_item(const Args& a, LAS unsigned char* lds, int b, int h, int qb, float thr2) {
    const int tid = otid(), lane = tid & 63, wave = __builtin_amdgcn_readfirstlane(tid >> 6), q = lane & 31, hh = lane >> 5;
    const bf16_t* qkv = (const bf16_t*)(a.ws + WS_QKV);
    const bf16_t* vt = (const bf16_t*)(a.ws + WS_VT) + (size_t)(b * AH + h) * HD * SEQ;
    const float* Floc = (const float*)(a.ws + WS_F) + (size_t)(b * AH + h) * SEQ;
    LAS float* offl = (LAS float*)(lds + 33024);
    if (tid < 8) { const float* st = (const float*)(a.ws + WS_CTL) + CW_SEGT + (b * AH + h) * 8; float s = 0.f; for (int i = 0; i < tid; ++i) s += st[i]; offl[tid] = s; }
    __syncthreads();
    auto F = [&](int i) -> float { return Floc[i] + offl[i >> 11]; };
    const int t0 = qb * 256, tw0 = t0 + 32 * wave, t = tw0 + q;
    const size_t mrow = (size_t)b * SEQ;
    LAS unsigned char* Kl = lds; LAS unsigned char* Vl = lds + 16384; LAS float* Fl = (LAS float*)(lds + 32768);
    int j0;
    {
        const float Ft0 = F(t0); const int jd = t0 / 64; int need = 0;
        for (int k = 0; k < 4; ++k) {
            const int jj = jd - 1 - (64 * k + lane);
            const bool nd = (jj >= 0) && (Ft0 - F(jj >= 0 ? 64 * jj + 63 : 0) > -thr2);
            const unsigned long long bal = __ballot(nd);
            need += __popcll(bal);
            if (bal != ~0ull) break;
        }
        j0 = jd - need;
    }
    const int jend = t0 / 64 + 3;
    bf16x8 qf[8];
#pragma unroll
    for (int ks = 0; ks < 8; ++ks) qf[ks] = *(const bf16x8*)(qkv + (mrow + t) * 3072 + h * 128 + ks * 16 + hh * 8);
    const float Fq = F(t);
    f32x16 o[4];
#pragma unroll
    for (int i = 0; i < 4; ++i)
#pragma unroll
        for (int r = 0; r < 16; ++r) o[i][r] = 0.f;
    float mrun = -1e30f, lrun = 0.f;
    u32x4 kreg[2], vreg[2]; float freg = 0.f;
    auto issue = [&](int j) {
#pragma unroll
        for (int i = 0; i < 2; ++i) { const int idx = tid + 512 * i;
            kreg[i] = *(const u32x4*)(qkv + (mrow + 64 * j + (idx >> 4)) * 3072 + 1024 + h * 128 + (idx & 15) * 8);
            vreg[i] = *(const u32x4*)(vt + (size_t)j * (HD * 64) + (size_t)idx * 8); }
        if (tid < 64) freg = F(64 * j + tid);
    };
    auto commit = [&]() {
#pragma unroll
        for (int i = 0; i < 2; ++i) { const int idx = tid + 512 * i;
            { const int r = idx >> 4, ch = idx & 15; *(LAS u32x4*)(Kl + r * 256 + ((ch ^ (r & 15)) << 4)) = kreg[i]; }
            { const int d = idx >> 3, ch = idx & 7; *(LAS u32x4*)(Vl + d * 128 + ((ch ^ ((d >> 1) & 7)) << 4)) = vreg[i]; } }
        if (tid < 64) Fl[tid] = freg;
    };
    issue(j0);
    for (int j = j0; j <= jend; ++j) {
        __syncthreads();
        commit();
        __syncthreads();
        if (j < jend) issue(j + 1);
        if (64 * j <= tw0 + 31) {
            f32x16 sacc[2];
#pragma unroll
            for (int rb = 0; rb < 2; ++rb) {
#pragma unroll
                for (int r = 0; r < 16; ++r) sacc[rb][r] = 0.f;
#pragma unroll
                for (int ks = 0; ks < 8; ++ks) {
                    const int r = rb * 32 + q, ch = ks * 2 + hh;
                    const bf16x8 kf = *(const LAS bf16x8*)(Kl + r * 256 + ((ch ^ (r & 15)) << 4));
                    sacc[rb] = __builtin_amdgcn_mfma_f32_32x32x16_bf16(kf, qf[ks], sacc[rb], 0, 0, 0);
                }
            }
            const bool diag = (64 * j + 63 > tw0);
            float mx = -1e30f;
#pragma unroll
            for (int rb = 0; rb < 2; ++rb)
#pragma unroll
                for (int g4 = 0; g4 < 4; ++g4) {
                    const f32x4 fs = *(const LAS f32x4*)(Fl + rb * 32 + 8 * g4 + 4 * hh);
#pragma unroll
                    for (int i = 0; i < 4; ++i) {
                        const int reg = 4 * g4 + i;
                        float s = sacc[rb][reg] + (Fq - fs[i]);
                        if (diag) { const int key = 64 * j + rb * 32 + 8 * g4 + 4 * hh + i; s = (key > t) ? -1e30f : s; }
                        sacc[rb][reg] = s; mx = fmaxf(mx, s);
                    }
                }
            mx = fmaxf(mx, __shfl_xor(mx, 32));
            if (__ballot(mx > mrun + 8.0f) != 0ull) {
                const float mnew = fmaxf(mrun, mx);
                const float alpha = __builtin_amdgcn_exp2f(mrun - mnew);
                mrun = mnew;
                lrun *= alpha;
#pragma unroll
                for (int i = 0; i < 4; ++i)
#pragma unroll
                    for (int r = 0; r < 16; ++r) o[i][r] *= alpha;
            }
            float ps = 0.f;
#pragma unroll
            for (int rb = 0; rb < 2; ++rb)
#pragma unroll
                for (int r = 0; r < 16; ++r) { const float p = __builtin_amdgcn_exp2f(sacc[rb][r] - mrun); sacc[rb][r] = p; ps += p; }
            lrun += ps;
#pragma unroll
            for (int rb = 0; rb < 2; ++rb)
#pragma unroll
                for (int s2 = 0; s2 < 2; ++s2) {
                    u32x4 pw; pw.x = pk2(sacc[rb][8 * s2 + 0], sacc[rb][8 * s2 + 1]); pw.y = pk2(sacc[rb][8 * s2 + 2], sacc[rb][8 * s2 + 3]);
                    pw.z = pk2(sacc[rb][8 * s2 + 4], sacc[rb][8 * s2 + 5]); pw.w = pk2(sacc[rb][8 * s2 + 6], sacc[rb][8 * s2 + 7]);
                    const bf16x8 pf = __builtin_bit_cast(bf16x8, pw);
                    const int ch = rb * 4 + s2 * 2 + hh;
#pragma unroll
                    for (int db = 0; db < 4; ++db) {
                        const int d = db * 32 + q;
                        const bf16x8 vf = *(const LAS bf16x8*)(Vl + d * 128 + ((ch ^ ((d >> 1) & 7)) << 4));
                        o[db] = __builtin_amdgcn_mfma_f32_32x32x16_bf16(vf, pf, o[db], 0, 0, 0);
                    }
                }
        }
    }
    const float ltot = lrun + __shfl_xor(lrun, 32);
    const float inv = 1.0f / ltot;
    bf16_t* yo = (bf16_t*)(a.ws + WS_YATT) + (mrow + t) * AW + h * 128;
#pragma unroll
    for (int db = 0; db < 4; ++db)
#pragma unroll
        for (int g4 = 0; g4 < 4; ++g4) {
            u32x2 w; w.x = pk2(o[db][4 * g4] * inv, o[db][4 * g4 + 1] * inv); w.y = pk2(o[db][4 * g4 + 2] * inv, o[db][4 * g4 + 3] * inv);
            *(u32x2*)(yo + db * 32 + 8 * g4 + 4 * hh) = w;
        }
    __syncthreads();
}


constexpr size_t WS_S5POW = WS_S5TAB;
constexpr size_t WS_S5BB = WS_S5TAB + 512 * 1024;
constexpr size_t WS_S5Q = WS_S5TAB + 1 * MiB;
constexpr size_t WS_S5P = WS_S5TAB + 3 * MiB;
constexpr size_t WS_S5K = WS_S5TAB + 5 * MiB;
DI void s5_tables_p0(const Args& a) {
    const int gt = blockIdx.x * NTHREADS + otid();
    if (gt >= SGRP * SST) return;
    const int g = gt >> 6, p = gt & 63;
    const float lre = a.A_re[g * SST + p], lim = a.A_im[g * SST + p], dt = expf(a.log_dt[g]);
    const float mag = expf(lre * dt), abr = mag * cosf(lim * dt), abi = mag * sinf(lim * dt);
    const float den = lre * lre + lim * lim, nr = abr - 1.0f;
    const float cr = (nr * lre + abi * lim) / den, ci = (abi * lre - nr * lim) / den;
    float* pw = (float*)(a.ws + WS_S5POW) + (size_t)gt * 34;
    double pr = 1.0, pi = 0.0;
    for (int n = 0; n <= 16; ++n) { pw[2 * n] = (float)pr; pw[2 * n + 1] = (float)pi; const double t = pr * abr - pi * abi; pi = pr * abi + pi * abr; pr = t; }
    float* bb = (float*)(a.ws + WS_S5BB) + (size_t)gt * 32;
    for (int c = 0; c < 16; ++c) { const float br = a.B_re[(g * SST + p) * SCH + c], bi = a.B_im[(g * SST + p) * SCH + c];
        bb[2 * c] = cr * br - ci * bi; bb[2 * c + 1] = cr * bi + ci * br; }
}
DI void s5_tables_p1(const Args& a) {
    const size_t gt0 = (size_t)blockIdx.x * NTHREADS + otid(), nthr = (size_t)gridDim.x * NTHREADS;
    const float* POW = (const float*)(a.ws + WS_S5POW); const float* BB = (const float*)(a.ws + WS_S5BB);
    bf16_t* Qt = (bf16_t*)(a.ws + WS_S5Q); bf16_t* Pt = (bf16_t*)(a.ws + WS_S5P); bf16_t* Kt = (bf16_t*)(a.ws + WS_S5K);
    for (size_t i = gt0; i < (size_t)SGRP * 16 * 128 * 16; i += nthr) {
        {
            const int c = i & 15, pp = (i >> 4) & 127, j = (i >> 11) & 15, g = (int)(i >> 15), p = pp & 63;
            const float* pw = POW + ((size_t)(g * SST + p) * 17 + (15 - j)) * 2; const float* bb = BB + ((size_t)(g * SST + p) * 16 + c) * 2;
            const float re = pw[0] * bb[0] - pw[1] * bb[1], im = pw[0] * bb[1] + pw[1] * bb[0];
            Qt[i] = (bf16_t)(pk2(pp < 64 ? re : im, 0.f) & 0xffffu);
        }
        {
            const int pp = i & 127, c = (i >> 7) & 15, t = (i >> 11) & 15, g = (int)(i >> 15), p = pp & 63;
            const float* pw = POW + ((size_t)(g * SST + p) * 17 + (t + 1)) * 2;
            const float cr = a.C_re[(g * SCH + c) * SST + p], ci = a.C_im[(g * SCH + c) * SST + p];
            const float re = cr * pw[0] - ci * pw[1], im = cr * pw[1] + ci * pw[0];
            Pt[i] = (bf16_t)(pk2(pp < 64 ? re : -im, 0.f) & 0xffffu);
        }
    }
    for (size_t i = gt0; i < (size_t)SGRP * 17 * 32 * 16; i += nthr) {
        const int cp = i & 15, row = (i >> 4) & 31, d = (int)((i >> 9) % 17), g = (int)(i / (17 * 512));
        const int tau = d - 1 + (row >> 4), c = row & 15;
        float s = 0.f;
        if (tau >= 0) for (int p = 0; p < SST; ++p) {
            const float* pw = POW + ((size_t)(g * SST + p) * 17 + tau) * 2; const float* bb = BB + ((size_t)(g * SST + p) * 16 + cp) * 2;
            const float wr = pw[0] * bb[0] - pw[1] * bb[1], wi = pw[0] * bb[1] + pw[1] * bb[0];
            s += a.C_re[(g * SCH + c) * SST + p] * wr - a.C_im[(g * SCH + c) * SST + p] * wi;
        }
        Kt[i] = (bf16_t)(pk2(s, 0.f) & 0xffffu);
    }
}
DI float gelu_as(float v) {
    const float av = fabsf(v), t = __builtin_amdgcn_rcpf(av * 0.2316418882f + 1.0f);
    float q = t * 0.5307027145f + (-0.7265760135f); q = q * t + 0.7107068705f; q = q * t + (-0.142248368f); q = q * t + 0.127414796f; q = q * t;
    const float e = __builtin_amdgcn_exp2f((v * v) * (-0.72134752044f));
    const float m = v * (q * e);
    return v < 0.f ? m : v - m;
}
DI void s5_mfma_item(const Args& a, LAS unsigned char* lds, int b, int g) {
    const int tid = otid(), lane = tid & 63, w = __builtin_amdgcn_readfirstlane(tid >> 6), q = lane & 31, hh = lane >> 5;
    LAS unsigned char* Xl = lds;
    LAS unsigned char* El = lds + 32768;
    LAS unsigned char* Cl = lds + 65536;
    LAS unsigned char* Kl = lds + 81920;
    const bf16_t* U = (const bf16_t*)(a.ws + WS_U);
    bf16_t* GY = (bf16_t*)(a.ws + WS_GY);
    __syncthreads();
    {   const u32x4* ks = (const u32x4*)((const bf16_t*)(a.ws + WS_S5K) + (size_t)g * 17 * 512);
        for (int i = tid; i < 17 * 64; i += NTHREADS) *(LAS u32x4*)(Kl + i * 16) = ks[i]; }
    const int rbE = w & 3, cbE = w >> 2;
    bf16x8 qf[16], pf[8];
    {   const bf16_t* Qt = (const bf16_t*)(a.ws + WS_S5Q) + (size_t)g * 16 * 128 * 16;
#pragma unroll
        for (int j = 0; j < 16; ++j) qf[j] = *(const bf16x8*)(Qt + ((size_t)j * 128 + rbE * 32 + q) * 16 + 8 * hh);
        const bf16_t* Pt = (const bf16_t*)(a.ws + WS_S5P) + (size_t)g * 16 * 16 * 128;
        const int t = 2 * w + (q >> 4), c = q & 15;
#pragma unroll
        for (int ks = 0; ks < 8; ++ks) pf[ks] = *(const bf16x8*)(Pt + ((size_t)t * 16 + c) * 128 + ks * 16 + 8 * hh); }
    float dsel[2][4];
#pragma unroll
    for (int z = 0; z < 2; ++z)
#pragma unroll
        for (int i = 0; i < 4; ++i) dsel[z][i] = a.Dskip[g * SCH + 4 * hh + 8 * z + i];
    float cr = 0.f, ci = 0.f, a16r = 0.f, a16i = 0.f;
    if (w == 0) { const float* pw = (const float*)(a.ws + WS_S5POW) + ((size_t)(g * SST + lane) * 17 + 16) * 2; a16r = pw[0]; a16i = pw[1]; }
    __syncthreads();
    u32x4 xpre[4];
#pragma unroll
    for (int i = 0; i < 2; ++i) { const size_t tokm = (size_t)b * SEQ + tid + 512 * i;
        xpre[2 * i] = *(const u32x4*)(U + tokm * SW + g * SCH); xpre[2 * i + 1] = *(const u32x4*)(U + tokm * SW + g * SCH + 8); }
    for (int sc = 0; sc < SEQ / 1024; ++sc) {
        const size_t m0 = (size_t)b * SEQ + (size_t)sc * 1024;
#pragma unroll
        for (int i = 0; i < 2; ++i) { const int tok = tid + 512 * i, j = tok & 15, k = tok >> 4;
            *(LAS u32x4*)(Xl + ((j * 64 + k) * 2) * 16) = xpre[2 * i]; *(LAS u32x4*)(Xl + ((j * 64 + k) * 2 + 1) * 16) = xpre[2 * i + 1]; }
        if (sc + 1 < SEQ / 1024) {
#pragma unroll
            for (int i = 0; i < 2; ++i) { const size_t tokm = m0 + 1024 + tid + 512 * i;
                xpre[2 * i] = *(const u32x4*)(U + tokm * SW + g * SCH); xpre[2 * i + 1] = *(const u32x4*)(U + tokm * SW + g * SCH + 8); }
        }
        __syncthreads();
        {
            f32x16 e;
#pragma unroll
            for (int r = 0; r < 16; ++r) e[r] = 0.f;
#pragma unroll
            for (int j = 0; j < 16; ++j) { const bf16x8 xb = *(const LAS bf16x8*)(Xl + ((j * 64 + cbE * 32 + q) * 2 + hh) * 16);
                e = __builtin_amdgcn_mfma_f32_32x32x16_bf16(qf[j], xb, e, 0, 0, 0); }
            const int k = cbE * 32 + q;
#pragma unroll
            for (int g4 = 0; g4 < 4; ++g4) { const int pp = rbE * 32 + 8 * g4 + 4 * hh;
                *(LAS f32x4*)(El + k * 512 + (((pp >> 2) ^ (k & 31)) << 4)) = (f32x4){e[4 * g4], e[4 * g4 + 1], e[4 * g4 + 2], e[4 * g4 + 3]}; }
        }
        __syncthreads();
        if (w == 0) {
#pragma unroll 1
            for (int k0 = 0; k0 < 64; k0 += 16) {
                float er[16], ei[16];
#pragma unroll
                for (int kk = 0; kk < 16; ++kk) { const int k = k0 + kk;
                    er[kk] = *(const LAS float*)(El + k * 512 + ((((lane) >> 2) ^ (k & 31)) << 4) + (lane & 3) * 4);
                    ei[kk] = *(const LAS float*)(El + k * 512 + ((((64 + lane) >> 2) ^ (k & 31)) << 4) + (lane & 3) * 4); }
                unsigned short cw[32];
#pragma unroll
                for (int kk = 0; kk < 16; ++kk) {
                    cw[2 * kk] = (unsigned short)(pk2(cr, 0.f) & 0xffffu); cw[2 * kk + 1] = (unsigned short)(pk2(ci, 0.f) & 0xffffu);
                    const float nr = a16r * cr - a16i * ci + er[kk], ni = a16r * ci + a16i * cr + ei[kk];
                    cr = nr; ci = ni;
                }
#pragma unroll
                for (int kk = 0; kk < 16; ++kk) { const int k = k0 + kk;
                    *(LAS unsigned short*)(Cl + k * 256 + ((((lane) >> 3) ^ (k & 15)) << 4) + (lane & 7) * 2) = cw[2 * kk];
                    *(LAS unsigned short*)(Cl + k * 256 + ((((64 + lane) >> 3) ^ (k & 15)) << 4) + (lane & 7) * 2) = cw[2 * kk + 1]; }
            }
        }
        f32x16 y[2];
#pragma unroll
        for (int cb = 0; cb < 2; ++cb)
#pragma unroll
            for (int r = 0; r < 16; ++r) y[cb][r] = 0.f;
#pragma unroll 2
        for (int j = 0; j <= 2 * w + 1; ++j) {
            const bf16x8 kf = *(const LAS bf16x8*)(Kl + (((2 * w - j + 1) * 32 + q) * 16 + 8 * hh) * 2);
#pragma unroll
            for (int cb = 0; cb < 2; ++cb) { const bf16x8 xb = *(const LAS bf16x8*)(Xl + ((j * 64 + cb * 32 + q) * 2 + hh) * 16);
                y[cb] = __builtin_amdgcn_mfma_f32_32x32x16_bf16(kf, xb, y[cb], 0, 0, 0); }
        }
        __syncthreads();
#pragma unroll
        for (int ks = 0; ks < 8; ++ks)
#pragma unroll
            for (int cb = 0; cb < 2; ++cb) { const int k = cb * 32 + q;
                const bf16x8 cf = *(const LAS bf16x8*)(Cl + k * 256 + (((ks * 2 + hh) ^ (k & 15)) << 4));
                y[cb] = __builtin_amdgcn_mfma_f32_32x32x16_bf16(pf[ks], cf, y[cb], 0, 0, 0); }
#pragma unroll
        for (int cb = 0; cb < 2; ++cb) {
            const int k = cb * 32 + q;
#pragma unroll
            for (int g4 = 0; g4 < 4; ++g4) {
                const int tt = g4 >> 1, z = g4 & 1, t = 2 * w + tt, c0 = 4 * hh + 8 * z;
                const u32x2 uw = *(const LAS u32x2*)(Xl + ((t * 64 + k) * 2 + z) * 16 + hh * 8);
                const float u0 = bflo(uw.x), u1 = bfhi(uw.x), u2 = bflo(uw.y), u3 = bfhi(uw.y);
                const float y0 = gelu_as(y[cb][4 * g4] + dsel[z][0] * u0), y1 = gelu_as(y[cb][4 * g4 + 1] + dsel[z][1] * u1);
                const float y2 = gelu_as(y[cb][4 * g4 + 2] + dsel[z][2] * u2), y3 = gelu_as(y[cb][4 * g4 + 3] + dsel[z][3] * u3);
                u32x2 o; o.x = pk2(y0, y1); o.y = pk2(y2, y3);
                *(u32x2*)(GY + (m0 + 16 * k + t) * SW + g * SCH + c0) = o;
            }
        }
        __syncthreads();
    }
}

DI void phase3(const Args& a, LAS unsigned char* lds) {
    const int tid = otid(), lane = tid & 63, wave = tid >> 6, blk = blockIdx.x;
    unsigned* ctl = (unsigned*)(a.ws + WS_CTL);
    for (int it = blk; it < NB * SGRP; it += gridDim.x) s5_mfma_item(a, lds, it >> 5, it & 31);
    float wqm = 0.f, wkm = 0.f;
    for (int i = lane; i < HD; i += 64) { wqm = fmaxf(wqm, fabsf(a.q_norm_w[i])); wkm = fmaxf(wkm, fabsf(a.k_norm_w[i])); }
#pragma unroll
    for (int o = 1; o < 64; o <<= 1) { wqm = fmaxf(wqm, __shfl_xor(wqm, o)); wkm = fmaxf(wkm, __shfl_xor(wkm, o)); }
    const float qkb2 = 11.313708499f * wqm * wkm * LOG2E * 1.02f;
    const float thr2 = 2.0f * qkb2 + 30.0f * LOG2E;
    LAS int* qi = (LAS int*)(lds + 40960);
    for (;;) {
        __syncthreads();
        if (tid == 0) *qi = (int)atomicAdd(ctl + CW_QUEUE, 1u);
        __syncthreads();
        const int it = *qi;
        if (it >= NB * AH * 64) break;
        attn_item(a, lds, it / (AH * 64), (it / 64) % AH, it % 64, thr2);
    }
}


constexpr size_t WS_H2B = WS_QKV;
constexpr size_t WS_QP = WS_GATES;
constexpr size_t WS_IDS = 992 * MiB;
constexpr size_t WS_GW = 1008 * MiB;
struct EpiPlain {
    static constexpr bool PERM = true;
    bf16_t* o; int ldc;
    DI void operator()(const f32x4 (&acc)[2][2][4][2], const pg8::Unit& un, int wr, int wc, int fr, int fq) const {
        epi_foreach(acc, un, wr, wc, fr, fq, [&](int row, int col0, float (&v)[8]) { store8_bf16(o + (size_t)row * ldc + col0, v); });
    }
};
DI unsigned enc_sortable(float f) { const unsigned u = __float_as_uint(f); return u ^ ((u >> 31) ? 0xffffffffu : 0x80000000u); }
DI float dec_sortable(unsigned s) { return __uint_as_float(s ^ ((s >> 31) ? 0x80000000u : 0xffffffffu)); }
#define TOPK_INSERT(L, x_) do { unsigned _x = (x_); _Pragma("unroll") for (int _k = 0; _k < 16; ++_k) { const unsigned _hi = max(L[_k], _x); _x = min(L[_k], _x); L[_k] = _hi; } } while (0)
DI void sort_bitonic16_desc(unsigned (&M)[16]) {
#pragma unroll
    for (int st = 8; st >= 1; st >>= 1)
#pragma unroll
        for (int i = 0; i < 16; ++i) if ((i & st) == 0) { const unsigned a_ = max(M[i], M[i + st]), b_ = min(M[i], M[i + st]); M[i] = a_; M[i + st] = b_; }
}
template <int N> DI void bitonic_sort_desc(unsigned (&v)[N]) {
#pragma unroll
    for (int k = 2; k <= N; k <<= 1)
#pragma unroll
        for (int j = k >> 1; j > 0; j >>= 1)
#pragma unroll
            for (int i = 0; i < N; ++i) { const int l = i ^ j;
                if (l > i) { const bool desc = (i & k) == 0; const unsigned hi_ = max(v[i], v[l]), lo_ = min(v[i], v[l]); v[i] = desc ? hi_ : lo_; v[l] = desc ? lo_ : hi_; } }
}
DI void merge_top16(unsigned (&A)[16], const unsigned (&B)[16]) {
#pragma unroll
    for (int k = 0; k < 16; ++k) A[k] = max(A[k], B[15 - k]);
    sort_bitonic16_desc(A);
}
DI void peer_select_item(const Args& a, LAS unsigned char* lds, int h, int tile) {
    const int tid = otid(), lane = tid & 63, wave = tid >> 6, q = lane & 31, hh = lane >> 5;
    const bf16_t* keys = (const bf16_t*)(a.ws + WS_KEYS) + (size_t)h * 2 * NKEYS * 128;
    __syncthreads();
    for (int i = tid; i < 2 * NKEYS * 16; i += NTHREADS) {
        const int r = i >> 4, ch = i & 15;
        *(LAS u32x4*)(lds + r * 256 + ((ch ^ (r & 15)) << 4)) = *(const u32x4*)(keys + (size_t)r * 128 + ch * 8);
    }
    __syncthreads();
    const size_t m = (size_t)tile * 256 + wave * 32 + q;
    const bf16_t* qp = (const bf16_t*)(a.ws + WS_QP) + m * D + h * 256;
    unsigned S[2][16];
#pragma unroll
    for (int p = 0; p < 2; ++p) {
        bf16x8 qf[8];
#pragma unroll
        for (int ks = 0; ks < 8; ++ks) qf[ks] = *(const bf16x8*)(qp + p * 128 + ks * 16 + hh * 8);
        f32x16 acc[4];
#pragma unroll
        for (int rb = 0; rb < 4; ++rb) {
#pragma unroll
            for (int r = 0; r < 16; ++r) acc[rb][r] = 0.f;
#pragma unroll
            for (int ks = 0; ks < 8; ++ks) {
                const int r = p * 128 + rb * 32 + q, ch = ks * 2 + hh;
                const bf16x8 kf = *(const LAS bf16x8*)(lds + r * 256 + ((ch ^ (r & 15)) << 4));
                acc[rb] = __builtin_amdgcn_mfma_f32_32x32x16_bf16(kf, qf[ks], acc[rb], 0, 0, 0);
            }
        }
        unsigned K0[16], K1[16], K2[16], K3[16];
#pragma unroll
        for (int r = 0; r < 16; ++r) {
            const unsigned n = (r & 3) + 8 * (r >> 2) + 4 * hh;
            K0[r] = (enc_sortable(acc[0][r]) & ~0x7Fu) | n; K1[r] = (enc_sortable(acc[1][r]) & ~0x7Fu) | (32 + n);
            K2[r] = (enc_sortable(acc[2][r]) & ~0x7Fu) | (64 + n); K3[r] = (enc_sortable(acc[3][r]) & ~0x7Fu) | (96 + n);
        }
        bitonic_sort_desc<16>(K0); bitonic_sort_desc<16>(K1); bitonic_sort_desc<16>(K2); bitonic_sort_desc<16>(K3);
        merge_top16(K0, K1); merge_top16(K2, K3); merge_top16(K0, K2);
        unsigned M[16];
#pragma unroll
        for (int k = 0; k < 16; ++k) { const unsigned pl = __shfl_xor(K0[15 - k], 32); M[k] = max(K0[k], pl); }
        sort_bitonic16_desc(M);
#pragma unroll
        for (int k = 0; k < 16; ++k) S[p][k] = M[k];
    }
    float f0[16], f1[16];
#pragma unroll
    for (int k = 0; k < 16; ++k) { f0[k] = dec_sortable(S[0][k] & ~0x7Fu); f1[k] = dec_sortable(S[1][k] & ~0x7Fu); }
    unsigned R[16], X[32], X2[2];
#pragma unroll
    for (int c = 0; c < 16; ++c) R[c] = (enc_sortable(f0[0] + f1[c]) & ~0xFFu) | (unsigned)c;
    {   int idx = 0;
#pragma unroll
        for (int p = 1; p < 16; ++p)
#pragma unroll
            for (int c = 0; c < 16; ++c) if ((p + 1) * (c + 1) <= 16) {
                const unsigned key = (enc_sortable(f0[p] + f1[c]) & ~0xFFu) | (unsigned)(p * 16 + c);
                if (idx < 32) X[idx] = key; else X2[idx - 32] = key;
                ++idx;
            }
    }
    bitonic_sort_desc<16>(R); bitonic_sort_desc<32>(X);
    {   unsigned XT[16];
#pragma unroll
        for (int k = 0; k < 16; ++k) XT[k] = X[k];
        merge_top16(R, XT); }
    TOPK_INSERT(R, X2[0]); TOPK_INSERT(R, X2[1]);
    unsigned pk0[4] = {0, 0, 0, 0}, pk1[4] = {0, 0, 0, 0};
#pragma unroll
    for (int k = 0; k < 16; ++k) { pk0[k >> 2] |= (S[0][k] & 0x7Fu) << (8 * (k & 3)); pk1[k >> 2] |= (S[1][k] & 0x7Fu) << (8 * (k & 3)); }
    int eid[16]; float ew[16]; float esum = 0.f;
    const float tv0 = dec_sortable(R[0] & ~0xFFu);
#pragma unroll
    for (int r = 0; r < 16; ++r) {
        const unsigned pq = R[r] & 0xFFu, p = pq >> 4, c = pq & 15u;
        unsigned w0 = pk0[0], w1 = pk1[0];
        w0 = (p >> 2) == 1 ? pk0[1] : w0; w0 = (p >> 2) == 2 ? pk0[2] : w0; w0 = (p >> 2) == 3 ? pk0[3] : w0;
        w1 = (c >> 2) == 1 ? pk1[1] : w1; w1 = (c >> 2) == 2 ? pk1[2] : w1; w1 = (c >> 2) == 3 ? pk1[3] : w1;
        const unsigned i0 = (w0 >> (8 * (p & 3))) & 0x7Fu, i1 = (w1 >> (8 * (c & 3))) & 0x7Fu;
        eid[r] = (int)(i0 * NKEYS + i1);
        ew[r] = __expf(dec_sortable(R[r] & ~0xFFu) - tv0); esum += ew[r];
    }
    const float inv = 1.0f / esum;
    if (hh == 0) {
        unsigned short* o = (unsigned short*)(a.ws + WS_IDS) + m * NSEL + h * 16;
#pragma unroll
        for (int r = 0; r < 16; r += 8) *(u32x4*)(o + r) = (u32x4){(unsigned)eid[r] | ((unsigned)eid[r + 1] << 16), (unsigned)eid[r + 2] | ((unsigned)eid[r + 3] << 16),
                                                                   (unsigned)eid[r + 4] | ((unsigned)eid[r + 5] << 16), (unsigned)eid[r + 6] | ((unsigned)eid[r + 7] << 16)};
    } else {
        float* o = (float*)(a.ws + WS_GW) + m * NSEL + h * 16;
#pragma unroll
        for (int r = 0; r < 16; r += 4) *(f32x4*)(o + r) = (f32x4){ew[r] * inv, ew[r + 1] * inv, ew[r + 2] * inv, ew[r + 3] * inv};
    }
}
DI void phase9(const Args& a, LAS unsigned char* lds) {
    if (gridDim.x == 256) {
        const int c = blockIdx.x, tile = 16 * (c & 7) + ((c >> 3) & 15), h0 = 4 * (c >> 7);
        for (int hh = 0; hh < 4; ++hh) peer_select_item(a, lds, h0 + hh, tile);
    } else
        for (int it = blockIdx.x; it < PH * (T / 256); it += gridDim.x) peer_select_item(a, lds, it / (T / 256), it % (T / 256));
}

#ifndef EPB
#define EPB 16
#endif
#ifndef EPB2
#define EPB2 8
#endif
DI void phase10(const Args& a) {
    const int tid = otid(), lane = tid & 63, wave = tid >> 6;
    const int gw = blockIdx.x * NWAVES + wave, NGW = gridDim.x * NWAVES;
    const unsigned char* PU = a.ws + WS_PU; const unsigned char* PV = a.ws + WS_PV;
    const float* PUS = (const float*)(a.ws + WS_PUS); const float* PVS = (const float*)(a.ws + WS_PVS);
    const float* mod = (const float*)(a.ws + WS_CTL) + CW_MOD;
    (void)gw;
    for (int ri = 0; ri < (T + NGW - 1) / NGW; ++ri) {
        const int m = affine_row(blockIdx.x, wave, ri, gridDim.x);
        if (m >= T) break;
        const int b = m >> 14;
        const int* ids = (const int*)(a.ws + WS_IDS) + (size_t)m * NSEL; const float* gwp = (const float*)(a.ws + WS_GW) + (size_t)m * NSEL;
        const int idA = ids[lane], idB = ids[64 + lane];
        const float gA = gwp[lane] * PVS[idA], gB = gwp[64 + lane] * PVS[idB];
        const float suA = PUS[idA], suB = PUS[idB];
        const bf16_t* hrow = (const bf16_t*)(a.ws + WS_H2B) + (size_t)m * D + 32 * lane;
        unsigned hp[16];
#pragma unroll
        for (int q = 0; q < 4; ++q) { const u32x4 t4 = *(const u32x4*)(hrow + 8 * q); hp[4 * q] = t4[0]; hp[4 * q + 1] = t4[1]; hp[4 * q + 2] = t4[2]; hp[4 * q + 3] = t4[3]; }
        float cf[4];
#pragma unroll
        for (int bt = 0; bt < 4; ++bt) {
            float part[32];
#pragma unroll
            for (int i0 = 0; i0 < 32; i0 += EPB) {
                v6u uw[EPB];
#pragma unroll
                for (int i = 0; i < EPB; ++i) {
                    const int id = __builtin_amdgcn_readlane(bt < 2 ? idA : idB, (bt & 1) * 32 + i0 + i);
                    uw[i] = fp6_load(PU + (size_t)id * ROWB, lane);
                }
#pragma unroll
                for (int i = 0; i < EPB; ++i) {
                    const v16u rp = fp6_unpack_bf16(uw[i]);
                    float s = 0.f;
#pragma unroll
                    for (int k = 0; k < 16; ++k) { const unsigned pu = rp[k], ph = hp[k];
                        s = __builtin_amdgcn_fdot2_f32_bf16(__builtin_bit_cast(bf16x2_t, ph), __builtin_bit_cast(bf16x2_t, pu), s, false); }
                    part[i0 + i] = s;
                }
                __builtin_amdgcn_sched_barrier(0);
            }
            float p16[16], p8[8], p4[4], p2[2], p1;
            { const bool hi = lane & 32;
#pragma unroll
              for (int i = 0; i < 16; ++i) { const float snd = hi ? part[i] : part[i + 16], kp = hi ? part[i + 16] : part[i]; p16[i] = kp + __shfl_xor(snd, 32); } }
            { const bool hi = lane & 16;
#pragma unroll
              for (int i = 0; i < 8; ++i) { const float snd = hi ? p16[i] : p16[i + 8], kp = hi ? p16[i + 8] : p16[i]; p8[i] = kp + __shfl_xor(snd, 16); } }
            { const bool hi = lane & 8;
#pragma unroll
              for (int i = 0; i < 4; ++i) { const float snd = hi ? p8[i] : p8[i + 4], kp = hi ? p8[i + 4] : p8[i]; p4[i] = kp + __shfl_xor(snd, 8); } }
            { const bool hi = lane & 4;
#pragma unroll
              for (int i = 0; i < 2; ++i) { const float snd = hi ? p4[i] : p4[i + 2], kp = hi ? p4[i + 2] : p4[i]; p2[i] = kp + __shfl_xor(snd, 4); } }
            { const bool hi = lane & 2; const float snd = hi ? p2[0] : p2[1], kp = hi ? p2[1] : p2[0]; p1 = kp + __shfl_xor(snd, 2); }
            p1 += __shfl_xor(p1, 1);
            const int src_lane = (bt & 1) * 32 + (lane >> 1);
            const float g = __shfl(bt < 2 ? gA : gB, src_lane), su = __shfl(bt < 2 ? suA : suB, src_lane);
            cf[bt] = geluf_(p1 * su) * g;
        }
        f32x2 acc[16];
#pragma unroll
        for (int k = 0; k < 16; ++k) acc[k] = (f32x2){0.f, 0.f};
#pragma unroll
        for (int bt = 0; bt < 4; ++bt) {
#pragma unroll 1
            for (int i0 = 0; i0 < 32; i0 += EPB2) {
                __builtin_amdgcn_sched_barrier(0);
                v6u vw[EPB2]; float cs[EPB2];
#pragma unroll
                for (int i = 0; i < EPB2; ++i) {
                    const int id = __builtin_amdgcn_readlane(bt < 2 ? idA : idB, (bt & 1) * 32 + i0 + i);
                    cs[i] = __uint_as_float((unsigned)__builtin_amdgcn_readlane((int)__float_as_uint(cf[bt]), 2 * (i0 + i)));
                    vw[i] = fp6_load(PV + (size_t)id * ROWB, lane);
                }
#pragma unroll
                for (int i = 0; i < EPB2; ++i) {
                    const v32f r = fp6_unpack_f32(vw[i]);
                    const f32x2 c2 = (f32x2){cs[i], cs[i]};
#pragma unroll
                    for (int k = 0; k < 16; ++k) acc[k] = __builtin_elementwise_fma(c2, (f32x2){r[2 * k], r[2 * k + 1]}, acc[k]);
                }
            }
        }
        float* orow = a.out + (size_t)m * D + 32 * lane;
        const float* gp = mod + b * NMOD + 5 * D + 32 * lane;
#pragma unroll
        for (int k4 = 0; k4 < 8; ++k4) {
            const f32x4 g2 = *(const f32x4*)(gp + 4 * k4);
            f32x4 xv = *(const f32x4*)(orow + 4 * k4);
#pragma unroll
            for (int k = 0; k < 4; ++k) xv[k] += g2[k] * acc[2 * k4 + (k >> 1)][k & 1];
            *(f32x4*)(orow + 4 * k4) = xv;
        }
    }
}


DI void phase10_fp4(const Args& a) {
    const int tid = otid(), lane = tid & 63, wave = tid >> 6;
    const int gw = blockIdx.x * NWAVES + wave, NGW = gridDim.x * NWAVES;
    const unsigned char* PU = a.ws + WS_PU; const unsigned char* PV = a.ws + WS_PV; const unsigned char* PUE = a.ws + WS_PUE; const unsigned char* PVE = a.ws + WS_PVE;
    const float* mod = (const float*)(a.ws + WS_CTL) + CW_MOD;
    (void)gw;
    for (int ri = 0; ri < (T + NGW - 1) / NGW; ++ri) {
        const int m = affine_row(blockIdx.x, wave, ri, gridDim.x);
        if (m >= T) break;
        const int b = m >> 14;
        const int* ids = (const int*)(a.ws + WS_IDS) + (size_t)m * NSEL; const float* gwp = (const float*)(a.ws + WS_GW) + (size_t)m * NSEL;
        const int idA = ids[lane], idB = ids[64 + lane];
        const float gA = gwp[lane], gB = gwp[64 + lane];
        const bf16_t* hrow = (const bf16_t*)(a.ws + WS_H2B) + (size_t)m * D + 32 * lane;
        f32x2 hf[16];
#pragma unroll
        for (int q = 0; q < 4; ++q) { const u32x4 t4 = *(const u32x4*)(hrow + 8 * q);
#pragma unroll
            for (int z = 0; z < 4; ++z) { const unsigned pw = t4[z]; hf[4 * q + z] = (f32x2){bflo(pw), bfhi(pw)}; } }
        float cf[4];
#pragma unroll
        for (int bt = 0; bt < 4; ++bt) {
            float part[32];
#pragma unroll
            for (int i0 = 0; i0 < 32; i0 += EPB) {
                u32x4 uw[EPB]; unsigned ue[EPB];
#pragma unroll
                for (int i = 0; i < EPB; ++i) {
                    const int id = __builtin_amdgcn_readlane(bt < 2 ? idA : idB, (bt & 1) * 32 + i0 + i);
                    uw[i] = *(const u32x4*)(PU + (size_t)id * ROWB4 + 16 * lane); ue[i] = PUE[(size_t)id * 64 + lane];
                }
#pragma unroll
                for (int i = 0; i < EPB; ++i) {
                    f32x2 s2 = (f32x2){0.f, 0.f};
#pragma unroll
                    for (int d = 0; d < 4; ++d) { f32x2 r[4]; const unsigned wd = uw[i][d]; fp4_unpack8(wd, r);
#pragma unroll
                        for (int z = 0; z < 4; ++z) s2 = __builtin_elementwise_fma(hf[4 * d + z], r[z], s2); }
                    part[i0 + i] = (s2[0] + s2[1]) * __uint_as_float(ue[i] << 23);
                }
                __builtin_amdgcn_sched_barrier(0);
            }
            float p16[16], p8[8], p4[4], p2[2], p1;
            { const bool hi = lane & 32;
#pragma unroll
              for (int i = 0; i < 16; ++i) { const float snd = hi ? part[i] : part[i + 16], kp = hi ? part[i + 16] : part[i]; p16[i] = kp + __shfl_xor(snd, 32); } }
            { const bool hi = lane & 16;
#pragma unroll
              for (int i = 0; i < 8; ++i) { const float snd = hi ? p16[i] : p16[i + 8], kp = hi ? p16[i + 8] : p16[i]; p8[i] = kp + __shfl_xor(snd, 16); } }
            { const bool hi = lane & 8;
#pragma unroll
              for (int i = 0; i < 4; ++i) { const float snd = hi ? p8[i] : p8[i + 4], kp = hi ? p8[i + 4] : p8[i]; p4[i] = kp + __shfl_xor(snd, 8); } }
            { const bool hi = lane & 4;
#pragma unroll
              for (int i = 0; i < 2; ++i) { const float snd = hi ? p4[i] : p4[i + 2], kp = hi ? p4[i + 2] : p4[i]; p2[i] = kp + __shfl_xor(snd, 4); } }
            { const bool hi = lane & 2; const float snd = hi ? p2[0] : p2[1], kp = hi ? p2[1] : p2[0]; p1 = kp + __shfl_xor(snd, 2); }
            p1 += __shfl_xor(p1, 1);
            const float g = __shfl(bt < 2 ? gA : gB, (bt & 1) * 32 + (lane >> 1));
            cf[bt] = geluf_(p1) * g;
        }
        f32x2 acc[16];
#pragma unroll
        for (int k = 0; k < 16; ++k) acc[k] = (f32x2){0.f, 0.f};
#pragma unroll
        for (int bt = 0; bt < 4; ++bt) {
#pragma unroll 1
            for (int i0 = 0; i0 < 32; i0 += EPB2) {
                __builtin_amdgcn_sched_barrier(0);
                u32x4 vw[EPB2]; unsigned ve[EPB2]; float cs[EPB2];
#pragma unroll
                for (int i = 0; i < EPB2; ++i) {
                    const int id = __builtin_amdgcn_readlane(bt < 2 ? idA : idB, (bt & 1) * 32 + i0 + i);
                    cs[i] = __uint_as_float((unsigned)__builtin_amdgcn_readlane((int)__float_as_uint(cf[bt]), 2 * (i0 + i)));
                    vw[i] = *(const u32x4*)(PV + (size_t)id * ROWB4 + 16 * lane); ve[i] = PVE[(size_t)id * 64 + lane];
                }
#pragma unroll
                for (int i = 0; i < EPB2; ++i) {
                    const float cl = cs[i] * __uint_as_float(ve[i] << 23);
                    const f32x2 c2 = (f32x2){cl, cl};
#pragma unroll
                    for (int d = 0; d < 4; ++d) { f32x2 r[4]; const unsigned wd = vw[i][d]; fp4_unpack8(wd, r);
#pragma unroll
                        for (int z = 0; z < 4; ++z) acc[4 * d + z] = __builtin_elementwise_fma(c2, r[z], acc[4 * d + z]); }
                }
            }
        }
        float* orow = a.out + (size_t)m * D + 32 * lane;
        const float* gp = mod + b * NMOD + 5 * D + 32 * lane;
#pragma unroll
        for (int k4 = 0; k4 < 8; ++k4) {
            const f32x4 g2 = *(const f32x4*)(gp + 4 * k4);
            f32x4 xv = *(const f32x4*)(orow + 4 * k4);
#pragma unroll
            for (int k = 0; k < 4; ++k) xv[k] += g2[k] * acc[2 * k4 + (k >> 1)][k & 1];
            *(f32x4*)(orow + 4 * k4) = xv;
        }
    }
}

constexpr size_t WS_SP = WS_GATES + 128 * MiB;
constexpr size_t WS_CF = WS_U;
struct SliceMap { int NS, grp, wv, nwv; };
DI SliceMap slice_map(int blk, int wave, int G) {
    SliceMap s; s.NS = G < 8 ? G : 8; s.grp = blk % s.NS; s.wv = (blk / s.NS) * NWAVES + wave; s.nwv = ((G - s.grp + s.NS - 1) / s.NS) * NWAVES; return s;
}
template <int CTRL> DI float dppf(float x) { return __builtin_bit_cast(float, __builtin_amdgcn_mov_dpp(__builtin_bit_cast(int, x), CTRL, 0xf, 0xf, true)); }
constexpr int DPP_XOR1 = 0xB1, DPP_XOR2 = 0x4E, DPP_MIR8 = 0x141, DPP_XOR8 = 0x128;
DI void hdigits_pass(const Args& a) {
    const int tid = otid(), lane = tid & 63, wave = tid >> 6;
    const int NGW = gridDim.x * NWAVES;
    for (int ri = 0; ri < (T + NGW - 1) / NGW; ++ri) {
        const int m = affine_row(blockIdx.x, wave, ri, gridDim.x);
        if (m >= T) break;
        const bf16_t* hrow = (const bf16_t*)(a.ws + WS_H2B) + (size_t)m * D + 32 * lane;
        u32x4 t4[4]; float mx = 0.f;
#pragma unroll
        for (int q = 0; q < 4; ++q) { t4[q] = *(const u32x4*)(hrow + 8 * q);
#pragma unroll
            for (int z = 0; z < 4; ++z) mx = fmaxf(mx, fmaxf(fabsf(bflo(t4[q][z])), fabsf(bfhi(t4[q][z])))); }
        mx = fmaxf(mx, dppf<DPP_XOR1>(mx)); mx = fmaxf(mx, dppf<DPP_XOR2>(mx)); mx = fmaxf(mx, dppf<DPP_MIR8>(mx));
        const float step = mx * (1.0f / 119.0f), S = mx > 0.f ? 119.0f / mx : 0.f;
        unsigned p0[4], p1[4];
#pragma unroll
        for (int d = 0; d < 4; ++d) {
            unsigned a0 = 0u, a1 = 0u;
#pragma unroll
            for (int e = 0; e < 8; ++e) {
                const unsigned pw = t4[d][e >> 1]; const float x = (e & 1) ? bfhi(pw) : bflo(pw);
                const int q = (int)rintf(x * S), q1 = (q + 8) >> 4;
                a0 |= ((unsigned)q & 15u) << (4 * e); a1 |= ((unsigned)q1 & 15u) << (4 * e);
            }
            p0[d] = a0; p1[d] = a1;
        }
        u32x4* dst = (u32x4*)(a.ws + WS_H4) + ((size_t)m * 64 + lane) * 2;
        dst[0] = (u32x4){p0[0], p0[1], p0[2], p0[3]}; dst[1] = (u32x4){p1[0], p1[1], p1[2], p1[3]};
        if ((lane & 7) == 0) ((float*)(a.ws + WS_HS))[(size_t)m * 8 + (lane >> 3)] = step;
    }
}
DI void p10a_issue(const unsigned char* pu, LAS unsigned char* lds, int idv, int gl, unsigned lo16, unsigned lo1, u32x4 (&uw)[8], unsigned (&uc)[8]) {
#pragma unroll
    for (int j = 0; j < 8; ++j) {
        const unsigned id = (unsigned)__shfl(idv, gl | j);
        uw[j] = *(const u32x4*)(pu + ((id << 10) + lo16)); uc[j] = lds[(id << 3) + lo1];
    }
}
DI float p10a_math(const u32x4 (&uw)[8], const unsigned (&uc)[8], LAS unsigned char* lds, const u32x4& c0, const u32x4& c1, int i) {
    float o = 0.f;
    float us[8];
#pragma unroll
    for (int j = 0; j < 8; ++j) us[j] = ((LAS float*)(lds + NEXP * 8))[uc[j]];
#pragma unroll
    for (int j = 0; j < 8; ++j) {
        int acc;
        asm("v_dot8_i32_i4 %0, %1, %2, 0" : "=v"(acc) : "v"(uw[j][0]), "v"(c1[0]));
#pragma unroll
        for (int d = 1; d < 4; ++d) acc = __builtin_amdgcn_sdot8((int)uw[j][d], (int)c1[d], acc, false);
        acc <<= 4;
#pragma unroll
        for (int d = 0; d < 4; ++d) acc = __builtin_amdgcn_sdot8((int)uw[j][d], (int)c0[d], acc, false);
        float v = (float)acc * us[j];
        asm("" : "+v"(v));
        v += dppf<DPP_XOR1>(v); v += dppf<DPP_XOR2>(v); v += dppf<DPP_MIR8>(v);
        o = (i == j) ? v : o;
    }
    return o;
}
DI void phase10a_u4(const Args& a, LAS unsigned char* lds) {
    const int tid = otid(), lane = tid & 63, wave = tid >> 6;
    const SliceMap sm = slice_map(blockIdx.x, wave, gridDim.x);
    const int g = lane >> 3, i = lane & 7, gl = lane & 56;
    const unsigned lo16 = 16u * i, lo1 = (unsigned)i;
    for (int x = sm.grp; x < 8; x += sm.NS) {
        const unsigned char* pu = a.ws + WS_PU + 128 * x;
        {
            __syncthreads();
            const u32x4* s4 = (const u32x4*)(a.ws + WS_PUS4 + (size_t)x * (NEXP * 8));
            for (int q = tid; q < NEXP * 8 / 16; q += NTHREADS) *(LAS u32x4*)(lds + 16 * q) = s4[q];
            if (tid < 256) ((LAS float*)(lds + NEXP * 8))[tid] = u4_step(tid);
            __syncthreads();
        }
        bf16_t* sp = (bf16_t*)(a.ws + WS_SP) + (size_t)x * T * NSEL + 16 * g + i;
        const unsigned short* idb = (const unsigned short*)(a.ws + WS_IDS) + 16 * g + i;
        const u32x4* h4 = (const u32x4*)(a.ws + WS_H4) + (size_t)(8 * x + i) * 2;
        const float* hsb = (const float*)(a.ws + WS_HS) + x;
        int t = sm.wv;
        if (t >= T) continue;
        int idlo = idb[(size_t)t * NSEL], idhi = idb[(size_t)t * NSEL + 8];
        u32x4 hp0 = h4[(size_t)t * 128], hp1 = h4[(size_t)t * 128 + 1];
        float hs = hsb[(size_t)t * 8];
        u32x4 uwA[8], uwB[8]; unsigned usA[8], usB[8];
        p10a_issue(pu, lds, idlo, gl, lo16, lo1, uwA, usA);
#pragma unroll 1
        for (; t < T; t += sm.nwv) {
            __builtin_amdgcn_sched_barrier(0);
            const u32x4 c0 = hp0, c1 = hp1; const float chs = hs; const int cidhi = idhi;
            {   const int tn = (t + sm.nwv < T) ? t + sm.nwv : t;
                idlo = idb[(size_t)tn * NSEL]; idhi = idb[(size_t)tn * NSEL + 8];
                hp0 = h4[(size_t)tn * 128]; hp1 = h4[(size_t)tn * 128 + 1]; hs = hsb[(size_t)tn * 8];
            }
            p10a_issue(pu, lds, cidhi, gl, lo16, lo1, uwB, usB);
            __builtin_amdgcn_sched_barrier(0);
            const float olo = p10a_math(uwA, usA, lds, c0, c1, i);
            __builtin_amdgcn_sched_barrier(0);
            p10a_issue(pu, lds, idlo, gl, lo16, lo1, uwA, usA);
            __builtin_amdgcn_sched_barrier(0);
            const float ohi = p10a_math(uwB, usB, lds, c0, c1, i);
            { const unsigned pw = pk2(olo * chs, ohi * chs); sp[(size_t)t * NSEL] = (bf16_t)(pw & 0xffffu); sp[(size_t)t * NSEL + 8] = (bf16_t)(pw >> 16); }
        }
    }
}
DI void phase10a_fp4(const Args& a) {
    const int tid = otid(), lane = tid & 63, wave = tid >> 6;
    const SliceMap sm = slice_map(blockIdx.x, wave, gridDim.x);
    const int g = lane >> 3, i = lane & 7, gl = lane & 56;
    for (int x = sm.grp; x < 8; x += sm.NS) {
        const unsigned char* pu = a.ws + WS_PU + 128 * x + 16 * i; const unsigned char* pe = a.ws + WS_PUE + 8 * x + i;
        float* sp = (float*)(a.ws + WS_SP) + (size_t)x * T * NSEL + 16 * g + i;
        const int* idb = (const int*)(a.ws + WS_IDS) + 16 * g + i;
        const bf16_t* hb = (const bf16_t*)(a.ws + WS_H2B) + 256 * x + 32 * i;
        int t = sm.wv;
        if (t >= T) continue;
        int idlo = idb[(size_t)t * NSEL], idhi = idb[(size_t)t * NSEL + 8];
        u32x4 hr[4];
#pragma unroll
        for (int q = 0; q < 4; ++q) hr[q] = *(const u32x4*)(hb + (size_t)t * D + 8 * q);
#pragma unroll 1
        for (; t < T; t += sm.nwv) {
            __builtin_amdgcn_sched_barrier(0);
            u32x4 uw[16]; unsigned ue[16];
#pragma unroll
            for (int j = 0; j < 16; ++j) {
                const int id = __shfl(j < 8 ? idlo : idhi, gl | (j & 7));
                uw[j] = *(const u32x4*)(pu + (size_t)id * ROWB4); ue[j] = pe[(size_t)id * 64];
            }
            f32x2 hf[16];
#pragma unroll
            for (int q = 0; q < 4; ++q) {
#pragma unroll
                for (int z = 0; z < 4; ++z) { const unsigned pw = hr[q][z]; hf[4 * q + z] = (f32x2){bflo(pw), bfhi(pw)}; } }
            {   const int tn = (t + sm.nwv < T) ? t + sm.nwv : t;
                idlo = idb[(size_t)tn * NSEL]; idhi = idb[(size_t)tn * NSEL + 8];
#pragma unroll
                for (int q = 0; q < 4; ++q) hr[q] = *(const u32x4*)(hb + (size_t)tn * D + 8 * q);
            }
            __builtin_amdgcn_sched_barrier(0);
            float olo = 0.f, ohi = 0.f;
#pragma unroll
            for (int j = 0; j < 16; ++j) {
                f32x2 s2 = (f32x2){0.f, 0.f};
#if XTRA == 2
                f32x2 s3 = (f32x2){1.f, 1.f};
#endif
#pragma unroll
                for (int d = 0; d < 4; ++d) { f32x2 r[4]; const unsigned wd = uw[j][d]; fp4_unpack8(wd, r);
#if XTRA == 1
                    { unsigned wd2 = wd; asm volatile("" : "+v"(wd2)); f32x2 r2[4]; fp4_unpack8(wd2, r2); asm volatile("" :: "v"(r2[0]), "v"(r2[1]), "v"(r2[2]), "v"(r2[3])); }
#endif
#if XTRA == 2
#pragma unroll
                    for (int z = 0; z < 4; ++z) s3 = __builtin_elementwise_fma(hf[4 * d + z], r[z], s3);
#endif
#pragma unroll
                    for (int z = 0; z < 4; ++z) s2 = __builtin_elementwise_fma(hf[4 * d + z], r[z], s2); }
#if XTRA == 2
                asm volatile("" :: "v"(s3));
#endif
                float v = (s2[0] + s2[1]) * __uint_as_float(ue[j] << 23);
                v += __shfl_xor(v, 1); v += __shfl_xor(v, 2); v += __shfl_xor(v, 4);
                if (j < 8) olo = (i == j) ? v : olo; else ohi = (i == j - 8) ? v : ohi;
            }
            sp[(size_t)t * NSEL] = olo; sp[(size_t)t * NSEL + 8] = ohi;
        }
    }
}
DI void phase10b(const Args& a) {
    const int gt = blockIdx.x * NTHREADS + otid(), NT = gridDim.x * NTHREADS;
    const u32x2* sp = (const u32x2*)(a.ws + WS_SP); const f32x4* gw = (const f32x4*)(a.ws + WS_GW); u32x2* cf = (u32x2*)(a.ws + WS_CF);
    constexpr int N4 = T * NSEL / 4;
    for (int q = gt; q < N4; q += NT) {
        f32x4 s = (f32x4){0.f, 0.f, 0.f, 0.f};
#pragma unroll
        for (int x = 0; x < 8; ++x) { const u32x2 w = sp[(size_t)x * N4 + q]; s += (f32x4){bflo(w.x), bfhi(w.x), bflo(w.y), bfhi(w.y)}; }
        const f32x4 gg = gw[q];
        f32x4 o;
#pragma unroll
        for (int k = 0; k < 4; ++k) o[k] = geluf_(s[k]) * gg[k];
        cf[q] = (u32x2){pk2(o[0], o[1]), pk2(o[2], o[3])};
    }
}
DI void phase10c_fp4(const Args& a, LAS unsigned char* lds) {
    const int tid = otid(), lane = tid & 63, wave = tid >> 6;
    const SliceMap sm = slice_map(blockIdx.x, wave, gridDim.x);
    const int g = lane >> 3, i = lane & 7, gl = lane & 56;
    const float* mod = (const float*)(a.ws + WS_CTL) + CW_MOD;
    for (int x = sm.grp; x < 8; x += sm.NS) {
        const unsigned char* pv = a.ws + WS_PV + 128 * x;
        const unsigned lo16 = 16u * i, lo1 = (unsigned)i;
        {
            __syncthreads();
            const u32x4* s4 = (const u32x4*)(a.ws + WS_PVE + (size_t)x * (NEXP * 8));
            for (int q = tid; q < NEXP * 8 / 16; q += NTHREADS) *(LAS u32x4*)(lds + 16 * q) = s4[q];
            __syncthreads();
        }
        const unsigned short* idb = (const unsigned short*)(a.ws + WS_IDS) + 16 * g + i;
        const bf16_t* cfb = (const bf16_t*)(a.ws + WS_CF) + 16 * g + i;
        const int col = 256 * x + 32 * i + 16 * ((lane >> 5) & 1) + 8 * ((lane >> 4) & 1) + 4 * ((lane >> 3) & 1);
        int t = sm.wv;
        if (t >= T) continue;
        int idlo = idb[(size_t)t * NSEL], idhi = idb[(size_t)t * NSEL + 8];
        float clo = bf2f(cfb[(size_t)t * NSEL]), chi = bf2f(cfb[(size_t)t * NSEL + 8]);
#pragma unroll 1
        for (; t < T; t += sm.nwv) {
            __builtin_amdgcn_sched_barrier(0);
            u32x4 vw[16]; unsigned ve[16]; float cs[16];
#pragma unroll
            for (int j = 0; j < 16; ++j) {
                const unsigned id = (unsigned)__shfl(j < 8 ? idlo : idhi, gl | (j & 7));
                cs[j] = __shfl(j < 8 ? clo : chi, gl | (j & 7));
                vw[j] = *(const u32x4*)(pv + ((id << 10) + lo16)); ve[j] = lds[(id << 3) + lo1];
            }
            {   const int tn = (t + sm.nwv < T) ? t + sm.nwv : t;
                idlo = idb[(size_t)tn * NSEL]; idhi = idb[(size_t)tn * NSEL + 8];
                clo = bf2f(cfb[(size_t)tn * NSEL]); chi = bf2f(cfb[(size_t)tn * NSEL + 8]);
            }
            float* orow = a.out + (size_t)t * D + col;
            const u32x2 xw = *(const u32x2*)(x1b_row(a.ws, t) + col);
            f32x4 xv = (f32x4){bflo(xw.x), bfhi(xw.x), bflo(xw.y), bfhi(xw.y)};
            const f32x4 g2 = *(const f32x4*)(mod + (t >> 14) * NMOD + 5 * D + col);
            __builtin_amdgcn_sched_barrier(0);
            f32x2 acc[16];
#pragma unroll
            for (int k = 0; k < 16; ++k) acc[k] = (f32x2){0.f, 0.f};
#pragma unroll
            for (int j = 0; j < 16; ++j) {
                const float bs = __uint_as_float(ve[j] << 23);
                const f32x2 c2 = (f32x2){cs[j], cs[j]};
#pragma unroll
                for (int d = 0; d < 4; ++d) { f32x2 r[4]; const unsigned wd = vw[j][d];
                    r[0] = __builtin_amdgcn_cvt_scalef32_pk_f32_fp4(wd, bs, 0); r[1] = __builtin_amdgcn_cvt_scalef32_pk_f32_fp4(wd, bs, 1);
                    r[2] = __builtin_amdgcn_cvt_scalef32_pk_f32_fp4(wd, bs, 2); r[3] = __builtin_amdgcn_cvt_scalef32_pk_f32_fp4(wd, bs, 3);
#pragma unroll
                    for (int z = 0; z < 4; ++z) acc[4 * d + z] = __builtin_elementwise_fma(c2, r[z], acc[4 * d + z]); }
            }
            f32x2 q8[8], q4[4], q2[2];
#pragma unroll
            for (int k = 0; k < 8; ++k) {
#pragma unroll
                for (int c = 0; c < 2; ++c) { const auto r = __builtin_amdgcn_permlane32_swap(__float_as_uint(acc[k][c]), __float_as_uint(acc[8 + k][c]), false, false);
                    q8[k][c] = __uint_as_float(r[0]) + __uint_as_float(r[1]); } }
#pragma unroll
            for (int k = 0; k < 4; ++k) {
#pragma unroll
                for (int c = 0; c < 2; ++c) { const auto r = __builtin_amdgcn_permlane16_swap(__float_as_uint(q8[k][c]), __float_as_uint(q8[4 + k][c]), false, false);
                    q4[k][c] = __uint_as_float(r[0]) + __uint_as_float(r[1]); } }
            { const bool hi = lane & 8;
#pragma unroll
              for (int k = 0; k < 2; ++k) {
#pragma unroll
                  for (int c = 0; c < 2; ++c) { const float kp = hi ? q4[2 + k][c] : q4[k][c], sd = hi ? q4[k][c] : q4[2 + k][c]; q2[k][c] = kp + dppf<DPP_XOR8>(sd); } } }
            xv[0] += g2[0] * q2[0][0]; xv[1] += g2[1] * q2[0][1]; xv[2] += g2[2] * q2[1][0]; xv[3] += g2[3] * q2[1][1];
            *(f32x4*)orow = xv;
        }
    }
}

#if DBG
DI float naive_mod(const Args& a, int b, int n) {
    float s = a.b_ada[n];
    for (int k = 0; k < D; ++k) s += siluf_(a.c[b * D + k]) * a.w_ada[(size_t)k * NMOD + n];
    return s;
}
DI void check_p0(const Args& a) {
    unsigned* ctl = (unsigned*)(a.ws + WS_CTL);
    const int gt = blockIdx.x * NTHREADS + otid();
    const float* mod = (const float*)ctl + CW_MOD;
    if (gt < 256) { const int b = gt & 1, n = (gt * 97 + 13) % NMOD; const float ref = naive_mod(a, b, n); dbg_report(ctl, 0, relerr(mod[b * NMOD + n], ref, 0.02f)); }
    else if (gt < 1280) {
        const int i = gt - 256; const unsigned h = (unsigned)i * 2654435761u;
        {   const int n = h % NPROJ, k = (h >> 13) % D; const int nsrc = n < 3072 ? n : n + 8;
            dbg_report(ctl, 1, relerr(bf2f(((const bf16_t*)(a.ws + WS_WIN))[(size_t)n * D + k]), a.w_in[(size_t)k * INW + nsrc], 1e-3f) * 0.5f); }
        {   const int n = h % D, k = (h >> 12) % SW; dbg_report(ctl, 1, relerr(bf2f(((const bf16_t*)(a.ws + WS_WSSM))[(size_t)n * SW + k]), a.w_ssm_up[(size_t)k * D + n], 1e-3f) * 0.5f); }
        {   const int n = h % D, k = (h >> 12) % AW; dbg_report(ctl, 1, relerr(bf2f(((const bf16_t*)(a.ws + WS_WATTN))[(size_t)n * AW + k]), a.w_attn_up[(size_t)k * D + n], 1e-3f) * 0.5f); }
        {   const int n = h % D, k = (h >> 12) % D; dbg_report(ctl, 1, relerr(bf2f(((const bf16_t*)(a.ws + WS_WOUT))[(size_t)n * D + k]), a.w_out[(size_t)k * D + n], 1e-3f) * 0.5f);
            dbg_report(ctl, 1, relerr(bf2f(((const bf16_t*)(a.ws + WS_WPQ))[(size_t)n * D + k]), a.w_peer_q[(size_t)k * D + n], 1e-3f) * 0.5f); }
        {   const int n = h % SW, k = (h >> 12) % SW; dbg_report(ctl, 1, relerr(bf2f(((const bf16_t*)(a.ws + WS_WGLU))[(size_t)n * SW + k]), a.w_glu[(size_t)k * SW + n], 1e-3f) * 0.5f); }
        {   const size_t e = ((size_t)h * 8191u + i) % ((size_t)NEXP * D); const int er = (int)(e >> 11), ek = (int)(e & 2047);
#if TAB4
            dbg_report(ctl, 1, relerr(fp4_at(a.ws + WS_PU + (size_t)er * ROWB4, a.ws + WS_PUE + (size_t)er * 64, ek), a.peer_u[e], 5e-2f) * 0.012f);
            dbg_report(ctl, 1, relerr(fp4_at(a.ws + WS_PV + (size_t)er * ROWB4, a.ws + WS_PVE + (size_t)er * 64, ek), a.peer_v[e], 6e-1f) * 0.012f); }
#else
            dbg_report(ctl, 1, relerr(fp6_at(a.ws + WS_PU + (size_t)er * ROWB, ek) * ((const float*)(a.ws + WS_PUS))[er], a.peer_u[e], 5e-2f) * 0.05f);
            dbg_report(ctl, 1, relerr(fp6_at(a.ws + WS_PV + (size_t)er * ROWB, ek) * ((const float*)(a.ws + WS_PVS))[er], a.peer_v[e], 6e-1f) * 0.05f); }
#endif
        {   const size_t e = (size_t)h % (16 * 128 * 128); dbg_report(ctl, 1, relerr(bf2f(((const bf16_t*)(a.ws + WS_KEYS))[e]), a.sub_keys[e], 1e-3f) * 0.5f); }
    }
}
DI void check_p1(const Args& a) {
    unsigned* ctl = (unsigned*)(a.ws + WS_CTL);
    const int tid_ = otid(); const int lane = tid_ & 63, gw = blockIdx.x * NWAVES + (tid_ >> 6);
    if (gw >= 64) return;
    const int m = (int)(((unsigned)gw * 2654435761u) % T), b = m >> 14;
    const float* mod = (const float*)ctl + CW_MOD;
    const float* xr = a.x + (size_t)m * D;
    float ss = 0.f;
    for (int k = lane; k < D; k += 64) ss += xr[k] * xr[k];
    const float r = rsqrtf(wave_sum(ss) / D + RMS_EPS);
    float f[8] = {0, 0, 0, 0, 0, 0, 0, 0};
    const bf16_t* hb = (const bf16_t*)(a.ws + WS_HB) + (size_t)m * D;
    for (int k = lane; k < D; k += 64) {
        const float sc = mod[b * NMOD + 1 * D + k], shv = mod[b * NMOD + k];
        const float h = xr[k] * r * a.norm1_w[k] * (1.0f + sc) + shv;
        dbg_report(ctl, 2, relerr(bf2f(hb[k]), h, 0.05f));
        for (int j = 0; j < 8; ++j) f[j] += h * a.w_in[(size_t)k * INW + 3072 + j];
    }
    for (int j = 0; j < 8; ++j) {
        const float z = wave_sum(f[j]) + a.b_forget[j];
        const float ref = -log1pf(expf(-z));
        if (lane == 0) dbg_report(ctl, 3, relerr(((const float*)(a.ws + WS_LF))[(size_t)m * 8 + j], ref, 0.01f));
    }
}
DI void check_p2(const Args& a) {
    unsigned* ctl = (unsigned*)(a.ws + WS_CTL);
    const int gt = blockIdx.x * NTHREADS + otid();
    if (gt >= 4096) return;
    const unsigned h = (unsigned)gt * 2654435761u;
    const int m = (h >> 7) % T, n = (h % 977 + gt * 7) % NPROJ;
    const bf16_t* hb = (const bf16_t*)(a.ws + WS_HB) + (size_t)m * D; const bf16_t* w = (const bf16_t*)(a.ws + WS_WIN) + (size_t)n * D;
    float s = 0.f;
    for (int k = 0; k < D; ++k) s += bf2f(hb[k]) * bf2f(w[k]);
    float got;
    if (n < 3072) got = bf2f(((const bf16_t*)(a.ws + WS_QKV))[(size_t)m * 3072 + n]);
    else if (n < 3584) got = bf2f(((const bf16_t*)(a.ws + WS_U))[(size_t)m * 512 + n - 3072]);
    else { got = bf2f(((const bf16_t*)(a.ws + WS_GATES))[(size_t)m * 4096 + n - 3584]); s = sigmoidf_(s); }
    dbg_report(ctl, 4, relerr(got, s, 0.05f));
}

DI void check_p3(const Args& a) {
    unsigned* ctl = (unsigned*)(a.ws + WS_CTL);
    const int tid_ = otid(); const int lane = tid_ & 63, gw = blockIdx.x * NWAVES + (tid_ >> 6);
    if (gw >= 48) return;
    const unsigned hsh = (unsigned)(gw + 1) * 2654435761u;
    const int b = gw & 1, h = (gw >> 1) & 7, t = (gw < 16) ? (gw * 37) : (int)(hsh % SEQ);
    const bf16_t* qkv = (const bf16_t*)(a.ws + WS_QKV);
    const bf16_t* vt = (const bf16_t*)(a.ws + WS_VT) + (size_t)(b * AH + h) * HD * SEQ;
    const float* Floc = (const float*)(a.ws + WS_F) + (size_t)(b * AH + h) * SEQ; const float* segt = (const float*)(a.ws + WS_CTL) + CW_SEGT + (b * AH + h) * 8;
    auto F = [&](int i) -> float { float o_ = 0.f; for (int z = 0; z < (i >> 11); ++z) o_ += segt[z]; return Floc[i] + o_; };
    float* scr = (float*)(a.ws + WS_DBGS) + (size_t)gw * SEQ;
    const size_t mrow = (size_t)b * SEQ;
    const bf16_t* qp = qkv + (mrow + t) * 3072 + h * 128;
    float mx = -1e30f;
    for (int s = lane; s <= t; s += 64) {
        const bf16_t* kp = qkv + (mrow + s) * 3072 + 1024 + h * 128;
        float d = 0.f;
        for (int k = 0; k < HD; ++k) d += bf2f(qp[k]) * bf2f(kp[k]);
        d += F(t) - F(s);
        scr[s] = d; mx = fmaxf(mx, d);
    }
    for (int o = 1; o < 64; o <<= 1) mx = fmaxf(mx, __shfl_xor(mx, o));
    float l = 0.f;
    for (int s = lane; s <= t; s += 64) { const float p = exp2f(scr[s] - mx); scr[s] = p; l += p; }
    l = wave_sum(l);
    __builtin_amdgcn_fence(__ATOMIC_RELEASE, "agent"); __builtin_amdgcn_fence(__ATOMIC_ACQUIRE, "agent");
    const bf16_t* yo = (const bf16_t*)(a.ws + WS_YATT) + (mrow + t) * AW + h * 128;
    for (int dd = 0; dd < 2; ++dd) {
        const int d = lane + 64 * dd;
        float acc = 0.f;
        for (int s = 0; s <= t; ++s) {
            const int pos = (s & ~15) + 8 * ((s >> 2) & 1) + 4 * ((s >> 3) & 1) + (s & 3);
            acc += scr[s] * bf2f(vt[((size_t)(pos >> 6) * HD + d) * 64 + (pos & 63)]);
        }
        dbg_report(ctl, 5, relerr(bf2f(yo[d]), acc / l, 0.5f));
    }
}


DI void check_p2b(const Args& a) {
    unsigned* ctl = (unsigned*)(a.ws + WS_CTL);
    const int tid_ = otid(); const int lane = tid_ & 63, gw = blockIdx.x * NWAVES + (tid_ >> 6);
    if (gw < 32) {
        const unsigned hsh = (unsigned)(gw + 3) * 2654435761u;
        const int m = 16384 + (hsh % 16384), h = (hsh >> 20) & 7, qk = gw & 1;
        const bf16_t* hb = (const bf16_t*)(a.ws + WS_HB) + (size_t)m * D;
        float raw[2], ss = 0.f;
        for (int dd = 0; dd < 2; ++dd) {
            const int d = lane + 64 * dd;
            const bf16_t* w = (const bf16_t*)(a.ws + WS_WIN) + (size_t)(qk * 1024 + h * 128 + d) * D;
            float s = 0.f;
            for (int k = 0; k < D; ++k) s += bf2f(hb[k]) * bf2f(w[k]);
            raw[dd] = s; ss += s * s;
        }
        ss = wave_sum(ss);
        const float r = rsqrtf(ss / HD + RMS_EPS);
        for (int dd = 0; dd < 2; ++dd) {
            const int d = lane + 64 * dd;
            const float ref = raw[dd] * r * (qk ? a.k_norm_w[d] : a.q_norm_w[d] * 0.08838834764831845f * LOG2E);
            dbg_report(ctl, 6, relerr(bf2f(((const bf16_t*)(a.ws + WS_QKV))[(size_t)m * 3072 + qk * 1024 + h * 128 + d]), ref, 0.05f));
        }
    } else if (gw < 48 && lane == 0) {
        const int bh = gw - 32, b = bh >> 3, h = bh & 7;
        const float* lf = (const float*)(a.ws + WS_LF); const float* F = (const float*)(a.ws + WS_F) + (size_t)bh * SEQ;
        double c = 0.0;
        const float* segt = (const float*)(a.ws + WS_CTL) + CW_SEGT + bh * 8;
        for (int s = 0; s < 3000; ++s) { c += (double)lf[((size_t)b * SEQ + s) * 8 + h]; if (s % 499 == 0) dbg_report(ctl, 7, relerr(F[s] + (s >= 2048 ? segt[0] : 0.f), (float)(c * 1.4426950408889634), 0.01f)); }
    }
}


DI void check_p456(const Args& a, int which) {
    unsigned* ctl = (unsigned*)(a.ws + WS_CTL);
    const int gt = blockIdx.x * NTHREADS + otid();
    if (gt >= 2048) return;
    const unsigned h = (unsigned)(gt + 11) * 2654435761u;
    const int m = (h >> 7) % T;
    if (which == 0) {
        const int n = h % SW;
        const bf16_t* g = (const bf16_t*)(a.ws + WS_GY) + (size_t)m * SW; const bf16_t* w = (const bf16_t*)(a.ws + WS_WGLU) + (size_t)n * SW;
        float s = a.b_glu[n];
        for (int k = 0; k < SW; ++k) s += bf2f(g[k]) * bf2f(w[k]);
        dbg_report(ctl, 8, relerr(bf2f(((const bf16_t*)(a.ws + WS_YG))[(size_t)m * SW + n]), bf2f(g[n]) * sigmoidf_(s), 0.2f));
    } else if (which == 1) {
        const int n = h % D;
        const bf16_t* yg = (const bf16_t*)(a.ws + WS_YG) + (size_t)m * SW; const bf16_t* w1 = (const bf16_t*)(a.ws + WS_WSSM) + (size_t)n * SW;
        const bf16_t* ya = (const bf16_t*)(a.ws + WS_YATT) + (size_t)m * AW; const bf16_t* w2 = (const bf16_t*)(a.ws + WS_WATTN) + (size_t)n * AW;
        float s1 = 0.f, s2 = 0.f;
        for (int k = 0; k < SW; ++k) s1 += bf2f(yg[k]) * bf2f(w1[k]);
        for (int k = 0; k < AW; ++k) s2 += bf2f(ya[k]) * bf2f(w2[k]);
        const bf16_t* gt_ = (const bf16_t*)(a.ws + WS_GATES) + (size_t)m * 4096;
        const float ref = bf2f(gt_[n]) * s1 + bf2f(gt_[2048 + n]) * s2;
        dbg_report(ctl, 9, relerr(bf2f(((const bf16_t*)(a.ws + WS_MRG))[(size_t)m * D + n]), ref, 0.3f));
    } else {
        const int n = h % D, b = m >> 14;
        const bf16_t* mr = (const bf16_t*)(a.ws + WS_MRG) + (size_t)m * D; const bf16_t* w = (const bf16_t*)(a.ws + WS_WOUT) + (size_t)n * D;
        float s = 0.f;
        for (int k = 0; k < D; ++k) s += bf2f(mr[k]) * bf2f(w[k]);
        const float g1 = ((const float*)ctl + CW_MOD)[b * NMOD + 2 * D + n];
        dbg_report(ctl, 10, relerr(a.out[(size_t)m * D + n], a.x[(size_t)m * D + n] + g1 * s, 1.0f) * 10.f);
    }
}


DI void check_p8(const Args& a) {
    unsigned* ctl = (unsigned*)(a.ws + WS_CTL);
    const int gt = blockIdx.x * NTHREADS + otid();
    if (gt >= 2048) return;
    const unsigned h = (unsigned)(gt + 5) * 2654435761u;
    const int m = (h >> 7) % T, n = h % D;
    const bf16_t* hr = (const bf16_t*)(a.ws + WS_H2B) + (size_t)m * D; const bf16_t* w = (const bf16_t*)(a.ws + WS_WPQ) + (size_t)n * D;
    float s = 0.f;
    for (int k = 0; k < D; ++k) s += bf2f(hr[k]) * bf2f(w[k]);
    dbg_report(ctl, 11, relerr(bf2f(((const bf16_t*)(a.ws + WS_QP))[(size_t)m * D + n]), s, 0.3f));
}
DI void check_p9(const Args& a) {
    unsigned* ctl = (unsigned*)(a.ws + WS_CTL);
    const int tid_ = otid(); const int lane = tid_ & 63, gw = blockIdx.x * NWAVES + (tid_ >> 6);
    if (gw >= 64) return;
    const unsigned hsh = (unsigned)(gw + 7) * 2654435761u;
    const int m = (hsh >> 5) % T, h = gw & 7;
    const bf16_t* qp = (const bf16_t*)(a.ws + WS_QP) + (size_t)m * D + h * 256;
    const bf16_t* keys = (const bf16_t*)(a.ws + WS_KEYS) + (size_t)h * 2 * NKEYS * 128;
    float* scr = (float*)(a.ws + WS_DBGS) + (size_t)gw * 256;
    for (int r = lane; r < 256; r += 64) {
        const int p = r >> 7; float s = 0.f;
        for (int k = 0; k < 128; ++k) s += bf2f(qp[p * 128 + k]) * bf2f(keys[(size_t)r * 128 + k]);
        scr[r] = s;
    }
    __builtin_amdgcn_fence(__ATOMIC_RELEASE, "agent"); __builtin_amdgcn_fence(__ATOMIC_ACQUIRE, "agent");
    const int* ids = (const int*)(a.ws + WS_IDS) + (size_t)m * NSEL + h * 16; const float* gwp = (const float*)(a.ws + WS_GW) + (size_t)m * NSEL + h * 16;
    float tv[16]; int te[16]; unsigned long long takenlo[4] = {0, 0, 0, 0};
    for (int r = 0; r < 16; ++r) {
        float best = -1e30f; int be = -1;
        for (int c = 0; c < 256; ++c) { const int e = lane * 256 + c; if ((takenlo[c >> 6] >> (c & 63)) & 1ull) continue; const float v = scr[e >> 7] + scr[128 + (e & 127)]; if (v > best) { best = v; be = e; } }
        float wb = best; for (int o = 1; o < 64; o <<= 1) wb = fmaxf(wb, __shfl_xor(wb, o));
        const unsigned long long bal = __ballot(best == wb); const int wl = __ffsll((long long)bal) - 1;
        const int we = __shfl(be, wl);
        if (lane == wl) { const int c = we - lane * 256; takenlo[c >> 6] |= 1ull << (c & 63); }
        tv[r] = wb; te[r] = we;
    }
    float es = 0.f; for (int r = 0; r < 16; ++r) es += expf(tv[r] - tv[0]);
    float err = 0.f;
    for (int r = 0; r < 16; ++r) {
        bool found = false;
        for (int k = 0; k < 16; ++k) if (ids[k] == te[r]) { found = true; err += fabsf(gwp[k] - expf(tv[r] - tv[0]) / es); }
        if (!found) err += expf(tv[r] - tv[0]) / es;
    }
    if (lane == 0) dbg_report(ctl, 12, err);
}
DI void check_p10(const Args& a) {
    unsigned* ctl = (unsigned*)(a.ws + WS_CTL);
    const int tid_ = otid(); const int lane = tid_ & 63, gw = blockIdx.x * NWAVES + (tid_ >> 6);
    if (gw >= 32) return;
    const unsigned hsh = (unsigned)(gw + 17) * 2654435761u;
    const int m = (hsh >> 5) % T, b = m >> 14;
    const bf16_t* hrow = (const bf16_t*)(a.ws + WS_H2B) + (size_t)m * D;
    const int* ids = (const int*)(a.ws + WS_IDS) + (size_t)m * NSEL; const float* gwp = (const float*)(a.ws + WS_GW) + (size_t)m * NSEL;
    const unsigned char* PU = a.ws + WS_PU; const unsigned char* PV = a.ws + WS_PV;
    float* scr = (float*)(a.ws + WS_DBGS) + 65536 + (size_t)gw * 128;
    for (int e = 0; e < NSEL; ++e) {
        float s = 0.f;
#if TAB4
        for (int k = lane; k < D; k += 64) s += bf2f(hrow[k]) * fp4_at(PU + (size_t)ids[e] * ROWB4, a.ws + WS_PUE + (size_t)ids[e] * 64, k);
        s = wave_sum(s);
        if (lane == 0) scr[e] = geluf_(s) * gwp[e];
#else
        for (int k = lane; k < D; k += 64) s += bf2f(hrow[k]) * fp6_at(PU + (size_t)ids[e] * ROWB, k);
        s = wave_sum(s) * ((const float*)(a.ws + WS_PUS))[ids[e]];
        if (lane == 0) scr[e] = geluf_(s) * gwp[e] * ((const float*)(a.ws + WS_PVS))[ids[e]];
#endif
    }
    __builtin_amdgcn_fence(__ATOMIC_RELEASE, "agent"); __builtin_amdgcn_fence(__ATOMIC_ACQUIRE, "agent");
    const float* mod = (const float*)ctl + CW_MOD;
    for (int c = 0; c < 8; ++c) {
        const int n = (hsh >> (c + 2)) % D;
        float pe = 0.f;
#if TAB4
        for (int e = lane; e < NSEL; e += 64) pe += scr[e] * fp4_at(PV + (size_t)ids[e] * ROWB4, a.ws + WS_PVE + (size_t)ids[e] * 64, n);
#else
        for (int e = lane; e < NSEL; e += 64) pe += scr[e] * fp6_at(PV + (size_t)ids[e] * ROWB, n);
#endif
        pe = wave_sum(pe);
        const bf16_t* mr = (const bf16_t*)(a.ws + WS_MRG) + (size_t)m * D; const bf16_t* w = (const bf16_t*)(a.ws + WS_WOUT) + (size_t)n * D;
        float s = 0.f;
        for (int k = lane; k < D; k += 64) s += bf2f(mr[k]) * bf2f(w[k]);
        s = wave_sum(s);
        const float g1 = mod[b * NMOD + 2 * D + n], g2 = mod[b * NMOD + 5 * D + n];
        const float ref = a.x[(size_t)m * D + n] + g1 * s + g2 * pe;
        if (lane == 0) dbg_report(ctl, 13, relerr(a.out[(size_t)m * D + n], ref, 1.0f) * 10.f);
    }
}


DI void check_fp6(const Args& a) {
    unsigned* ctl = (unsigned*)(a.ws + WS_CTL);
    if (blockIdx.x != 0 || otid() >= 64) return;
    bool ok = true;
#pragma unroll 1
    for (int rnd = 0; rnd < 2; ++rnd) {
        float e[32];
#pragma unroll
        for (int i = 0; i < 32; ++i) { const int c = (i * 7 + 3) & 31;
            const float mag = c < 16 ? 0.125f * c : (c < 24 ? 2.0f + 0.25f * (c - 16) : 4.0f + 0.5f * (c - 24));
            e[i] = (rnd ^ (i & 1)) ? -mag : mag; }
        const v6u w = fp6_pack_sw(e);
        const v32f r = fp6_unpack_f32(w);
#pragma unroll
        for (int i = 0; i < 32; ++i) ok = ok && (r[i] == e[i]);
    }
    dbg_report(ctl, 14, ok ? 1.f : 2.f);
}

__constant__ float dbg_tol[16] = {1e-3f, 4e-3f, 1e-2f, 1e-3f, 2e-2f, 2e-2f, 2e-2f, 2e-2f, 2e-2f, 2e-2f, 2e-2f, 2e-2f, 1e-1f, 2e-2f, 2e-2f, 2e-2f};
#endif


#define XB_TMO      128
#define XB_XCNT(j)  (256  + 64 * (j))
#define XB_XSUB(j)  (1280 + 64 * (j))
#define XB_XGEN(j)  (2304 + 64 * (j))
#define XB_TOP      3328
#define XB_TOPGEN   3392
#define XCD_BAR_WORDS 3456
#define XB_SPIN_CAP (1u << 18)
constexpr int CW_BAR = 4096;
DI unsigned xb_ld(unsigned* p)              { return __hip_atomic_load(p, __ATOMIC_RELAXED, __HIP_MEMORY_SCOPE_AGENT); }
DI unsigned xb_add(unsigned* p, unsigned v) { return __hip_atomic_fetch_add(p, v, __ATOMIC_RELAXED, __HIP_MEMORY_SCOPE_AGENT); }
DI unsigned xb_xcc_id() { return (unsigned)__builtin_amdgcn_s_getreg((3 << 11) | 20) & 0xFu; }
#define XB_SPIN(cond, bar) do { unsigned _sp = 0; while (cond) { __builtin_amdgcn_s_sleep(1); \
    if ((++_sp & 255u) == 0u) { if (xb_ld(&(bar)[XB_TMO])) break; if (_sp > XB_SPIN_CAP) { atomicAdd(&(bar)[XB_TMO], 1u); break; } } } } while (0)
struct XcdBarrier { unsigned* bar; unsigned x; volatile LAS unsigned* st; };
DI XcdBarrier xcd_barrier_post(unsigned* bar, volatile LAS unsigned* st) {
    XcdBarrier b; b.bar = bar; b.x = xb_xcc_id(); b.st = st;
    if (threadIdx.x == 0) (void)xb_add(&bar[XB_XCNT(b.x)], 1u);
    return b;
}
DI void xcd_barrier_complete(unsigned* bar, unsigned x, unsigned& nloc, unsigned& nx) {
    const unsigned G = gridDim.x * gridDim.y * gridDim.z;
    unsigned sum, cnt, mine, sp = 0u;
    for (;;) {
        sum = 0u; cnt = 0u; mine = 0u;
#pragma unroll
        for (unsigned j = 0; j < 16; ++j) { const unsigned c = xb_ld(&bar[XB_XCNT(j)]); sum += c; cnt += (c > 0u) ? 1u : 0u; mine = (j == x) ? c : mine; }
        if (sum == G) break;
        __builtin_amdgcn_s_sleep(1);
        if ((++sp & 255u) == 0u) { if (xb_ld(&bar[XB_TMO])) break; if (sp > XB_SPIN_CAP) { atomicAdd(&bar[XB_TMO], 1u); break; } }
    }
    nloc = mine > 0u ? mine : 1u; nx = cnt > 0u ? cnt : 1u;
}
#ifndef BAR_SCOPE
#define BAR_SCOPE ""
#endif
DI void xcd_barrier(const XcdBarrier& b) {
    asm volatile("s_waitcnt vmcnt(0)" ::: "memory");
    __syncthreads();
    if (threadIdx.x == 0) {
        unsigned* bar = b.bar;
        __builtin_amdgcn_s_waitcnt(0);
        unsigned nloc = b.st[0], nx = b.st[1];
        if (nloc == 0u) { xcd_barrier_complete(bar, b.x, nloc, nx); b.st[0] = nloc; b.st[1] = nx; }
        const unsigned old = xb_add(&bar[XB_XSUB(b.x)], 1u);
        const unsigned gen = old / nloc;
        if (old + 1u == (gen + 1u) * nloc) {
            __builtin_amdgcn_fence(__ATOMIC_RELEASE, BAR_SCOPE);
            asm volatile("s_waitcnt vmcnt(0)" ::: "memory");
            const unsigned og = xb_add(&bar[XB_TOP], 1u);
            const unsigned tg = og / nx;
            if (og + 1u == (tg + 1u) * nx) xb_add(&bar[XB_TOPGEN], 1u);
            else XB_SPIN(xb_ld(&bar[XB_TOPGEN]) == tg, bar);
            __builtin_amdgcn_fence(__ATOMIC_ACQUIRE, BAR_SCOPE);
            xb_add(&bar[XB_XGEN(b.x)], 1u);
            asm volatile("s_waitcnt vmcnt(0)" ::: "memory");
        } else {
            XB_SPIN(xb_ld(&bar[XB_XGEN(b.x)]) == gen, bar);
            __builtin_amdgcn_fence(__ATOMIC_ACQUIRE, BAR_SCOPE);
            asm volatile("s_waitcnt vmcnt(0)" ::: "memory");
        }
    }
    __syncthreads();
}


#ifndef TUNIT
#define TUNIT 50000
#endif
#ifndef TIMING
#define TIMING 0
#endif
__global__ void __launch_bounds__(NTHREADS, 2) mk_fwd(Args a) {
    extern __shared__ __attribute__((aligned(16))) unsigned char lds_raw[];
    LAS unsigned char* lds = (LAS unsigned char*)lds_raw;
    cg::grid_group grid = cg::this_grid();
    const int G = gridDim.x, blk = blockIdx.x;
    unsigned char* ws = a.ws;
    unsigned* ctl = (unsigned*)(ws + WS_CTL);
    unsigned long long* ts = (unsigned long long*)(ctl + 512);
#define STAMP(k) do { if (TIMING && blk == 0 && threadIdx.x == 0) ts[k] = __builtin_amdgcn_s_memrealtime(); } while (0)
#ifndef USE_XB
#define USE_XB 1
#endif
#define SYNC(k) do { if (USE_XB && (k) != 1) xcd_barrier(xbar); else { grid.sync(); if (threadIdx.x == 0) { __builtin_amdgcn_fence(__ATOMIC_ACQUIRE, BAR_SCOPE); asm volatile("s_waitcnt vmcnt(0)" ::: "memory"); } __syncthreads(); } STAMP(k); } while (0)
#if DBG
#define CHECK(stop, call) do { if (DBG_STOP > (stop)) call; grid.sync(); } while (0)
#else
#define CHECK(stop, call) do { } while (0)
#endif
    volatile LAS unsigned* xst = (volatile LAS unsigned*)(lds + LDS_BYTES - 64);
    if (threadIdx.x < 2) xst[threadIdx.x] = 0u;
    __syncthreads();
    XcdBarrier xbar = xcd_barrier_post(ctl + CW_BAR, xst);
    STAMP(0);
    phase0(a, lds);
    s5_tables_p0(a);
    SYNC(1);
#if DUP == 1
    phase0(a, lds); s5_tables_p0(a); SYNC(15);
#endif
    CHECK(0, check_p0(a));
    CHECK(0, check_fp6(a));
    if (DBG_STOP > 1) { s5_tables_p1(a); row_pass<true>(a, lds, a.x, a.norm1_w, 0, 1, (bf16_t*)(ws + WS_HB)); }
    SYNC(2);
#if DUP == 2
    s5_tables_p1(a); row_pass<true>(a, lds, a.x, a.norm1_w, 0, 1, (bf16_t*)(ws + WS_HB)); SYNC(15);
#endif
    CHECK(1, check_p1(a));
    if (DBG_STOP > 2) {
        pg8::Gemm g{(const bf16_t*)(ws + WS_HB), (const bf16_t*)(ws + WS_WIN), T, NPROJ, D};
        pg8::StaticOrder S; S.init(T, NPROJ, G, blk);
        EpiProj E{(bf16_t*)(ws + WS_QKV), (bf16_t*)(ws + WS_U), ws + WS_GATES};
        pg8::gemm_phase<EpiProj, pg8::StaticOrder, G_ALIGN, G_SP2>(lds, g, S, E);
    }
    SYNC(3);
    CHECK(2, check_p2(a));
    if (DBG_STOP > 3) phase2b(a, lds);
    SYNC(4);
    CHECK(3, check_p2b(a));
    if (DBG_STOP > 4) phase3(a, lds);
    SYNC(5);
    CHECK(4, check_p3(a));
    if (DBG_STOP > 5) {
        pg8::Gemm g{(const bf16_t*)(ws + WS_GY), (const bf16_t*)(ws + WS_WGLU), T, SW, SW};
        pg8::StaticOrder S; S.init(T, SW, G, blk);
        EpiGlu E{(const bf16_t*)(ws + WS_GY), a.b_glu, (bf16_t*)(ws + WS_YG)};
        pg8::gemm_phase<EpiGlu, pg8::StaticOrder, G_ALIGN, G_SP2>(lds, g, S, E);
    }
    SYNC(6);
    CHECK(5, check_p456(a, 0));
    for (int dup = 0; dup < (DUP == 5 ? 2 : 1); ++dup) {
        if (dup) SYNC(15);
        { pg8::Gemm g{(const bf16_t*)(ws + WS_YG), (const bf16_t*)(ws + WS_WSSM), T, D, SW};
          pg8::StaticOrder S; S.init(T, D, G, blk);
          EpiSsmUp E{ws + WS_GATES, (bf16_t*)(ws + WS_MRG)};
          pg8::gemm_phase<EpiSsmUp, pg8::StaticOrder, G_ALIGN, G_SP2>(lds, g, S, E); }
        { pg8::Gemm g{(const bf16_t*)(ws + WS_YATT), (const bf16_t*)(ws + WS_WATTN), T, D, AW};
          pg8::StaticOrder S; S.init(T, D, G, blk);
          EpiAttnUp E{ws + WS_GATES, (bf16_t*)(ws + WS_MRG)};
          pg8::gemm_phase<EpiAttnUp, pg8::StaticOrder, G_ALIGN, G_SP2>(lds, g, S, E); }
    }
    SYNC(7);
    CHECK(6, check_p456(a, 1));
    if (DBG_STOP > 7) {
        pg8::Gemm g{(const bf16_t*)(ws + WS_MRG), (const bf16_t*)(ws + WS_WOUT), T, D, D};
        pg8::StaticOrder S; S.init(T, D, G, blk);
        EpiOut E{a.x, (const float*)ctl + CW_MOD, a.b_ada, ws};
        pg8::gemm_phase<EpiOut, pg8::StaticOrder, G_ALIGN, G_SP2>(lds, g, S, E);
    }
    SYNC(8);
    CHECK(7, check_p456(a, 2));
    if (DBG_STOP > 8) row_pass<false, true>(a, lds, nullptr, a.norm2_w, 3, 4, (bf16_t*)(ws + WS_H2B));
    SYNC(9);
    if (DBG_STOP > 9) {
        pg8::Gemm g{(const bf16_t*)(ws + WS_H2B), (const bf16_t*)(ws + WS_WPQ), T, D, D};
        pg8::StaticOrder S; S.init(T, D, G, blk);
        EpiPlain E{(bf16_t*)(ws + WS_QP), D};
        pg8::gemm_phase<EpiPlain, pg8::StaticOrder, G_ALIGN, G_SP2>(lds, g, S, E);
    }
    SYNC(10);
    CHECK(9, check_p8(a));
    for (int dup = 0; dup < (DUP == 9 ? 2 : 1); ++dup) { if (dup) SYNC(15); phase9(a, lds);
#if TAB4 && P10_SLICED && U4
        hdigits_pass(a);
#endif
    }
    SYNC(11);
    CHECK(10, check_p9(a));
#if PROBE == 14
#elif TAB4 && P10_SLICED
#if U4
    if (DBG_STOP > 11) { phase10a_u4(a, lds); SYNC(13);
#if DUP == 10
        phase10a_u4(a, lds); SYNC(15);
#endif
        phase10b(a); SYNC(14);
#if DUP == 11
        phase10b(a); SYNC(15);
#endif
        phase10c_fp4(a, lds); }
#else
    if (DBG_STOP > 11) { phase10a_fp4(a); SYNC(13); phase10b(a); SYNC(14); phase10c_fp4(a, lds); }
#endif
#elif TAB4
    if (DBG_STOP > 11) phase10_fp4(a);
#else
    if (DBG_STOP > 11) phase10(a);
#endif
#if DBG || TIMING
    SYNC(12);
#endif
    CHECK(11, check_p10(a));
#if DBG
    if (DBG_STOP <= 7) {
        const f32x4* x4 = (const f32x4*)a.x; f32x4* o4 = (f32x4*)a.out;
        const size_t n4 = (size_t)T * D / 4;
        for (size_t i = (size_t)blk * NTHREADS + threadIdx.x; i < n4; i += (size_t)G * NTHREADS) o4[i] = x4[i];
    }
    grid.sync();
    {
        int code = 0;
        for (int i = 15; i >= 0; --i) { const float e = __uint_as_float(__hip_atomic_load(ctl + CW_DBG + i, __ATOMIC_RELAXED, __HIP_MEMORY_SCOPE_AGENT));
            if (e > dbg_tol[i]) { if (i >= DBG_LO && i < DBG_LO + 4) code |= 1 << (i - DBG_LO); else if (i < DBG_LO) code = 20 + i; } }
#ifdef DBG_MAG
        code = 1;
#endif
        if (code) {
#ifdef DBG_MAG
            const float s = 1.0f + fminf(__uint_as_float(__hip_atomic_load(ctl + CW_DBG + DBG_MAG, __ATOMIC_RELAXED, __HIP_MEMORY_SCOPE_AGENT)), 1000.f);
#else
            const float s = 1.0f + (float)code;
#endif
            f32x4* o4 = (f32x4*)a.out; const size_t n4 = (size_t)T * D / 4;
            for (size_t i = (size_t)blk * NTHREADS + threadIdx.x; i < n4; i += (size_t)G * NTHREADS) o4[i] = o4[i] * s;
        }
    }
#endif
#ifndef PROBE
#define PROBE 0
#endif
#if PROBE
    {
        SYNC(17);
        float* o = a.out; const size_t n = (size_t)T * D;
        for (size_t i = (size_t)blk * NTHREADS + threadIdx.x; i < n; i += (size_t)G * NTHREADS) {
            float v = 0.f;
            if (PROBE == 1) { if (i < (size_t)T * NSEL) v = ((const float*)(ws + WS_GW))[i]; }
            if (PROBE == 2) { if (i < (size_t)T * NSEL) v = (float)((const int*)(ws + WS_IDS))[i]; }
            if (PROBE == 3) { v = bf2f(((const bf16_t*)(ws + WS_H2B))[i]); }
            if (PROBE == 5) { v = bf2f(((const bf16_t*)(ws + WS_QP))[i]); }
            if (PROBE == 7) { v = bf2f(((const bf16_t*)(ws + WS_MRG))[i]); }
            if (PROBE == 8) { if (i < (size_t)T * SW) v = bf2f(((const bf16_t*)(ws + WS_GY))[i]); else if (i < (size_t)T * SW + (size_t)T * AW) v = bf2f(((const bf16_t*)(ws + WS_YATT))[i - (size_t)T * SW]); }
            if (PROBE == 9) { if (i < (size_t)T * SW) v = bf2f(((const bf16_t*)(ws + WS_YG))[i]); }
            if (PROBE == 15) { if (i < (size_t)NEXP * ROWB4 / 4) v = (float)(((const unsigned*)(ws + WS_PU))[i] >> 8); else if (i < (size_t)NEXP * ROWB4 / 2) v = (float)(((const unsigned*)(ws + WS_PV))[i - (size_t)NEXP * ROWB4 / 4] >> 8); }
            if (PROBE != 14) o[i] = v;
        }
    }
#endif
#if TIMING
    {
        const unsigned long long t0 = __hip_atomic_load(ts + 0, __ATOMIC_RELAXED, __HIP_MEMORY_SCOPE_AGENT), t1 = __hip_atomic_load(ts + 12, __ATOMIC_RELAXED, __HIP_MEMORY_SCOPE_AGENT);
        const unsigned long long ta = __hip_atomic_load(ts + TIMING - 1, __ATOMIC_RELAXED, __HIP_MEMORY_SCOPE_AGENT), tb = __hip_atomic_load(ts + TIMING, __ATOMIC_RELAXED, __HIP_MEMORY_SCOPE_AGENT);
        (void)t0; (void)t1;
        const float s = 1.0f + floorf((float)(tb - ta) / (float)TUNIT + 0.5f);
        f32x4* o4 = (f32x4*)a.out; const size_t n4 = (size_t)T * D / 4;
        for (size_t i = (size_t)blk * NTHREADS + threadIdx.x; i < n4; i += (size_t)G * NTHREADS) o4[i] = o4[i] * s;
    }
#endif
}

extern "C" void kernel_launch(void* const* d_in, const int* in_sizes, int n_in, void* d_out, int out_size,
                              void* d_ws, size_t ws_size, hipStream_t stream) {
    static int grid = 0;
    if (grid == 0) {
        int dev = 0, cus = 0, per_cu = 0;
        (void)hipGetDevice(&dev);
        (void)hipDeviceGetAttribute(&cus, hipDeviceAttributeMultiprocessorCount, dev);
        (void)hipFuncSetAttribute((const void*)mk_fwd, hipFuncAttributeMaxDynamicSharedMemorySize, LDS_BYTES);
        (void)hipOccupancyMaxActiveBlocksPerMultiprocessor(&per_cu, (const void*)mk_fwd, NTHREADS, LDS_BYTES);
        if (per_cu < 1) per_cu = 1;
        grid = cus * per_cu;
        if (n_in != 27 || ws_size < WS_END) { fprintf(stderr, "kernel_launch: unexpected n_in %d / ws_size %zu\n", n_in, ws_size); }
    }
    (void)hipMemsetAsync((char*)d_ws + WS_CTL, 0, CTL_ZERO_BYTES, stream);
    Args a{};
    const float** ap = (const float**)&a;
    for (int i = 0; i < 27; ++i) ap[i] = (const float*)d_in[i];
    a.out = (float*)d_out; a.ws = (unsigned char*)d_ws;
    void* args[] = {&a};
    hipError_t e = hipLaunchCooperativeKernel((const void*)mk_fwd, dim3(grid), dim3(NTHREADS), args, LDS_BYTES, stream);
    if (e != hipSuccess) fprintf(stderr, "cooperative launch failed: %s (grid %d)\n", hipGetErrorString(e), grid);
}
```

```cpp
#include <hip/hip_runtime.h>
#include <hip/hip_cooperative_groups.h>
#include <cstdio>
#include <cstdint>
namespace cg = cooperative_groups;

#ifndef DBG
#define DBG 0
#endif
#ifndef PROBE
#define PROBE 0
#endif
#ifndef DBG_LO
#define DBG_LO 10
#endif
#ifndef DBG_STOP
#define DBG_STOP 99
#endif

#define DI __device__ __forceinline__
#define GAS __attribute__((address_space(1)))
#define LAS __attribute__((address_space(3)))
typedef unsigned short bf16_t;
typedef short bf16x8 __attribute__((ext_vector_type(8)));
typedef float f32x4 __attribute__((ext_vector_type(4)));
typedef float f32x16 __attribute__((ext_vector_type(16)));
typedef unsigned u32x4 __attribute__((ext_vector_type(4)));
typedef unsigned u32x2 __attribute__((ext_vector_type(2)));
typedef __bf16 bf16x2_t __attribute__((ext_vector_type(2)));

constexpr int NTHREADS = 512, NWAVES = 8;
constexpr int LDS_BYTES = 147456;
constexpr int NB = 2, SEQ = 16384, T = NB * SEQ, D = 2048;
constexpr int AH = 8, HD = 128, AW = 1024;
constexpr int SW = 512, SGRP = 32, SCH = 16, SST = 64;
constexpr int INW = 7688, NPROJ = 7680;
constexpr int NMOD = 6 * D;
constexpr int PH = 8, NKEYS = 128, NEXP = 16384, TOPK = 16, NSEL = PH * TOPK;
constexpr float RMS_EPS = 1e-6f;
constexpr float LOG2E = 1.4426950408889634f;

constexpr size_t MiB = 1u << 20;
constexpr size_t WS_CTL = 0, CTL_ZERO_BYTES = 1 * MiB;
constexpr size_t WS_LF = 1 * MiB;
constexpr size_t WS_F = 2 * MiB;
constexpr size_t WS_WF = 3 * MiB;
constexpr size_t WS_KEYS = 3 * MiB + 512 * 1024;
constexpr size_t WS_WGLU = 4 * MiB, WS_WSSM = 5 * MiB, WS_WATTN = 7 * MiB, WS_WOUT = 11 * MiB, WS_WPQ = 19 * MiB, WS_WIN = 27 * MiB;
constexpr size_t WS_S5TAB = 57 * MiB;
constexpr size_t WS_PU = 64 * MiB, WS_PV = 88 * MiB;
constexpr size_t WS_HB = 192 * MiB;
constexpr size_t WS_QKV = 320 * MiB;
constexpr size_t WS_U = 512 * MiB;
constexpr size_t WS_YATT = 544 * MiB;
constexpr size_t WS_GY = 608 * MiB;
constexpr size_t WS_YG = 640 * MiB;
constexpr size_t WS_GATES = 672 * MiB;
constexpr size_t WS_END = 1024 * MiB;
constexpr int CW_DBG = 64;
constexpr int CW_QUEUE = 256;
constexpr int CW_SEGT = 1024;
constexpr int CW_MOD = 819200;

struct Args {
    const float *x, *c, *w_ada, *b_ada, *norm1_w, *w_in, *b_forget, *q_norm_w, *k_norm_w;
    const float *A_re, *A_im, *log_dt, *B_re, *B_im, *C_re, *C_im, *Dskip;
    const float *w_glu, *b_glu, *w_ssm_up, *w_attn_up, *w_out, *norm2_w, *w_peer_q, *sub_keys, *peer_u, *peer_v;
    float* out; unsigned char* ws;
};

DI unsigned pk2(float lo, float hi) { bf16x2_t v; v.x = (__bf16)lo; v.y = (__bf16)hi; return __builtin_bit_cast(unsigned, v); }
DI float bf2f(unsigned h) { return __uint_as_float(h << 16); }
DI float bflo(unsigned w) { return __uint_as_float(w << 16); }
DI float bfhi(unsigned w) { return __uint_as_float(w & 0xffff0000u); }
DI float sigmoidf_(float z) { return __builtin_amdgcn_rcpf(1.0f + __expf(-z)); }
DI float siluf_(float z) { return z / (1.0f + __expf(-z)); }
DI float geluf_(float z) { return 0.5f * z * (1.0f + erff(z * 0.70710678118654752f)); }
DI float wave_sum(float v) {
    v += __builtin_bit_cast(float, __builtin_amdgcn_mov_dpp(__builtin_bit_cast(int, v), 0xB1, 0xf, 0xf, true));
    v += __builtin_bit_cast(float, __builtin_amdgcn_mov_dpp(__builtin_bit_cast(int, v), 0x4E, 0xf, 0xf, true));
    v += __builtin_bit_cast(float, __builtin_amdgcn_mov_dpp(__builtin_bit_cast(int, v), 0x141, 0xf, 0xf, true));
    v += __builtin_bit_cast(float, __builtin_amdgcn_mov_dpp(__builtin_bit_cast(int, v), 0x128, 0xf, 0xf, true));
    { const auto r = __builtin_amdgcn_permlane16_swap(__float_as_uint(v), __float_as_uint(v), false, false); v = __uint_as_float(r[0]) + __uint_as_float(r[1]); }
    { const auto r = __builtin_amdgcn_permlane32_swap(__float_as_uint(v), __float_as_uint(v), false, false); v = __uint_as_float(r[0]) + __uint_as_float(r[1]); }
    return v;
}
DI int otid() { int t = threadIdx.x; asm volatile("" : "+v"(t)); return t; }
#define LDS_WAIT() asm volatile("s_waitcnt lgkmcnt(0)" ::: "memory")
DI void dbg_report(unsigned* ctl, int id, float err) {
    if (!(err == err)) err = 1e30f;
    atomicMax(ctl + CW_DBG + id, __float_as_uint(fabsf(err)));
}
DI float relerr(float got, float ref, float floor_) { return fabsf(got - ref) / (fabsf(ref) + floor_); }

namespace pg8 {
constexpr int BM = 256, BK = 64, HALF = 128, HTB = HALF * BK * 2, NXCD = 8, WGM = 8;
DI int lds_byte(int r, int c) { const int st = (r >> 4) * 2 + (c >> 5), rr = r & 15, cc = c & 31, ob = rr * 64 + cc * 2; return st * 1024 + (ob ^ (((ob >> 9) & 1) << 5)); }
DI void stage_rc(int b, int& R, int& C) { const int st = b / 1024, sb = b % 1024, swz = sb ^ (((sb >> 9) & 1) << 5); R = (st >> 1) * 16 + swz / 64; C = (st & 1) * 32 + (swz % 64) / 2; }
DI int perm32(int rho) { const int n = rho >> 4, i = rho & 15; return 8 * (i >> 2) + 4 * n + (i & 3); }
struct Unit { int pm, pn; };
struct Gemm { const bf16_t* A; const bf16_t* Bt; int M, N, K; };
struct StaticOrder {
    int nM, nN, nwg, G, c;
    DI void init(int M, int N, int G_, int c_) { nM = M / BM; nN = N / BM; nwg = nM * nN; G = G_; c = c_; }
    DI bool next(int i, Unit& u) const {
        const long L = (long)i * G + c; if (L >= nwg) return false;
        int wgid = (int)L; { const int q = nwg / NXCD, r = nwg % NXCD, xcd = wgid % NXCD, off = wgid / NXCD; wgid = (xcd < r ? xcd * (q + 1) : r * (q + 1) + (xcd - r) * q) + off; }
        const int nig = WGM * nN, gid = wgid / nig, fm = gid * WGM, gsz = (nM - fm) < WGM ? (nM - fm) : WGM;
        u.pm = fm + ((wgid % nig) % gsz); u.pn = (wgid % nig) / gsz; return true;
    }
    DI void a_ready(const Unit&) const {}
    DI void done(const Unit&) const {}
};
template <class Epi, class Sched, bool ALIGN_EPI = false, bool SP2 = false>
DI void gemm_phase(LAS unsigned char* lds, const Gemm g, const Sched& S, const Epi& E) {
    int tid = threadIdx.x; asm volatile("" : "+v"(tid));
    const int wid = __builtin_amdgcn_readfirstlane(tid >> 6), lane = tid & 63, wr = wid >> 2, wc = wid & 3, fr = lane & 15, fq = lane >> 4;
    const int K = g.K, nt = K / BK;
    unsigned voffA[2], voffB[2];
#pragma unroll
    for (int i = 0; i < 2; ++i) { int R, C; stage_rc(tid * 16 + i * 8192, R, C); const int Rb = Epi::PERM ? ((R & ~31) + perm32(R & 31)) : R;
        voffA[i] = (unsigned)(R * K + C) * 2u; voffB[i] = (unsigned)(Rb * K + C) * 2u; }
    const size_t kstep = (size_t)(BK * 2);
    const size_t hstep = (size_t)HALF * K * 2;
    const size_t tstep = 2 * hstep;
    const unsigned ldsw = (unsigned)wid * 1024u;
    const int aoff = lds_byte(wr * 64 + fr, fq * 8), boff = lds_byte(wc * 32 + fr, fq * 8);
#define PG8_SA(b, h) (((b) * 2 + (h)) * HTB)
#define PG8_SB(b, h) ((4 + (b) * 2 + (h)) * HTB)
#define PG8_STAGE(bufoff, gbase, voff) do { _Pragma("unroll") for (int _i = 0; _i < 2; ++_i) \
        __builtin_amdgcn_global_load_lds((const unsigned*)((const char*)(gbase) + (voff)[_i]), (LAS unsigned*)(lds + (bufoff) + ldsw + _i * 8192), 16, 0, 0); } while (0)
#define PG8_LDA(dst, b, h) do { _Pragma("unroll") for (int m = 0; m < 4; ++m) _Pragma("unroll") for (int k = 0; k < 2; ++k) dst[m][k] = *(const LAS bf16x8*)(lds + PG8_SA(b, h) + aoff + m * 2048 + k * 1024); } while (0)
#define PG8_LDB(dst, b, h) do { _Pragma("unroll") for (int n = 0; n < 2; ++n) _Pragma("unroll") for (int k = 0; k < 2; ++k) dst[n][k] = *(const LAS bf16x8*)(lds + PG8_SB(b, h) + boff + n * 2048 + k * 1024); } while (0)
#define PG8_MMA(ai, bj, At, Bt) do { __builtin_amdgcn_s_setprio(1); _Pragma("unroll") for (int m = 0; m < 4; ++m) _Pragma("unroll") for (int n = 0; n < 2; ++n) _Pragma("unroll") for (int k = 0; k < 2; ++k) \
        acc[ai][bj][m][n] = __builtin_amdgcn_mfma_f32_16x16x32_bf16(Bt[n][k], At[m][k], acc[ai][bj][m][n], 0, 0, 0); __builtin_amdgcn_s_setprio(0); } while (0)
#define PG8_WAIT_V(n) asm volatile("s_waitcnt vmcnt(" #n ")" ::: "memory")
#define PG8_WAIT_L(n) asm volatile("s_waitcnt lgkmcnt(" #n ")" ::: "memory")
#define PG8_BAR __builtin_amdgcn_s_barrier()
#define PG8_SCHED __builtin_amdgcn_sched_barrier(0)
    Unit cur, nxt; int ui = 0;
    if (!S.next(0, cur)) return;
    f32x4 acc[2][2][4][2];
#pragma unroll
    for (int a = 0; a < 2; ++a)
#pragma unroll
        for (int b = 0; b < 2; ++b)
#pragma unroll
            for (int m = 0; m < 4; ++m)
#pragma unroll
                for (int n = 0; n < 2; ++n) acc[a][b][m][n] = (f32x4){0.f, 0.f, 0.f, 0.f};
    bf16x8 At[4][2], B0[2][2], B1[2][2];
    const char* cA = (const char*)g.A + (size_t)cur.pm * tstep; const char* cB = (const char*)g.Bt + (size_t)cur.pn * tstep;
    S.a_ready(cur);
    if constexpr (SP2) {
        PG8_STAGE(PG8_SB(0, 0), cB, voffB); PG8_STAGE(PG8_SB(0, 1), cB + hstep, voffB); PG8_STAGE(PG8_SA(0, 0), cA, voffA); PG8_STAGE(PG8_SA(0, 1), cA + hstep, voffA);
        if (wr == 1) PG8_BAR;
        PG8_WAIT_V(2); PG8_BAR;
        PG8_STAGE(PG8_SB(1, 0), cB + kstep, voffB); PG8_STAGE(PG8_SA(1, 0), cA + kstep, voffA); PG8_STAGE(PG8_SB(1, 1), cB + hstep + kstep, voffB);
        PG8_WAIT_V(6); PG8_BAR;
    } else {
        PG8_STAGE(PG8_SB(0, 0), cB, voffB); PG8_STAGE(PG8_SA(0, 0), cA, voffA); PG8_STAGE(PG8_SB(0, 1), cB + hstep, voffB); PG8_STAGE(PG8_SA(0, 1), cA + hstep, voffA);
        if (wr == 1) PG8_BAR;
        PG8_WAIT_V(4); PG8_BAR;
        PG8_STAGE(PG8_SB(1, 0), cB + kstep, voffB); PG8_STAGE(PG8_SA(1, 0), cA + kstep, voffA); PG8_STAGE(PG8_SB(1, 1), cB + hstep + kstep, voffB);
        PG8_WAIT_V(6); PG8_BAR;
    }
    for (;;) {
        const bool has_next = S.next(ui + 1, nxt);
        const char* nA = has_next ? (const char*)g.A + (size_t)nxt.pm * tstep : cA; const char* nB = has_next ? (const char*)g.Bt + (size_t)nxt.pn * tstep : cB;
        for (int t = 0; t < nt; t += 2) {
            const bool last = (t == nt - 2);
            const char* a1 = cA + (size_t)(t + 1) * kstep;
            const char* a2 = last ? nA : cA + (size_t)(t + 2) * kstep; const char* b2 = last ? nB : cB + (size_t)(t + 2) * kstep;
            const char* a3 = a2 + kstep; const char* b3 = b2 + kstep;
            if (last && has_next) S.a_ready(nxt);
            if constexpr (SP2) {
            PG8_LDB(B0, 0, 0); PG8_LDB(B1, 0, 1); PG8_SCHED; PG8_LDA(At, 0, 0); PG8_STAGE(PG8_SA(1, 1), a1 + hstep, voffA);
            PG8_WAIT_V(8); PG8_WAIT_L(0); PG8_BAR; PG8_MMA(0, 0, At, B0); PG8_MMA(0, 1, At, B1); PG8_BAR; PG8_SCHED;
            PG8_LDA(At, 0, 1); PG8_STAGE(PG8_SB(0, 0), b2, voffB); PG8_STAGE(PG8_SB(0, 1), b2 + hstep, voffB); PG8_STAGE(PG8_SA(0, 0), a2, voffA);
            PG8_WAIT_V(8); PG8_WAIT_L(0); PG8_BAR; PG8_MMA(1, 0, At, B0); PG8_MMA(1, 1, At, B1); PG8_BAR; PG8_SCHED;
            PG8_LDB(B0, 1, 0); PG8_LDB(B1, 1, 1); PG8_SCHED; PG8_LDA(At, 1, 0); PG8_STAGE(PG8_SA(0, 1), a2 + hstep, voffA);
            PG8_WAIT_V(8); PG8_WAIT_L(0); PG8_BAR; PG8_MMA(0, 0, At, B0); PG8_MMA(0, 1, At, B1); PG8_BAR; PG8_SCHED;
            PG8_LDA(At, 1, 1); PG8_STAGE(PG8_SB(1, 0), b3, voffB); PG8_STAGE(PG8_SB(1, 1), b3 + hstep, voffB); PG8_STAGE(PG8_SA(1, 0), a3, voffA);
            PG8_WAIT_V(8); PG8_WAIT_L(0); PG8_BAR; PG8_MMA(1, 0, At, B0); PG8_MMA(1, 1, At, B1); PG8_BAR; PG8_SCHED;
            } else {
            PG8_LDB(B0, 0, 0); PG8_SCHED; PG8_LDA(At, 0, 0); PG8_STAGE(PG8_SA(1, 1), a1 + hstep, voffA);
            PG8_WAIT_L(8); PG8_BAR; PG8_WAIT_L(0); PG8_MMA(0, 0, At, B0); PG8_BAR; PG8_SCHED;
            PG8_LDB(B1, 0, 1); PG8_STAGE(PG8_SB(0, 0), b2, voffB);
            PG8_BAR; PG8_WAIT_L(0); PG8_MMA(0, 1, At, B1); PG8_BAR;
            PG8_LDA(At, 0, 1); PG8_STAGE(PG8_SA(0, 0), a2, voffA);
            PG8_BAR; PG8_WAIT_L(0); PG8_MMA(1, 0, At, B0); PG8_BAR; PG8_SCHED;
            PG8_STAGE(PG8_SB(0, 1), b2 + hstep, voffB);
            PG8_WAIT_V(6); PG8_BAR; PG8_MMA(1, 1, At, B1); PG8_BAR;
            PG8_LDB(B0, 1, 0); PG8_SCHED; PG8_LDA(At, 1, 0); PG8_STAGE(PG8_SA(0, 1), a2 + hstep, voffA);
            PG8_WAIT_L(8); PG8_BAR; PG8_WAIT_L(0); PG8_MMA(0, 0, At, B0); PG8_BAR; PG8_SCHED;
            PG8_LDB(B1, 1, 1); PG8_STAGE(PG8_SB(1, 0), b3, voffB);
            PG8_BAR; PG8_WAIT_L(0); PG8_MMA(0, 1, At, B1); PG8_BAR;
            PG8_LDA(At, 1, 1); PG8_STAGE(PG8_SA(1, 0), a3, voffA);
            PG8_BAR; PG8_WAIT_L(0); PG8_MMA(1, 0, At, B0); PG8_BAR; PG8_SCHED;
            PG8_STAGE(PG8_SB(1, 1), b3 + hstep, voffB);
            PG8_WAIT_V(6); PG8_BAR; PG8_MMA(1, 1, At, B1); PG8_BAR;
            }
        }
        if constexpr (ALIGN_EPI) { if (wr == 0) PG8_BAR; }
        E(acc, cur, wr, wc, fr, fq); S.done(cur);
        if (!has_next) break;
#pragma unroll
        for (int a = 0; a < 2; ++a)
#pragma unroll
            for (int b = 0; b < 2; ++b)
#pragma unroll
                for (int m = 0; m < 4; ++m)
#pragma unroll
                    for (int n = 0; n < 2; ++n) acc[a][b][m][n] = (f32x4){0.f, 0.f, 0.f, 0.f};
        cur = nxt; cA = nA; cB = nB; ++ui;
        if constexpr (ALIGN_EPI) { if (wr == 1) PG8_BAR; }
    }
    PG8_WAIT_V(0);
    if constexpr (!ALIGN_EPI) { if (wr == 0) PG8_BAR; }
    PG8_BAR;
#undef PG8_SA
#undef PG8_SB
#undef PG8_STAGE
#undef PG8_LDA
#undef PG8_LDB
#undef PG8_MMA
#undef PG8_WAIT_V
#undef PG8_WAIT_L
#undef PG8_BAR
#undef PG8_SCHED
}
}
constexpr bool G_ALIGN = true, G_SP2 = true;

template <class F>
DI void epi_foreach(const f32x4 (&acc)[2][2][4][2], const pg8::Unit& u, int wr, int wc, int fr, int fq, const F& f) {
#pragma unroll
    for (int ai = 0; ai < 2; ++ai)
#pragma unroll
        for (int m = 0; m < 4; ++m) {
            const int row = u.pm * 256 + ai * 128 + wr * 64 + m * 16 + fr;
#pragma unroll
            for (int bj = 0; bj < 2; ++bj) {
                const int col0 = u.pn * 256 + bj * 128 + wc * 32 + 8 * fq;
                float v[8];
#pragma unroll
                for (int k = 0; k < 4; ++k) { v[k] = acc[ai][bj][m][0][k]; v[4 + k] = acc[ai][bj][m][1][k]; }
                f(row, col0, v);
            }
        }
}
DI void store8_bf16(bf16_t* p, const float (&v)[8]) {
    u32x4 w; w.x = pk2(v[0], v[1]); w.y = pk2(v[2], v[3]); w.z = pk2(v[4], v[5]); w.w = pk2(v[6], v[7]);
    *(u32x4*)p = w;
}
DI void load8_bf16(const bf16_t* p, float (&v)[8]) {
    const u32x4 w = *(const u32x4*)p;
    v[0] = bflo(w.x); v[1] = bfhi(w.x); v[2] = bflo(w.y); v[3] = bfhi(w.y); v[4] = bflo(w.z); v[5] = bfhi(w.z); v[6] = bflo(w.w); v[7] = bfhi(w.w);
}
DI void load8_u8gate(const unsigned char* p, float (&g)[8]) {
    const u32x2 w = *(const u32x2*)p;
#pragma unroll
    for (int k = 0; k < 4; ++k) { g[k] = (float)((w.x >> (8 * k)) & 0xffu) * (1.0f / 255.0f); g[4 + k] = (float)((w.y >> (8 * k)) & 0xffu) * (1.0f / 255.0f); }
}
struct EpiProj {
    static constexpr bool PERM = true;
    bf16_t *qkv, *u; unsigned char* gates;
    DI void operator()(const f32x4 (&acc)[2][2][4][2], const pg8::Unit& un, int wr, int wc, int fr, int fq) const {
        const int pn = un.pn;
        if (pn < 12) { bf16_t* o = qkv; epi_foreach(acc, un, wr, wc, fr, fq, [&](int row, int col0, float (&v)[8]) { store8_bf16(o + (size_t)row * 3072 + col0, v); }); }
        else if (pn < 14) { bf16_t* o = u; epi_foreach(acc, un, wr, wc, fr, fq, [&](int row, int col0, float (&v)[8]) { store8_bf16(o + (size_t)row * 512 + (col0 - 3072), v); }); }
        else { unsigned char* o = gates; epi_foreach(acc, un, wr, wc, fr, fq, [&](int row, int col0, float (&v)[8]) {
                unsigned w0 = 0u, w1 = 0u;
#pragma unroll
                for (int k = 0; k < 4; ++k) { w0 |= (unsigned)(sigmoidf_(v[k]) * 255.0f + 0.5f) << (8 * k); w1 |= (unsigned)(sigmoidf_(v[4 + k]) * 255.0f + 0.5f) << (8 * k); }
                *(u32x2*)(o + (size_t)row * 4096 + (col0 - 3584)) = (u32x2){w0, w1}; }); }
    }
};


constexpr size_t WS_MRG = WS_HB;
constexpr size_t WS_X1B0 = 448 * MiB, WS_X1B1 = 928 * MiB;
DI bf16_t* x1b_row(unsigned char* ws, int m) { return (bf16_t*)(ws + ((m >> 14) ? WS_X1B1 : WS_X1B0)) + (size_t)(m & 16383) * D; }
struct EpiGlu {
    static constexpr bool PERM = true;
    const bf16_t* gy; const float* bglu; bf16_t* yg;
    DI void operator()(const f32x4 (&acc)[2][2][4][2], const pg8::Unit& un, int wr, int wc, int fr, int fq) const {
        epi_foreach(acc, un, wr, wc, fr, fq, [&](int row, int col0, float (&v)[8]) {
            float g[8]; load8_bf16(gy + (size_t)row * SW + col0, g);
#pragma unroll
            for (int k = 0; k < 8; ++k) v[k] = g[k] * sigmoidf_(v[k] + bglu[col0 + k]);
            store8_bf16(yg + (size_t)row * SW + col0, v); });
    }
};
struct EpiSsmUp {
    static constexpr bool PERM = true;
    const unsigned char* gates; bf16_t* mrg;
    DI void operator()(const f32x4 (&acc)[2][2][4][2], const pg8::Unit& un, int wr, int wc, int fr, int fq) const {
        epi_foreach(acc, un, wr, wc, fr, fq, [&](int row, int col0, float (&v)[8]) {
            float g[8]; load8_u8gate(gates + (size_t)row * 4096 + col0, g);
#pragma unroll
            for (int k = 0; k < 8; ++k) v[k] *= g[k];
            store8_bf16(mrg + (size_t)row * D + col0, v); });
    }
};
struct EpiAttnUp {
    static constexpr bool PERM = true;
    const unsigned char* gates; bf16_t* mrg;
    DI void operator()(const f32x4 (&acc)[2][2][4][2], const pg8::Unit& un, int wr, int wc, int fr, int fq) const {
        epi_foreach(acc, un, wr, wc, fr, fq, [&](int row, int col0, float (&v)[8]) {
            float g[8], o[8]; load8_u8gate(gates + (size_t)row * 4096 + 2048 + col0, g); load8_bf16(mrg + (size_t)row * D + col0, o);
#pragma unroll
            for (int k = 0; k < 8; ++k) v[k] = v[k] * g[k] + o[k];
            store8_bf16(mrg + (size_t)row * D + col0, v); });
    }
};
struct EpiOut {
    static constexpr bool PERM = true;
    const float* x; const float* mod; const float* bada; unsigned char* ws;
    DI void operator()(const f32x4 (&acc)[2][2][4][2], const pg8::Unit& un, int wr, int wc, int fr, int fq) const {
        epi_foreach(acc, un, wr, wc, fr, fq, [&](int row, int col0, float (&v)[8]) {
            const int b = row >> 14;
            const float* gp = mod + b * NMOD + 2 * D + col0;
            const f32x4 g0 = *(const f32x4*)gp, g1 = *(const f32x4*)(gp + 4);
            const f32x4 x0 = *(const f32x4*)(x + (size_t)row * D + col0), x1 = *(const f32x4*)(x + (size_t)row * D + col0 + 4);
            f32x4 r0, r1;
#pragma unroll
            for (int k = 0; k < 4; ++k) { r0[k] = x0[k] + g0[k] * v[k]; r1[k] = x1[k] + g1[k] * v[4 + k]; }
            *(u32x4*)(x1b_row(ws, row) + col0) = (u32x4){pk2(r0[0], r0[1]), pk2(r0[2], r0[3]), pk2(r1[0], r1[1]), pk2(r1[2], r1[3])}; });
    }
};


constexpr size_t WS_PUS = 112 * MiB, WS_PVS = 112 * MiB + 512 * 1024;
constexpr int ROWB = 1536;
typedef float f32x2 __attribute__((ext_vector_type(2)));
typedef float v16f __attribute__((ext_vector_type(16)));
typedef float v32f __attribute__((ext_vector_type(32)));
typedef unsigned v6u __attribute__((ext_vector_type(6)));
typedef unsigned v16u __attribute__((ext_vector_type(16)));
typedef __bf16 v32bf __attribute__((ext_vector_type(32)));
DI v32f fp6_unpack_f32(const v6u w) { v32f r; asm volatile("s_nop 1\n\tv_cvt_scalef32_pk32_f32_fp6 %0, %1, 1.0\n\ts_nop 15" : "=&v"(r) : "v"(w)); return r; }
DI v16u fp6_unpack_bf16(const v6u w) { v16u r; asm volatile("s_nop 1\n\tv_cvt_scalef32_pk32_bf16_fp6 %0, %1, 1.0\n\ts_nop 15" : "=&v"(r) : "v"(w)); return r; }

DI unsigned fp6_code(float x) {
    const float a = fminf(fabsf(x), 7.5f);
    const float c = a < 2.0f ? a * 8.0f : (a < 4.0f ? 8.0f + a * 4.0f : 16.0f + a * 2.0f);
    const unsigned q = (unsigned)__builtin_rintf(c);
    return q | ((__float_as_uint(x) >> 31) << 5);
}
DI v6u fp6_pack_sw(const float (&e)[32]) {
    unsigned long long lo = 0, mid = 0, hi = 0;
#pragma unroll
    for (int i = 0; i < 32; ++i) {
        const unsigned long long c = fp6_code(e[i]);
        const int bit = 6 * i;
        if (bit < 64) { lo |= c << bit; if (bit > 58) mid |= c >> (64 - bit); }
        else if (bit < 128) { mid |= c << (bit - 64); if (bit > 122) hi |= c >> (128 - bit); }
        else hi |= c << (bit - 128);
    }
    v6u w; w[0] = (unsigned)lo; w[1] = (unsigned)(lo >> 32); w[2] = (unsigned)mid; w[3] = (unsigned)(mid >> 32); w[4] = (unsigned)hi; w[5] = (unsigned)(hi >> 32);
    return w;
}
DI void fp6_row_convert(const float* src, unsigned char* dst, float* inv_scale, int lane) {
    f32x4 v[8]; float mx = 0.f;
#pragma unroll
    for (int q = 0; q < 8; ++q) { v[q] = *(const f32x4*)(src + 32 * lane + 4 * q);
        mx = fmaxf(mx, fmaxf(fmaxf(fabsf(v[q].x), fabsf(v[q].y)), fmaxf(fabsf(v[q].z), fabsf(v[q].w)))); }
#pragma unroll
    for (int o = 1; o < 64; o <<= 1) mx = fmaxf(mx, __shfl_xor(mx, o));
    int ex = 1; if (mx > 0.f) (void)frexpf(7.5f / mx, &ex);
    const float S = ldexpf(1.0f, ex - 1);
    float el[32];
#pragma unroll
    for (int q = 0; q < 8; ++q) { el[4 * q] = v[q].x * S; el[4 * q + 1] = v[q].y * S; el[4 * q + 2] = v[q].z * S; el[4 * q + 3] = v[q].w * S; }
    const v6u w = fp6_pack_sw(el);
    *(u32x4*)(dst + 16 * lane) = (u32x4){w[0], w[1], w[2], w[3]};
    *(u32x2*)(dst + 1024 + 8 * lane) = (u32x2){w[4], w[5]};
    if (lane == 0) *inv_scale = 1.0f / S;
}
DI v6u fp6_load(const unsigned char* row, int lane) {
    const u32x4 a_ = *(const u32x4*)(row + 16 * lane); const u32x2 b_ = *(const u32x2*)(row + 1024 + 8 * lane);
    v6u w; w[0] = a_[0]; w[1] = a_[1]; w[2] = a_[2]; w[3] = a_[3]; w[4] = b_[0]; w[5] = b_[1]; return w;
}
DI float fp6_at(const unsigned char* row, int k) {
    const v6u w = fp6_load(row, k >> 5);
    const v32f r = fp6_unpack_f32(w);
    float o = 0.f;
#pragma unroll
    for (int i = 0; i < 32; ++i) o = ((k & 31) == i) ? r[i] : o;
    return o;
}


#ifndef TAB4
#define TAB4 1
#endif
#ifndef P10_SLICED
#define P10_SLICED 1
#endif
#ifndef XTRA
#define XTRA 0
#endif
#ifndef DUP
#define DUP 0
#endif
constexpr int ROWB4 = 1024;
constexpr size_t WS_PUE = 177 * MiB, WS_PVE = 178 * MiB;
DI unsigned fp4_idx(float a) { return (unsigned)(a > 0.25f) + (unsigned)(a > 0.75f) + (unsigned)(a > 1.25f) + (unsigned)(a > 1.75f) + (unsigned)(a > 2.5f) + (unsigned)(a > 3.5f) + (unsigned)(a > 5.0f); }
DI void row_load32(const float* src, int lane, f32x4 (&v)[8]) {
#pragma unroll
    for (int q = 0; q < 8; ++q) v[q] = *(const f32x4*)(src + 32 * lane + 4 * q);
}
DI void fp4_row_pack(const f32x4 (&v)[8], unsigned char* dst, unsigned char* sdst, int lane) {
    float mx = 0.f;
#pragma unroll
    for (int q = 0; q < 8; ++q) mx = fmaxf(mx, fmaxf(fmaxf(fabsf(v[q].x), fabsf(v[q].y)), fmaxf(fabsf(v[q].z), fabsf(v[q].w))));
    int ex = 1; if (mx > 0.f) (void)frexpf(6.0f / mx, &ex);
    int lg = ex - 1; lg = lg < -100 ? -100 : (lg > 100 ? 100 : lg);
    const float S = ldexpf(1.0f, lg);
    unsigned w[4];
#pragma unroll
    for (int d = 0; d < 4; ++d) {
        unsigned acc = 0u;
#pragma unroll
        for (int e = 0; e < 8; ++e) { const int i = 8 * d + e; const float x = v[i >> 2][i & 3];
            acc |= (fp4_idx(fabsf(x) * S) | ((__float_as_uint(x) >> 31) << 3)) << (4 * e); }
        w[d] = acc;
    }
    *(u32x4*)(dst + 16 * lane) = (u32x4){w[0], w[1], w[2], w[3]};
    sdst[lane] = (unsigned char)(127 - lg);
}
DI void fp4_unpack8(const unsigned w, f32x2 (&r)[4]) {
    r[0] = __builtin_amdgcn_cvt_scalef32_pk_f32_fp4(w, 1.0f, 0); r[1] = __builtin_amdgcn_cvt_scalef32_pk_f32_fp4(w, 1.0f, 1);
    r[2] = __builtin_amdgcn_cvt_scalef32_pk_f32_fp4(w, 1.0f, 2); r[3] = __builtin_amdgcn_cvt_scalef32_pk_f32_fp4(w, 1.0f, 3);
}
DI float fp4_at(const unsigned char* row, const unsigned char* srow, int k) {
    const unsigned w = ((const unsigned*)row)[k >> 3]; f32x2 r[4]; fp4_unpack8(w, r);
    const int e = k & 7; float o = 0.f;
#pragma unroll
    for (int z = 0; z < 4; ++z) o = ((e >> 1) == z) ? ((e & 1) ? r[z][1] : r[z][0]) : o;
    return o * __uint_as_float((unsigned)srow[k >> 5] << 23);
}

#ifndef U4
#define U4 1
#endif
constexpr size_t WS_PUS4 = 80 * MiB;
constexpr size_t WS_H4 = WS_HB;
constexpr size_t WS_HS = WS_HB + 96 * MiB;
DI float u4_step(int code) { return exp2f((float)(code - 208) * 0.0625f); }
DI void int4_row_pack(const f32x4 (&v)[8], unsigned char* dst, unsigned char* sdst, int lane) {
    float mx = 0.f;
#pragma unroll
    for (int q = 0; q < 8; ++q) mx = fmaxf(mx, fmaxf(fmaxf(fabsf(v[q].x), fabsf(v[q].y)), fmaxf(fabsf(v[q].z), fabsf(v[q].w))));
    int code = 0;
    if (mx > 0.f) { code = (int)ceilf(16.0f * log2f(mx * (1.0f / 7.0f))) + 208; code = code < 0 ? 0 : (code > 255 ? 255 : code); }
    const float S = 1.0f / u4_step(code);
    unsigned w[4];
#pragma unroll
    for (int d = 0; d < 4; ++d) {
        unsigned acc = 0u;
#pragma unroll
        for (int e = 0; e < 8; ++e) { const int i = 8 * d + e; const float x = v[i >> 2][i & 3];
            int q = (int)rintf(x * S); q = q < -7 ? -7 : (q > 7 ? 7 : q);
            acc |= ((unsigned)q & 15u) << (4 * e); }
        w[d] = acc;
    }
    *(u32x4*)(dst + 16 * lane) = (u32x4){w[0], w[1], w[2], w[3]};
    sdst[lane] = (unsigned char)code;
}
DI void transpose_item(const float* W, int ldw, int src_n0, bf16_t* WT, int K, int dst_n0, int k0, LAS float* scr, int lane) {
#pragma unroll
    for (int i = 0; i < 32; ++i) { const int kk = 2 * i + (lane >> 5); scr[kk * 33 + (lane & 31)] = W[(size_t)(k0 + kk) * ldw + src_n0 + (lane & 31)]; }
    LDS_WAIT();
    const int c = lane & 7;
#pragma unroll
    for (int j = 0; j < 4; ++j) { const int n = (lane >> 3) + 8 * j; const LAS float* s = scr + (8 * c) * 33 + n;
        u32x4 o; o.x = pk2(s[0 * 33], s[1 * 33]); o.y = pk2(s[2 * 33], s[3 * 33]); o.z = pk2(s[4 * 33], s[5 * 33]); o.w = pk2(s[6 * 33], s[7 * 33]);
        *(u32x4*)(WT + (size_t)(dst_n0 + n) * K + k0 + 8 * c) = o; }
    LDS_WAIT();
}
DI void convert_stream(const float* src, bf16_t* dst, size_t n, size_t gthread, size_t nthreads) {
    for (size_t i = gthread * 8; i < n; i += nthreads * 8) {
        const f32x4 a = *(const f32x4*)(src + i), b = *(const f32x4*)(src + i + 4);
        u32x4 o; o.x = pk2(a.x, a.y); o.y = pk2(a.z, a.w); o.z = pk2(b.x, b.y); o.w = pk2(b.z, b.w);
        *(u32x4*)(dst + i) = o;
    }
}
DI void phase0(const Args& a, LAS unsigned char* lds) {
    const int tid = otid(), lane = tid & 63, wave = tid >> 6, G = gridDim.x, blk = blockIdx.x;
    unsigned char* ws = a.ws;
    {
        LAS float* sc = (LAS float*)lds;
        LAS float* red = (LAS float*)(lds + 16384);
        float* mod = (float*)(ws + WS_CTL) + CW_MOD;
        if (blk < 192) {
            for (int i = tid; i < 2 * D; i += NTHREADS) sc[i] = siluf_(a.c[i]);
            __syncthreads();
            for (int it = blk; it < 192; it += G) {
                const int cq = tid & 15, kg = tid >> 4;
                const float* wp = a.w_ada + (size_t)(kg * 64) * NMOD + it * 64 + 4 * cq;
                f32x4 a0 = (f32x4){0.f, 0.f, 0.f, 0.f}, a1 = a0;
#pragma unroll 16
                for (int kk = 0; kk < 64; ++kk) { const f32x4 w = *(const f32x4*)(wp + (size_t)kk * NMOD); a0 += w * sc[kg * 64 + kk]; a1 += w * sc[D + kg * 64 + kk]; }
                *(LAS f32x4*)(red + (kg * 2 + 0) * 64 + 4 * cq) = a0; *(LAS f32x4*)(red + (kg * 2 + 1) * 64 + 4 * cq) = a1;
                __syncthreads();
                if (tid < 128) { const int b = tid >> 6, c = tid & 63; float s = 0.f;
#pragma unroll
                    for (int q = 0; q < 32; ++q) s += red[(q * 2 + b) * 64 + c];
                    mod[b * NMOD + it * 64 + c] = s + a.b_ada[it * 64 + c]; }
                __syncthreads();
            }
        }
        __syncthreads();
    }
    LAS float* scr = (LAS float*)(lds + wave * 16384);
    const int gw = blk * NWAVES + wave, NGW = G * NWAVES;
    constexpr int I_IN = 32 * 240, I_GLU = 8 * 16, I_SSM = 8 * 64, I_ATT = 16 * 64, I_OUT = 32 * 64, I_PQ = 32 * 64;
    constexpr int NIT = I_IN + I_GLU + I_SSM + I_ATT + I_OUT + I_PQ;
    for (int it = gw; it < NIT; it += NGW) {
        int r = it;
        if (r < I_IN) { const int kb = r / 240, nb = r % 240, n0 = nb * 32; transpose_item(a.w_in, INW, n0 + (n0 >= 3072 ? 8 : 0), (bf16_t*)(ws + WS_WIN), D, n0, kb * 64, scr, lane); continue; } r -= I_IN;
        if (r < I_GLU) { const int kb = r / 16, nb = r % 16; transpose_item(a.w_glu, SW, nb * 32, (bf16_t*)(ws + WS_WGLU), SW, nb * 32, kb * 64, scr, lane); continue; } r -= I_GLU;
        if (r < I_SSM) { const int kb = r / 64, nb = r % 64; transpose_item(a.w_ssm_up, D, nb * 32, (bf16_t*)(ws + WS_WSSM), SW, nb * 32, kb * 64, scr, lane); continue; } r -= I_SSM;
        if (r < I_ATT) { const int kb = r / 64, nb = r % 64; transpose_item(a.w_attn_up, D, nb * 32, (bf16_t*)(ws + WS_WATTN), AW, nb * 32, kb * 64, scr, lane); continue; } r -= I_ATT;
        if (r < I_OUT) { const int kb = r / 64, nb = r % 64; transpose_item(a.w_out, D, nb * 32, (bf16_t*)(ws + WS_WOUT), D, nb * 32, kb * 64, scr, lane); continue; } r -= I_OUT;
        { const int kb = r / 64, nb = r % 64; transpose_item(a.w_peer_q, D, nb * 32, (bf16_t*)(ws + WS_WPQ), D, nb * 32, kb * 64, scr, lane); }
    }
    {
        float* wf = (float*)(ws + WS_WF);
        for (int i = blk * NTHREADS + tid; i < 8 * D; i += G * NTHREADS) { const int j = i >> 11, k = i & 2047; wf[i] = a.w_in[(size_t)k * INW + 3072 + j]; }
    }
    const size_t gt = (size_t)blk * NTHREADS + tid, nthr = (size_t)G * NTHREADS;
    convert_stream(a.sub_keys, (bf16_t*)(ws + WS_KEYS), (size_t)16 * 128 * 128, gt, nthr);
    {
        constexpr int NCH = 2 * NEXP / 16;
        const int ntrip = 2 * ((NCH + G - 1) / G);
        f32x4 cur[8], nxt[8];
        {   const int r0 = 16 * blk + 2 * wave;
            if (blk < NCH) row_load32((r0 >= NEXP ? a.peer_v : a.peer_u) + (size_t)(r0 & (NEXP - 1)) * D, lane, cur); }
        for (int rr = 0; rr < ntrip; ++rr) {
            const int ch = blk + (rr >> 1) * G, r = 16 * ch + 2 * wave + (rr & 1);
            if (ch >= NCH) break;
            {   const int chn = blk + ((rr + 1) >> 1) * G, rn0 = 16 * chn + 2 * wave + ((rr + 1) & 1), rn = (rr + 1 < ntrip && chn < NCH) ? rn0 : r;
                row_load32((rn >= NEXP ? a.peer_v : a.peer_u) + (size_t)(rn & (NEXP - 1)) * D, lane, nxt); }
            const int tb = r >= NEXP, e = r - tb * NEXP;
            unsigned char* sd = ws + (tb ? WS_PVE : WS_PUS4) + (size_t)(lane >> 3) * (NEXP * 8) + (size_t)e * 8 + (lane & 7) - lane;
            if (!tb) int4_row_pack(cur, ws + WS_PU + (size_t)e * ROWB4, sd, lane);
            else fp4_row_pack(cur, ws + WS_PV + (size_t)e * ROWB4, sd, lane);
#pragma unroll
            for (int q = 0; q < 8; ++q) cur[q] = nxt[q];
        }
    }
}


DI int affine_row(int blk, int wave, int i, int G) {
    if (G == 256) return 4096 * (blk & 7) + 128 * (blk >> 3) + 16 * wave + i;
    return (blk * NWAVES + wave) + i * (G * NWAVES);
}
template <bool WITH_F, bool XBF = false>
DI void row_pass(const Args& a, LAS unsigned char* lds, const float* xin, const float* normw, int shift_idx, int scale_idx, bf16_t* hb) {
    const int tid = otid(), lane = tid & 63, wave = tid >> 6, G = gridDim.x, blk = blockIdx.x;
    const float* mod = (const float*)(a.ws + WS_CTL) + CW_MOD;
    LAS f32x4* wfl = (LAS f32x4*)lds;
    if (WITH_F) {
        const f32x4* wf = (const f32x4*)(a.ws + WS_WF);
        for (int i = tid; i < 8 * 512; i += NTHREADS) wfl[i] = wf[i];
        __syncthreads();
    }
    const int gw = blk * NWAVES + wave, NGW = G * NWAVES;
    int curb = -1;
    f32x4 gg[8], sh[8], vn[8];
    (void)gw;
    {   const int m0 = affine_row(blk, wave, 0, G);
        if (m0 < T) {
            if (XBF) { const u32x2* xr = (const u32x2*)x1b_row(a.ws, m0) + lane;
#pragma unroll
                for (int j = 0; j < 8; ++j) { const u32x2 w = xr[64 * j]; vn[j] = (f32x4){bflo(w.x), bfhi(w.x), bflo(w.y), bfhi(w.y)}; } }
            else { const f32x4* xr = (const f32x4*)(xin + (size_t)m0 * D) + lane;
#pragma unroll
                for (int j = 0; j < 8; ++j) vn[j] = xr[64 * j]; } } }
    for (int ri = 0; ri < (T + NGW - 1) / NGW; ++ri) {
        const int m = affine_row(blk, wave, ri, G);
        if (m >= T) break;
        const int b = m >> 14;
        if (b != curb) {
            curb = b;
#pragma unroll
            for (int j = 0; j < 8; ++j) {
                const int e = 4 * (lane + 64 * j);
                const f32x4 nw = *(const f32x4*)(normw + e);
                const f32x4 sc = *(const f32x4*)(mod + b * NMOD + scale_idx * D + e);
                sh[j] = *(const f32x4*)(mod + b * NMOD + shift_idx * D + e);
                gg[j] = nw * (sc + 1.0f);
            }
        }
        f32x4 v[8]; float ss = 0.f;
#pragma unroll
        for (int j = 0; j < 8; ++j) { v[j] = vn[j]; ss += (v[j].x * v[j].x + v[j].y * v[j].y) + (v[j].z * v[j].z + v[j].w * v[j].w); }
        {
            const int mn0 = (ri + 1 < (T + NGW - 1) / NGW) ? affine_row(blk, wave, ri + 1, G) : m, mn = mn0 < T ? mn0 : m;
            if (XBF) { const u32x2* xr = (const u32x2*)x1b_row(a.ws, mn) + lane;
#pragma unroll
                for (int j = 0; j < 8; ++j) { const u32x2 w = xr[64 * j]; vn[j] = (f32x4){bflo(w.x), bfhi(w.x), bflo(w.y), bfhi(w.y)}; } }
            else { const f32x4* xr = (const f32x4*)(xin + (size_t)mn * D) + lane;
#pragma unroll
                for (int j = 0; j < 8; ++j) vn[j] = xr[64 * j]; }
        }
        const float r = rsqrtf(wave_sum(ss) * (1.0f / D) + RMS_EPS);
#pragma unroll
        for (int j = 0; j < 8; ++j) v[j] = v[j] * r * gg[j] + sh[j];
        u32x2* o = (u32x2*)(hb + (size_t)m * D) + lane;
#pragma unroll
        for (int j = 0; j < 8; ++j) { u32x2 w; w.x = pk2(v[j].x, v[j].y); w.y = pk2(v[j].z, v[j].w); o[64 * j] = w; }
        if (WITH_F) {
            float mine = 0.f;
#pragma unroll 1
            for (int q = 0; q < 8; q += 4) {
                float s0 = 0.f, s1 = 0.f, s2 = 0.f, s3 = 0.f;
#pragma unroll
                for (int j = 0; j < 8; ++j) {
                    const f32x4 w0 = wfl[q * 512 + lane + 64 * j], w1 = wfl[(q + 1) * 512 + lane + 64 * j], w2 = wfl[(q + 2) * 512 + lane + 64 * j], w3 = wfl[(q + 3) * 512 + lane + 64 * j];
                    s0 += (v[j].x * w0.x + v[j].y * w0.y) + (v[j].z * w0.z + v[j].w * w0.w); s1 += (v[j].x * w1.x + v[j].y * w1.y) + (v[j].z * w1.z + v[j].w * w1.w);
                    s2 += (v[j].x * w2.x + v[j].y * w2.y) + (v[j].z * w2.z + v[j].w * w2.w); s3 += (v[j].x * w3.x + v[j].y * w3.y) + (v[j].z * w3.z + v[j].w * w3.w); }
                s0 = wave_sum(s0); s1 = wave_sum(s1); s2 = wave_sum(s2); s3 = wave_sum(s3);
                mine = (lane == q) ? s0 : mine; mine = (lane == q + 1) ? s1 : mine; mine = (lane == q + 2) ? s2 : mine; mine = (lane == q + 3) ? s3 : mine;
            }
            if (lane < 8) {
                const float z = mine + a.b_forget[lane];
                const float ls = fminf(z, 0.f) - log1pf(__expf(-fabsf(z)));
                ((float*)(a.ws + WS_LF))[(size_t)m * 8 + lane] = ls;
            }
        }
    }
}


constexpr size_t WS_VT = 113 * MiB;
constexpr size_t WS_DBGS = 928 * MiB;
DI void phase2b(const Args& a, LAS unsigned char* lds) {
    const int tid = otid(), lane = tid & 63, wave = tid >> 6, G = gridDim.x, blk = blockIdx.x;
    const int gw = blk * NWAVES + wave, NGW = G * NWAVES;
    bf16_t* qkv = (bf16_t*)(a.ws + WS_QKV);
    if (gw < NB * AH * 8) {
        const int bh = gw >> 3, seg = gw & 7, b = bh >> 3, h = bh & 7;
        const float* lf = (const float*)(a.ws + WS_LF);
        float* F = (float*)(a.ws + WS_F) + (size_t)bh * SEQ + seg * 2048;
        double carry = 0.0;
        float xv[32];
#pragma unroll
        for (int c = 0; c < 32; ++c) xv[c] = lf[((size_t)b * SEQ + seg * 2048 + c * 64 + lane) * 8 + h];
#pragma unroll
        for (int c = 0; c < 32; ++c) {
            double x = (double)xv[c];
#pragma unroll
            for (int o = 1; o < 64; o <<= 1) { const double t = __shfl_up(x, o); if (lane >= o) x += t; }
            F[c * 64 + lane] = (float)((carry + x) * 1.4426950408889634);
            carry += __shfl(x, 63);
        }
        if (lane == 0) ((float*)(a.ws + WS_CTL) + CW_SEGT)[gw] = (float)(carry * 1.4426950408889634);
    }
    {
        const int head = lane >> 3, d0 = (lane & 7) * 16;
        float wq[16], wk[16];
        const float QS = 0.08838834764831845f * LOG2E;
#pragma unroll
        for (int i = 0; i < 16; ++i) { wq[i] = a.q_norm_w[d0 + i] * QS; wk[i] = a.k_norm_w[d0 + i]; }
        for (int ri = 0; ri < (T + NGW - 1) / NGW; ++ri) {
            const int m = affine_row(blk, wave, ri, G);
            if (m >= T) break;
            bf16_t* row = qkv + (size_t)m * 3072 + head * 128 + d0;
#pragma unroll
            for (int qk = 0; qk < 2; ++qk) {
                bf16_t* p = row + qk * 1024;
                float v[16]; float va[8], vb[8];
                load8_bf16(p, va); load8_bf16(p + 8, vb);
#pragma unroll
                for (int i = 0; i < 8; ++i) { v[i] = va[i]; v[8 + i] = vb[i]; }
                float ss = 0.f;
#pragma unroll
                for (int i = 0; i < 16; ++i) ss += v[i] * v[i];
                ss += __shfl_xor(ss, 1); ss += __shfl_xor(ss, 2); ss += __shfl_xor(ss, 4);
                const float r = rsqrtf(ss * (1.0f / HD) + RMS_EPS);
#pragma unroll
                for (int i = 0; i < 8; ++i) { va[i] = v[i] * r * (qk ? wk[i] : wq[i]); vb[i] = v[8 + i] * r * (qk ? wk[8 + i] : wq[8 + i]); }
                store8_bf16(p, va); store8_bf16(p + 8, vb);
            }
        }
    }
    {
        LAS unsigned char* tile = lds + wave * 17408;
        bf16_t* vt = (bf16_t*)(a.ws + WS_VT);
        for (int it = gw; it < NB * AH * (SEQ / 64); it += NGW) {
            const int b = it / (AH * 256), h = (it / 256) % AH, c = it % 256;
            const size_t m0 = (size_t)b * SEQ + c * 64;
#pragma unroll 4
            for (int i = 0; i < 16; ++i) { const int row = 4 * i + (lane >> 4), ch = lane & 15;
                const u32x4 v = *(const u32x4*)(qkv + (m0 + row) * 3072 + 2048 + h * 128 + ch * 8);
                *(LAS u32x4*)(tile + row * 272 + ch * 16) = v; }
            LDS_WAIT();
#pragma unroll 1
            for (int dd = 0; dd < 2; ++dd) {
                const int d = lane + 64 * dd;
                bf16_t* dst = vt + (((size_t)(b * AH + h) * (SEQ / 64) + c) * HD + d) * 64;
#pragma unroll
                for (int g4 = 0; g4 < 4; ++g4) {
                    unsigned w[8];
#pragma unroll
                    for (int pp = 0; pp < 8; ++pp) {
                        const int p0 = 2 * pp, p1 = 2 * pp + 1;
                        const int k0 = 8 * ((p0 >> 2) & 1) + 4 * (p0 >> 3) + (p0 & 3), k1 = 8 * ((p1 >> 2) & 1) + 4 * (p1 >> 3) + (p1 & 3);
                        const unsigned lo = *(const LAS unsigned short*)(tile + (g4 * 16 + k0) * 272 + d * 2);
                        const unsigned hi = *(const LAS unsigned short*)(tile + (g4 * 16 + k1) * 272 + d * 2);
                        w[pp] = lo | (hi << 16);
                    }
                    *(u32x4*)(dst + g4 * 16) = (u32x4){w[0], w[1], w[2], w[3]};
                    *(u32x4*)(dst + g4 * 16 + 8) = (u32x4){w[4], w[5], w[6], w[7]};
                }
            }
            LDS_WAIT();
        }
    }
}

DI void attn_item(const Args& a, LAS unsigned char* lds, int b, int h, int qb, float thr2) {
    const int tid = otid(), lane = tid & 63, wave = __builtin_amdgcn_readfirstlane(tid >> 6), q = lane & 31, hh = lane >> 5;
    const bf16_t* qkv = (const bf16_t*)(a.ws + WS_QKV);
    const bf16_t* vt = (const bf16_t*)(a.ws + WS_VT) + (size_t)(b * AH + h) * HD * SEQ;
    const float* Floc = (const float*)(a.ws + WS_F) + (size_t)(b * AH + h) * SEQ;
    LAS float* offl = (LAS float*)(lds + 33024);
    if (tid < 8) { const float* st = (const float*)(a.ws + WS_CTL) + CW_SEGT + (b * AH + h) * 8; float s = 0.f; for (int i = 0; i < tid; ++i) s += st[i]; offl[tid] = s; }
    __syncthreads();
    auto F = [&](int i) -> float { return Floc[i] + offl[i >> 11]; };
    const int t0 = qb * 256, tw0 = t0 + 32 * wave, t = tw0 + q;
    const size_t mrow = (size_t)b * SEQ;
    LAS unsigned char* Kl = lds; LAS unsigned char* Vl = lds + 16384; LAS float* Fl = (LAS float*)(lds + 32768);
    int j0;
    {
        const float Ft0 = F(t0); const int jd = t0 / 64; int need = 0;
        for (int k = 0; k < 4; ++k) {
            const int jj = jd - 1 - (64 * k + lane);
            const bool nd = (jj >= 0) && (Ft0 - F(jj >= 0 ? 64 * jj + 63 : 0) > -thr2);
            const unsigned long long bal = __ballot(nd);
            need += __popcll(bal);
            if (bal != ~0ull) break;
        }
        j0 = jd - need;
    }
    const int jend = t0 / 64 + 3;
    bf16x8 qf[8];
#pragma unroll
    for (int ks = 0; ks < 8; ++ks) qf[ks] = *(const bf16x8*)(qkv + (mrow + t) * 3072 + h * 128 + ks * 16 + hh * 8);
    const float Fq = F(t);
    f32x16 o[4];
#pragma unroll
    for (int i = 0; i < 4; ++i)
#pragma unroll
        for (int r = 0; r < 16; ++r) o[i][r] = 0.f;
    float mrun = -1e30f, lrun = 0.f;
    u32x4 kreg[2], vreg[2]; float freg = 0.f;
    auto issue = [&](int j) {
#pragma unroll
        for (int i = 0; i < 2; ++i) { const int idx = tid + 512 * i;
            kreg[i] = *(const u32x4*)(qkv + (mrow + 64 * j + (idx >> 4)) * 3072 + 1024 + h * 128 + (idx & 15) * 8);
            vreg[i] = *(const u32x4*)(vt + (size_t)j * (HD * 64) + (size_t)idx * 8); }
        if (tid < 64) freg = F(64 * j + tid);
    };
    auto commit = [&]() {
#pragma unroll
        for (int i = 0; i < 2; ++i) { const int idx = tid + 512 * i;
            { const int r = idx >> 4, ch = idx & 15; *(LAS u32x4*)(Kl + r * 256 + ((ch ^ (r & 15)) << 4)) = kreg[i]; }
            { const int d = idx >> 3, ch = idx & 7; *(LAS u32x4*)(Vl + d * 128 + ((ch ^ ((d >> 1) & 7)) << 4)) = vreg[i]; } }
        if (tid < 64) Fl[tid] = freg;
    };
    issue(j0);
    for (int j = j0; j <= jend; ++j) {
        __syncthreads();
        commit();
        __syncthreads();
        if (j < jend) issue(j + 1);
        if (64 * j <= tw0 + 31) {
            f32x16 sacc[2];
#pragma unroll
            for (int rb = 0; rb < 2; ++rb) {
#pragma unroll
                for (int r = 0; r < 16; ++r) sacc[rb][r] = 0.f;
#pragma unroll
                for (int ks = 0; ks < 8; ++ks) {
                    const int r = rb * 32 + q, ch = ks * 2 + hh;
                    const bf16x8 kf = *(const LAS bf16x8*)(Kl + r * 256 + ((ch ^ (r & 15)) << 4));
                    sacc[rb] = __builtin_amdgcn_mfma_f32_32x32x16_bf16(kf, qf[ks], sacc[rb], 0, 0, 0);
                }
            }
            const bool diag = (64 * j + 63 > tw0);
            float mx = -1e30f;
#pragma unroll
            for (int rb = 0; rb < 2; ++rb)
#pragma unroll
                for (int g4 = 0; g4 < 4; ++g4) {
                    const f32x4 fs = *(const LAS f32x4*)(Fl + rb * 32 + 8 * g4 + 4 * hh);
#pragma unroll
                    for (int i = 0; i < 4; ++i) {
                        const int reg = 4 * g4 + i;
                        float s = sacc[rb][reg] + (Fq - fs[i]);
                        if (diag) { const int key = 64 * j + rb * 32 + 8 * g4 + 4 * hh + i; s = (key > t) ? -1e30f : s; }
                        sacc[rb][reg] = s; mx = fmaxf(mx, s);
                    }
                }
            mx = fmaxf(mx, __shfl_xor(mx, 32));
            if (__ballot(mx > mrun + 8.0f) != 0ull) {
                const float mnew = fmaxf(mrun, mx);
                const float alpha = __builtin_amdgcn_exp2f(mrun - mnew);
                mrun = mnew;
                lrun *= alpha;
#pragma unroll
                for (int i = 0; i < 4; ++i)
#pragma unroll
                    for (int r = 0; r < 16; ++r) o[i][r] *= alpha;
            }
            float ps = 0.f;
#pragma unroll
            for (int rb = 0; rb < 2; ++rb)
#pragma unroll
                for (int r = 0; r < 16; ++r) { const float p = __builtin_amdgcn_exp2f(sacc[rb][r] - mrun); sacc[rb][r] = p; ps += p; }
            lrun += ps;
#pragma unroll
            for (int rb = 0; rb < 2; ++rb)
#pragma unroll
                for (int s2 = 0; s2 < 2; ++s2) {
                    u32x4 pw; pw.x = pk2(sacc[rb][8 * s2 + 0], sacc[rb][8 * s2 + 1]); pw.y = pk2(sacc[rb][8 * s2 + 2], sacc[rb][8 * s2 + 3]);
                    pw.z = pk2(sacc[rb][8 * s2 + 4], sacc[rb][8 * s2 + 5]); pw.w = pk2(sacc[rb][8 * s2 + 6], sacc[rb][8 * s2 + 7]);
                    const bf16x8 pf = __builtin_bit_cast(bf16x8, pw);
                    const int ch = rb * 4 + s2 * 2 + hh;
#pragma unroll
                    for (int db = 0; db < 4; ++db) {
                        const int d = db * 32 + q;
                        const bf16x8 vf = *(const LAS bf16x8*)(Vl + d * 128 + ((ch ^ ((d >> 1) & 7)) << 4));
                        o[db] = __builtin_amdgcn_mfma_f32_32x32x16_bf16(vf, pf, o[db], 0, 0, 0);
                    }
                }
        }
    }
    const float ltot = lrun + __shfl_xor(lrun, 32);
    const float inv = 1.0f / ltot;
    bf16_t* yo = (bf16_t*)(a.ws + WS_YATT) + (mrow + t) * AW + h * 128;
#pragma unroll
    for (int db = 0; db < 4; ++db)
#pragma unroll
        for (int g4 = 0; g4 < 4; ++g4) {
            u32x2 w; w.x = pk2(o[db][4 * g4] * inv, o[db][4 * g4 + 1] * inv); w.y = pk2(o[db][4 * g4 + 2] * inv, o[db][4 * g4 + 3] * inv);
            *(u32x2*)(yo + db * 32 + 8 * g4 + 4 * hh) = w;
        }
    __syncthreads();
}


constexpr size_t WS_S5POW = WS_S5TAB;
constexpr size_t WS_S5BB = WS_S5TAB + 512 * 1024;
constexpr size_t WS_S5Q = WS_S5TAB + 1 * MiB;
constexpr size_t WS_S5P = WS_S5TAB + 3 * MiB;
constexpr size_t WS_S5K = WS_S5TAB + 5 * MiB;
DI void s5_tables_p0(const Args& a) {
    const int gt = blockIdx.x * NTHREADS + otid();
    if (gt >= SGRP * SST) return;
    const int g = gt >> 6, p = gt & 63;
    const float lre = a.A_re[g * SST + p], lim = a.A_im[g * SST + p], dt = expf(a.log_dt[g]);
    const float mag = expf(lre * dt), abr = mag * cosf(lim * dt), abi = mag * sinf(lim * dt);
    const float den = lre * lre + lim * lim, nr = abr - 1.0f;
    const float cr = (nr * lre + abi * lim) / den, ci = (abi * lre - nr * lim) / den;
    float* pw = (float*)(a.ws + WS_S5POW) + (size_t)gt * 34;
    double pr = 1.0, pi = 0.0;
    for (int n = 0; n <= 16; ++n) { pw[2 * n] = (float)pr; pw[2 * n + 1] = (float)pi; const double t = pr * abr - pi * abi; pi = pr * abi + pi * abr; pr = t; }
    float* bb = (float*)(a.ws + WS_S5BB) + (size_t)gt * 32;
    for (int c = 0; c < 16; ++c) { const float br = a.B_re[(g * SST + p) * SCH + c], bi = a.B_im[(g * SST + p) * SCH + c];
        bb[2 * c] = cr * br - ci * bi; bb[2 * c + 1] = cr * bi + ci * br; }
}
DI void s5_tables_p1(const Args& a) {
    const size_t gt0 = (size_t)blockIdx.x * NTHREADS + otid(), nthr = (size_t)gridDim.x * NTHREADS;
    const float* POW = (const float*)(a.ws + WS_S5POW); const float* BB = (const float*)(a.ws + WS_S5BB);
    bf16_t* Qt = (bf16_t*)(a.ws + WS_S5Q); bf16_t* Pt = (bf16_t*)(a.ws + WS_S5P); bf16_t* Kt = (bf16_t*)(a.ws + WS_S5K);
    for (size_t i = gt0; i < (size_t)SGRP * 16 * 128 * 16; i += nthr) {
        {
            const int c = i & 15, pp = (i >> 4) & 127, j = (i >> 11) & 15, g = (int)(i >> 15), p = pp & 63;
            const float* pw = POW + ((size_t)(g * SST + p) * 17 + (15 - j)) * 2; const float* bb = BB + ((size_t)(g * SST + p) * 16 + c) * 2;
            const float re = pw[0] * bb[0] - pw[1] * bb[1], im = pw[0] * bb[1] + pw[1] * bb[0];
            Qt[i] = (bf16_t)(pk2(pp < 64 ? re : im, 0.f) & 0xffffu);
        }
        {
            const int pp = i & 127, c = (i >> 7) & 15, t = (i >> 11) & 15, g = (int)(i >> 15), p = pp & 63;
            const float* pw = POW + ((size_t)(g * SST + p) * 17 + (t + 1)) * 2;
            const float cr = a.C_re[(g * SCH + c) * SST + p], ci = a.C_im[(g * SCH + c) * SST + p];
            const float re = cr * pw[0] - ci * pw[1], im = cr * pw[1] + ci * pw[0];
            Pt[i] = (bf16_t)(pk2(pp < 64 ? re : -im, 0.f) & 0xffffu);
        }
    }
    for (size_t i = gt0; i < (size_t)SGRP * 17 * 32 * 16; i += nthr) {
        const int cp = i & 15, row = (i >> 4) & 31, d = (int)((i >> 9) % 17), g = (int)(i / (17 * 512));
        const int tau = d - 1 + (row >> 4), c = row & 15;
        float s = 0.f;
        if (tau >= 0) for (int p = 0; p < SST; ++p) {
            const float* pw = POW + ((size_t)(g * SST + p) * 17 + tau) * 2; const float* bb = BB + ((size_t)(g * SST + p) * 16 + cp) * 2;
            const float wr = pw[0] * bb[0] - pw[1] * bb[1], wi = pw[0] * bb[1] + pw[1] * bb[0];
            s += a.C_re[(g * SCH + c) * SST + p] * wr - a.C_im[(g * SCH + c) * SST + p] * wi;
        }
        Kt[i] = (bf16_t)(pk2(s, 0.f) & 0xffffu);
    }
}
DI float gelu_as(float v) {
    const float av = fabsf(v), t = __builtin_amdgcn_rcpf(av * 0.2316418882f + 1.0f);
    float q = t * 0.5307027145f + (-0.7265760135f); q = q * t + 0.7107068705f; q = q * t + (-0.142248368f); q = q * t + 0.127414796f; q = q * t;
    const float e = __builtin_amdgcn_exp2f((v * v) * (-0.72134752044f));
    const float m = v * (q * e);
    return v < 0.f ? m : v - m;
}
DI void s5_mfma_item(const Args& a, LAS unsigned char* lds, int b, int g) {
    const int tid = otid(), lane = tid & 63, w = __builtin_amdgcn_readfirstlane(tid >> 6), q = lane & 31, hh = lane >> 5;
    LAS unsigned char* Xl = lds;
    LAS unsigned char* El = lds + 32768;
    LAS unsigned char* Cl = lds + 65536;
    LAS unsigned char* Kl = lds + 81920;
    const bf16_t* U = (const bf16_t*)(a.ws + WS_U);
    bf16_t* GY = (bf16_t*)(a.ws + WS_GY);
    __syncthreads();
    {   const u32x4* ks = (const u32x4*)((const bf16_t*)(a.ws + WS_S5K) + (size_t)g * 17 * 512);
        for (int i = tid; i < 17 * 64; i += NTHREADS) *(LAS u32x4*)(Kl + i * 16) = ks[i]; }
    const int rbE = w & 3, cbE = w >> 2;
    bf16x8 qf[16], pf[8];
    {   const bf16_t* Qt = (const bf16_t*)(a.ws + WS_S5Q) + (size_t)g * 16 * 128 * 16;
#pragma unroll
        for (int j = 0; j < 16; ++j) qf[j] = *(const bf16x8*)(Qt + ((size_t)j * 128 + rbE * 32 + q) * 16 + 8 * hh);
        const bf16_t* Pt = (const bf16_t*)(a.ws + WS_S5P) + (size_t)g * 16 * 16 * 128;
        const int t = 2 * w + (q >> 4), c = q & 15;
#pragma unroll
        for (int ks = 0; ks < 8; ++ks) pf[ks] = *(const bf16x8*)(Pt + ((size_t)t * 16 + c) * 128 + ks * 16 + 8 * hh); }
    float dsel[2][4];
#pragma unroll
    for (int z = 0; z < 2; ++z)
#pragma unroll
        for (int i = 0; i < 4; ++i) dsel[z][i] = a.Dskip[g * SCH + 4 * hh + 8 * z + i];
    float cr = 0.f, ci = 0.f, a16r = 0.f, a16i = 0.f;
    if (w == 0) { const float* pw = (const float*)(a.ws + WS_S5POW) + ((size_t)(g * SST + lane) * 17 + 16) * 2; a16r = pw[0]; a16i = pw[1]; }
    __syncthreads();
    u32x4 xpre[4];
#pragma unroll
    for (int i = 0; i < 2; ++i) { const size_t tokm = (size_t)b * SEQ + tid + 512 * i;
        xpre[2 * i] = *(const u32x4*)(U + tokm * SW + g * SCH); xpre[2 * i + 1] = *(const u32x4*)(U + tokm * SW + g * SCH + 8); }
    for (int sc = 0; sc < SEQ / 1024; ++sc) {
        const size_t m0 = (size_t)b * SEQ + (size_t)sc * 1024;
#pragma unroll
        for (int i = 0; i < 2; ++i) { const int tok = tid + 512 * i, j = tok & 15, k = tok >> 4;
            *(LAS u32x4*)(Xl + ((j * 64 + k) * 2) * 16) = xpre[2 * i]; *(LAS u32x4*)(Xl + ((j * 64 + k) * 2 + 1) * 16) = xpre[2 * i + 1]; }
        if (sc + 1 < SEQ / 1024) {
#pragma unroll
            for (int i = 0; i < 2; ++i) { const size_t tokm = m0 + 1024 + tid + 512 * i;
                xpre[2 * i] = *(const u32x4*)(U + tokm * SW + g * SCH); xpre[2 * i + 1] = *(const u32x4*)(U + tokm * SW + g * SCH + 8); }
        }
        __syncthreads();
        {
            f32x16 e;
#pragma unroll
            for (int r = 0; r < 16; ++r) e[r] = 0.f;
#pragma unroll
            for (int j = 0; j < 16; ++j) { const bf16x8 xb = *(const LAS bf16x8*)(Xl + ((j * 64 + cbE * 32 + q) * 2 + hh) * 16);
                e = __builtin_amdgcn_mfma_f32_32x32x16_bf16(qf[j], xb, e, 0, 0, 0); }
            const int k = cbE * 32 + q;
#pragma unroll
            for (int g4 = 0; g4 < 4; ++g4) { const int pp = rbE * 32 + 8 * g4 + 4 * hh;
                *(LAS f32x4*)(El + k * 512 + (((pp >> 2) ^ (k & 31)) << 4)) = (f32x4){e[4 * g4], e[4 * g4 + 1], e[4 * g4 + 2], e[4 * g4 + 3]}; }
        }
        __syncthreads();
        if (w == 0) {
#pragma unroll 1
            for (int k0 = 0; k0 < 64; k0 += 16) {
                float er[16], ei[16];
#pragma unroll
                for (int kk = 0; kk < 16; ++kk) { const int k = k0 + kk;
                    er[kk] = *(const LAS float*)(El + k * 512 + ((((lane) >> 2) ^ (k & 31)) << 4) + (lane & 3) * 4);
                    ei[kk] = *(const LAS float*)(El + k * 512 + ((((64 + lane) >> 2) ^ (k & 31)) << 4) + (lane & 3) * 4); }
                unsigned short cw[32];
#pragma unroll
                for (int kk = 0; kk < 16; ++kk) {
                    cw[2 * kk] = (unsigned short)(pk2(cr, 0.f) & 0xffffu); cw[2 * kk + 1] = (unsigned short)(pk2(ci, 0.f) & 0xffffu);
                    const float nr = a16r * cr - a16i * ci + er[kk], ni = a16r * ci + a16i * cr + ei[kk];
                    cr = nr; ci = ni;
                }
#pragma unroll
                for (int kk = 0; kk < 16; ++kk) { const int k = k0 + kk;
                    *(LAS unsigned short*)(Cl + k * 256 + ((((lane) >> 3) ^ (k & 15)) << 4) + (lane & 7) * 2) = cw[2 * kk];
                    *(LAS unsigned short*)(Cl + k * 256 + ((((64 + lane) >> 3) ^ (k & 15)) << 4) + (lane & 7) * 2) = cw[2 * kk + 1]; }
            }
        }
        f32x16 y[2];
#pragma unroll
        for (int cb = 0; cb < 2; ++cb)
#pragma unroll
            for (int r = 0; r < 16; ++r) y[cb][r] = 0.f;
#pragma unroll 2
        for (int j = 0; j <= 2 * w + 1; ++j) {
            const bf16x8 kf = *(const LAS bf16x8*)(Kl + (((2 * w - j + 1) * 32 + q) * 16 + 8 * hh) * 2);
#pragma unroll
            for (int cb = 0; cb < 2; ++cb) { const bf16x8 xb = *(const LAS bf16x8*)(Xl + ((j * 64 + cb * 32 + q) * 2 + hh) * 16);
                y[cb] = __builtin_amdgcn_mfma_f32_32x32x16_bf16(kf, xb, y[cb], 0, 0, 0); }
        }
        __syncthreads();
#pragma unroll
        for (int ks = 0; ks < 8; ++ks)
#pragma unroll
            for (int cb = 0; cb < 2; ++cb) { const int k = cb * 32 + q;
                const bf16x8 cf = *(const LAS bf16x8*)(Cl + k * 256 + (((ks * 2 + hh) ^ (k & 15)) << 4));
                y[cb] = __builtin_amdgcn_mfma_f32_32x32x16_bf16(pf[ks], cf, y[cb], 0, 0, 0); }
#pragma unroll
        for (int cb = 0; cb < 2; ++cb) {
            const int k = cb * 32 + q;
#pragma unroll
            for (int g4 = 0; g4 < 4; ++g4) {
                const int tt = g4 >> 1, z = g4 & 1, t = 2 * w + tt, c0 = 4 * hh + 8 * z;
                const u32x2 uw = *(const LAS u32x2*)(Xl + ((t * 64 + k) * 2 + z) * 16 + hh * 8);
                const float u0 = bflo(uw.x), u1 = bfhi(uw.x), u2 = bflo(uw.y), u3 = bfhi(uw.y);
                const float y0 = gelu_as(y[cb][4 * g4] + dsel[z][0] * u0), y1 = gelu_as(y[cb][4 * g4 + 1] + dsel[z][1] * u1);
                const float y2 = gelu_as(y[cb][4 * g4 + 2] + dsel[z][2] * u2), y3 = gelu_as(y[cb][4 * g4 + 3] + dsel[z][3] * u3);
                u32x2 o; o.x = pk2(y0, y1); o.y = pk2(y2, y3);
                *(u32x2*)(GY + (m0 + 16 * k + t) * SW + g * SCH + c0) = o;
            }
        }
        __syncthreads();
    }
}

DI void phase3(const Args& a, LAS unsigned char* lds) {
    const int tid = otid(), lane = tid & 63, wave = tid >> 6, blk = blockIdx.x;
    unsigned* ctl = (unsigned*)(a.ws + WS_CTL);
    for (int it = blk; it < NB * SGRP; it += gridDim.x) s5_mfma_item(a, lds, it >> 5, it & 31);
    float wqm = 0.f, wkm = 0.f;
    for (int i = lane; i < HD; i += 64) { wqm = fmaxf(wqm, fabsf(a.q_norm_w[i])); wkm = fmaxf(wkm, fabsf(a.k_norm_w[i])); }
#pragma unroll
    for (int o = 1; o < 64; o <<= 1) { wqm = fmaxf(wqm, __shfl_xor(wqm, o)); wkm = fmaxf(wkm, __shfl_xor(wkm, o)); }
    const float qkb2 = 11.313708499f * wqm * wkm * LOG2E * 1.02f;
    const float thr2 = 2.0f * qkb2 + 30.0f * LOG2E;
    LAS int* qi = (LAS int*)(lds + 40960);
    for (;;) {
        __syncthreads();
        if (tid == 0) *qi = (int)atomicAdd(ctl + CW_QUEUE, 1u);
        __syncthreads();
        const int it = *qi;
        if (it >= NB * AH * 64) break;
        attn_item(a, lds, it / (AH * 64), (it / 64) % AH, it % 64, thr2);
    }
}


constexpr size_t WS_H2B = WS_QKV;
constexpr size_t WS_QP = WS_GATES;
constexpr size_t WS_IDS = 992 * MiB;
constexpr size_t WS_GW = 1008 * MiB;
struct EpiPlain {
    static constexpr bool PERM = true;
    bf16_t* o; int ldc;
    DI void operator()(const f32x4 (&acc)[2][2][4][2], const pg8::Unit& un, int wr, int wc, int fr, int fq) const {
        epi_foreach(acc, un, wr, wc, fr, fq, [&](int row, int col0, float (&v)[8]) { store8_bf16(o + (size_t)row * ldc + col0, v); });
    }
};
DI unsigned enc_sortable(float f) { const unsigned u = __float_as_uint(f); return u ^ ((u >> 31) ? 0xffffffffu : 0x80000000u); }
DI float dec_sortable(unsigned s) { return __uint_as_float(s ^ ((s >> 31) ? 0x80000000u : 0xffffffffu)); }
#define TOPK_INSERT(L, x_) do { unsigned _x = (x_); _Pragma("unroll") for (int _k = 0; _k < 16; ++_k) { const unsigned _hi = max(L[_k], _x); _x = min(L[_k], _x); L[_k] = _hi; } } while (0)
DI void sort_bitonic16_desc(unsigned (&M)[16]) {
#pragma unroll
    for (int st = 8; st >= 1; st >>= 1)
#pragma unroll
        for (int i = 0; i < 16; ++i) if ((i & st) == 0) { const unsigned a_ = max(M[i], M[i + st]), b_ = min(M[i], M[i + st]); M[i] = a_; M[i + st] = b_; }
}
template <int N> DI void bitonic_sort_desc(unsigned (&v)[N]) {
#pragma unroll
    for (int k = 2; k <= N; k <<= 1)
#pragma unroll
        for (int j = k >> 1; j > 0; j >>= 1)
#pragma unroll
            for (int i = 0; i < N; ++i) { const int l = i ^ j;
                if (l > i) { const bool desc = (i & k) == 0; const unsigned hi_ = max(v[i], v[l]), lo_ = min(v[i], v[l]); v[i] = desc ? hi_ : lo_; v[l] = desc ? lo_ : hi_; } }
}
DI void merge_top16(unsigned (&A)[16], const unsigned (&B)[16]) {
#pragma unroll
    for (int k = 0; k < 16; ++k) A[k] = max(A[k], B[15 - k]);
    sort_bitonic16_desc(A);
}
DI void peer_select_item(const Args& a, LAS unsigned char* lds, int h, int tile) {
    const int tid = otid(), lane = tid & 63, wave = tid >> 6, q = lane & 31, hh = lane >> 5;
    const bf16_t* keys = (const bf16_t*)(a.ws + WS_KEYS) + (size_t)h * 2 * NKEYS * 128;
    __syncthreads();
    for (int i = tid; i < 2 * NKEYS * 16; i += NTHREADS) {
        const int r = i >> 4, ch = i & 15;
        *(LAS u32x4*)(lds + r * 256 + ((ch ^ (r & 15)) << 4)) = *(const u32x4*)(keys + (size_t)r * 128 + ch * 8);
    }
    __syncthreads();
    const size_t m = (size_t)tile * 256 + wave * 32 + q;
    const bf16_t* qp = (const bf16_t*)(a.ws + WS_QP) + m * D + h * 256;
    unsigned S[2][16];
#pragma unroll
    for (int p = 0; p < 2; ++p) {
        bf16x8 qf[8];
#pragma unroll
        for (int ks = 0; ks < 8; ++ks) qf[ks] = *(const bf16x8*)(qp + p * 128 + ks * 16 + hh * 8);
        f32x16 acc[4];
#pragma unroll
        for (int rb = 0; rb < 4; ++rb) {
#pragma unroll
            for (int r = 0; r < 16; ++r) acc[rb][r] = 0.f;
#pragma unroll
            for (int ks = 0; ks < 8; ++ks) {
                const int r = p * 128 + rb * 32 + q, ch = ks * 2 + hh;
                const bf16x8 kf = *(const LAS bf16x8*)(lds + r * 256 + ((ch ^ (r & 15)) << 4));
                acc[rb] = __builtin_amdgcn_mfma_f32_32x32x16_bf16(kf, qf[ks], acc[rb], 0, 0, 0);
            }
        }
        unsigned K0[16], K1[16], K2[16], K3[16];
#pragma unroll
        for (int r = 0; r < 16; ++r) {
            const unsigned n = (r & 3) + 8 * (r >> 2) + 4 * hh;
            K0[r] = (enc_sortable(acc[0][r]) & ~0x7Fu) | n; K1[r] = (enc_sortable(acc[1][r]) & ~0x7Fu) | (32 + n);
            K2[r] = (enc_sortable(acc[2][r]) & ~0x7Fu) | (64 + n); K3[r] = (enc_sortable(acc[3][r]) & ~0x7Fu) | (96 + n);
        }
        bitonic_sort_desc<16>(K0); bitonic_sort_desc<16>(K1); bitonic_sort_desc<16>(K2); bitonic_sort_desc<16>(K3);
        merge_top16(K0, K1); merge_top16(K2, K3); merge_top16(K0, K2);
        unsigned M[16];
#pragma unroll
        for (int k = 0; k < 16; ++k) { const unsigned pl = __shfl_xor(K0[15 - k], 32); M[k] = max(K0[k], pl); }
        sort_bitonic16_desc(M);
#pragma unroll
        for (int k = 0; k < 16; ++k) S[p][k] = M[k];
    }
    float f0[16], f1[16];
#pragma unroll
    for (int k = 0; k < 16; ++k) { f0[k] = dec_sortable(S[0][k] & ~0x7Fu); f1[k] = dec_sortable(S[1][k] & ~0x7Fu); }
    unsigned R[16], X[32], X2[2];
#pragma unroll
    for (int c = 0; c < 16; ++c) R[c] = (enc_sortable(f0[0] + f1[c]) & ~0xFFu) | (unsigned)c;
    {   int idx = 0;
#pragma unroll
        for (int p = 1; p < 16; ++p)
#pragma unroll
            for (int c = 0; c < 16; ++c) if ((p + 1) * (c + 1) <= 16) {
                const unsigned key = (enc_sortable(f0[p] + f1[c]) & ~0xFFu) | (unsigned)(p * 16 + c);
                if (idx < 32) X[idx] = key; else X2[idx - 32] = key;
                ++idx;
            }
    }
    bitonic_sort_desc<16>(R); bitonic_sort_desc<32>(X);
    {   unsigned XT[16];
#pragma unroll
        for (int k = 0; k < 16; ++k) XT[k] = X[k];
        merge_top16(R, XT); }
    TOPK_INSERT(R, X2[0]); TOPK_INSERT(R, X2[1]);
    unsigned pk0[4] = {0, 0, 0, 0}, pk1[4] = {0, 0, 0, 0};
#pragma unroll
    for (int k = 0; k < 16; ++k) { pk0[k >> 2] |= (S[0][k] & 0x7Fu) << (8 * (k & 3)); pk1[k >> 2] |= (S[1][k] & 0x7Fu) << (8 * (k & 3)); }
    int eid[16]; float ew[16]; float esum = 0.f;
    const float tv0 = dec_sortable(R[0] & ~0xFFu);
#pragma unroll
    for (int r = 0; r < 16; ++r) {
        const unsigned pq = R[r] & 0xFFu, p = pq >> 4, c = pq & 15u;
        unsigned w0 = pk0[0], w1 = pk1[0];
        w0 = (p >> 2) == 1 ? pk0[1] : w0; w0 = (p >> 2) == 2 ? pk0[2] : w0; w0 = (p >> 2) == 3 ? pk0[3] : w0;
        w1 = (c >> 2) == 1 ? pk1[1] : w1; w1 = (c >> 2) == 2 ? pk1[2] : w1; w1 = (c >> 2) == 3 ? pk1[3] : w1;
        const unsigned i0 = (w0 >> (8 * (p & 3))) & 0x7Fu, i1 = (w1 >> (8 * (c & 3))) & 0x7Fu;
        eid[r] = (int)(i0 * NKEYS + i1);
        ew[r] = __expf(dec_sortable(R[r] & ~0xFFu) - tv0); esum += ew[r];
    }
    const float inv = 1.0f / esum;
    if (hh == 0) {
        unsigned short* o = (unsigned short*)(a.ws + WS_IDS) + m * NSEL + h * 16;
#pragma unroll
        for (int r = 0; r < 16; r += 8) *(u32x4*)(o + r) = (u32x4){(unsigned)eid[r] | ((unsigned)eid[r + 1] << 16), (unsigned)eid[r + 2] | ((unsigned)eid[r + 3] << 16),
                                                                   (unsigned)eid[r + 4] | ((unsigned)eid[r + 5] << 16), (unsigned)eid[r + 6] | ((unsigned)eid[r + 7] << 16)};
    } else {
        float* o = (float*)(a.ws + WS_GW) + m * NSEL + h * 16;
#pragma unroll
        for (int r = 0; r < 16; r += 4) *(f32x4*)(o + r) = (f32x4){ew[r] * inv, ew[r + 1] * inv, ew[r + 2] * inv, ew[r + 3] * inv};
    }
}
DI void phase9(const Args& a, LAS unsigned char* lds) {
    if (gridDim.x == 256) {
        const int c = blockIdx.x, tile = 16 * (c & 7) + ((c >> 3) & 15), h0 = 4 * (c >> 7);
        for (int hh = 0; hh < 4; ++hh) peer_select_item(a, lds, h0 + hh, tile);
    } else
        for (int it = blockIdx.x; it < PH * (T / 256); it += gridDim.x) peer_select_item(a, lds, it / (T / 256), it % (T / 256));
}

#ifndef EPB
#define EPB 16
#endif
#ifndef EPB2
#define EPB2 8
#endif
DI void phase10(const Args& a) {
    const int tid = otid(), lane = tid & 63, wave = tid >> 6;
    const int gw = blockIdx.x * NWAVES + wave, NGW = gridDim.x * NWAVES;
    const unsigned char* PU = a.ws + WS_PU; const unsigned char* PV = a.ws + WS_PV;
    const float* PUS = (const float*)(a.ws + WS_PUS); const float* PVS = (const float*)(a.ws + WS_PVS);
    const float* mod = (const float*)(a.ws + WS_CTL) + CW_MOD;
    (void)gw;
    for (int ri = 0; ri < (T + NGW - 1) / NGW; ++ri) {
        const int m = affine_row(blockIdx.x, wave, ri, gridDim.x);
        if (m >= T) break;
        const int b = m >> 14;
        const int* ids = (const int*)(a.ws + WS_IDS) + (size_t)m * NSEL; const float* gwp = (const float*)(a.ws + WS_GW) + (size_t)m * NSEL;
        const int idA = ids[lane], idB = ids[64 + lane];
        const float gA = gwp[lane] * PVS[idA], gB = gwp[64 + lane] * PVS[idB];
        const float suA = PUS[idA], suB = PUS[idB];
        const bf16_t* hrow = (const bf16_t*)(a.ws + WS_H2B) + (size_t)m * D + 32 * lane;
        unsigned hp[16];
#pragma unroll
        for (int q = 0; q < 4; ++q) { const u32x4 t4 = *(const u32x4*)(hrow + 8 * q); hp[4 * q] = t4[0]; hp[4 * q + 1] = t4[1]; hp[4 * q + 2] = t4[2]; hp[4 * q + 3] = t4[3]; }
        float cf[4];
#pragma unroll
        for (int bt = 0; bt < 4; ++bt) {
            float part[32];
#pragma unroll
            for (int i0 = 0; i0 < 32; i0 += EPB) {
                v6u uw[EPB];
#pragma unroll
                for (int i = 0; i < EPB; ++i) {
                    const int id = __builtin_amdgcn_readlane(bt < 2 ? idA : idB, (bt & 1) * 32 + i0 + i);
                    uw[i] = fp6_load(PU + (size_t)id * ROWB, lane);
                }
#pragma unroll
                for (int i = 0; i < EPB; ++i) {
                    const v16u rp = fp6_unpack_bf16(uw[i]);
                    float s = 0.f;
#pragma unroll
                    for (int k = 0; k < 16; ++k) { const unsigned pu = rp[k], ph = hp[k];
                        s = __builtin_amdgcn_fdot2_f32_bf16(__builtin_bit_cast(bf16x2_t, ph), __builtin_bit_cast(bf16x2_t, pu), s, false); }
                    part[i0 + i] = s;
                }
                __builtin_amdgcn_sched_barrier(0);
            }
            float p16[16], p8[8], p4[4], p2[2], p1;
            { const bool hi = lane & 32;
#pragma unroll
              for (int i = 0; i < 16; ++i) { const float snd = hi ? part[i] : part[i + 16], kp = hi ? part[i + 16] : part[i]; p16[i] = kp + __shfl_xor(snd, 32); } }
            { const bool hi = lane & 16;
#pragma unroll
              for (int i = 0; i < 8; ++i) { const float snd = hi ? p16[i] : p16[i + 8], kp = hi ? p16[i + 8] : p16[i]; p8[i] = kp + __shfl_xor(snd, 16); } }
            { const bool hi = lane & 8;
#pragma unroll
              for (int i = 0; i < 4; ++i) { const float snd = hi ? p8[i] : p8[i + 4], kp = hi ? p8[i + 4] : p8[i]; p4[i] = kp + __shfl_xor(snd, 8); } }
            { const bool hi = lane & 4;
#pragma unroll
              for (int i = 0; i < 2; ++i) { const float snd = hi ? p4[i] : p4[i + 2], kp = hi ? p4[i + 2] : p4[i]; p2[i] = kp + __shfl_xor(snd, 4); } }
            { const bool hi = lane & 2; const float snd = hi ? p2[0] : p2[1], kp = hi ? p2[1] : p2[0]; p1 = kp + __shfl_xor(snd, 2); }
            p1 += __shfl_xor(p1, 1);
            const int src_lane = (bt & 1) * 32 + (lane >> 1);
            const float g = __shfl(bt < 2 ? gA : gB, src_lane), su = __shfl(bt < 2 ? suA : suB, src_lane);
            cf[bt] = geluf_(p1 * su) * g;
        }
        f32x2 acc[16];
#pragma unroll
        for (int k = 0; k < 16; ++k) acc[k] = (f32x2){0.f, 0.f};
#pragma unroll
        for (int bt = 0; bt < 4; ++bt) {
#pragma unroll 1
            for (int i0 = 0; i0 < 32; i0 += EPB2) {
                __builtin_amdgcn_sched_barrier(0);
                v6u vw[EPB2]; float cs[EPB2];
#pragma unroll
                for (int i = 0; i < EPB2; ++i) {
                    const int id = __builtin_amdgcn_readlane(bt < 2 ? idA : idB, (bt & 1) * 32 + i0 + i);
                    cs[i] = __uint_as_float((unsigned)__builtin_amdgcn_readlane((int)__float_as_uint(cf[bt]), 2 * (i0 + i)));
                    vw[i] = fp6_load(PV + (size_t)id * ROWB, lane);
                }
#pragma unroll
                for (int i = 0; i < EPB2; ++i) {
                    const v32f r = fp6_unpack_f32(vw[i]);
                    const f32x2 c2 = (f32x2){cs[i], cs[i]};
#pragma unroll
                    for (int k = 0; k < 16; ++k) acc[k] = __builtin_elementwise_fma(c2, (f32x2){r[2 * k], r[2 * k + 1]}, acc[k]);
                }
            }
        }
        float* orow = a.out + (size_t)m * D + 32 * lane;
        const float* gp = mod + b * NMOD + 5 * D + 32 * lane;
#pragma unroll
        for (int k4 = 0; k4 < 8; ++k4) {
            const f32x4 g2 = *(const f32x4*)(gp + 4 * k4);
            f32x4 xv = *(const f32x4*)(orow + 4 * k4);
#pragma unroll
            for (int k = 0; k < 4; ++k) xv[k] += g2[k] * acc[2 * k4 + (k >> 1)][k & 1];
            *(f32x4*)(orow + 4 * k4) = xv;
        }
    }
}


DI void phase10_fp4(const Args& a) {
    const int tid = otid(), lane = tid & 63, wave = tid >> 6;
    const int gw = blockIdx.x * NWAVES + wave, NGW = gridDim.x * NWAVES;
    const unsigned char* PU = a.ws + WS_PU; const unsigned char* PV = a.ws + WS_PV; const unsigned char* PUE = a.ws + WS_PUE; const unsigned char* PVE = a.ws + WS_PVE;
    const float* mod = (const float*)(a.ws + WS_CTL) + CW_MOD;
    (void)gw;
    for (int ri = 0; ri < (T + NGW - 1) / NGW; ++ri) {
        const int m = affine_row(blockIdx.x, wave, ri, gridDim.x);
        if (m >= T) break;
        const int b = m >> 14;
        const int* ids = (const int*)(a.ws + WS_IDS) + (size_t)m * NSEL; const float* gwp = (const float*)(a.ws + WS_GW) + (size_t)m * NSEL;
        const int idA = ids[lane], idB = ids[64 + lane];
        const float gA = gwp[lane], gB = gwp[64 + lane];
        const bf16_t* hrow = (const bf16_t*)(a.ws + WS_H2B) + (size_t)m * D + 32 * lane;
        f32x2 hf[16];
#pragma unroll
        for (int q = 0; q < 4; ++q) { const u32x4 t4 = *(const u32x4*)(hrow + 8 * q);
#pragma unroll
            for (int z = 0; z < 4; ++z) { const unsigned pw = t4[z]; hf[4 * q + z] = (f32x2){bflo(pw), bfhi(pw)}; } }
        float cf[4];
#pragma unroll
        for (int bt = 0; bt < 4; ++bt) {
            float part[32];
#pragma unroll
            for (int i0 = 0; i0 < 32; i0 += EPB) {
                u32x4 uw[EPB]; unsigned ue[EPB];
#pragma unroll
                for (int i = 0; i < EPB; ++i) {
                    const int id = __builtin_amdgcn_readlane(bt < 2 ? idA : idB, (bt & 1) * 32 + i0 + i);
                    uw[i] = *(const u32x4*)(PU + (size_t)id * ROWB4 + 16 * lane); ue[i] = PUE[(size_t)id * 64 + lane];
                }
#pragma unroll
                for (int i = 0; i < EPB; ++i) {
                    f32x2 s2 = (f32x2){0.f, 0.f};
#pragma unroll
                    for (int d = 0; d < 4; ++d) { f32x2 r[4]; const unsigned wd = uw[i][d]; fp4_unpack8(wd, r);
#pragma unroll
                        for (int z = 0; z < 4; ++z) s2 = __builtin_elementwise_fma(hf[4 * d + z], r[z], s2); }
                    part[i0 + i] = (s2[0] + s2[1]) * __uint_as_float(ue[i] << 23);
                }
                __builtin_amdgcn_sched_barrier(0);
            }
            float p16[16], p8[8], p4[4], p2[2], p1;
            { const bool hi = lane & 32;
#pragma unroll
              for (int i = 0; i < 16; ++i) { const float snd = hi ? part[i] : part[i + 16], kp = hi ? part[i + 16] : part[i]; p16[i] = kp + __shfl_xor(snd, 32); } }
            { const bool hi = lane & 16;
#pragma unroll
              for (int i = 0; i < 8; ++i) { const float snd = hi ? p16[i] : p16[i + 8], kp = hi ? p16[i + 8] : p16[i]; p8[i] = kp + __shfl_xor(snd, 16); } }
            { const bool hi = lane & 8;
#pragma unroll
              for (int i = 0; i < 4; ++i) { const float snd = hi ? p8[i] : p8[i + 4], kp = hi ? p8[i + 4] : p8[i]; p4[i] = kp + __shfl_xor(snd, 8); } }
            { const bool hi = lane & 4;
#pragma unroll
              for (int i = 0; i < 2; ++i) { const float snd = hi ? p4[i] : p4[i + 2], kp = hi ? p4[i + 2] : p4[i]; p2[i] = kp + __shfl_xor(snd, 4); } }
            { const bool hi = lane & 2; const float snd = hi ? p2[0] : p2[1], kp = hi ? p2[1] : p2[0]; p1 = kp + __shfl_xor(snd, 2); }
            p1 += __shfl_xor(p1, 1);
            const float g = __shfl(bt < 2 ? gA : gB, (bt & 1) * 32 + (lane >> 1));
            cf[bt] = geluf_(p1) * g;
        }
        f32x2 acc[16];
#pragma unroll
        for (int k = 0; k < 16; ++k) acc[k] = (f32x2){0.f, 0.f};
#pragma unroll
        for (int bt = 0; bt < 4; ++bt) {
#pragma unroll 1
            for (int i0 = 0; i0 < 32; i0 += EPB2) {
                __builtin_amdgcn_sched_barrier(0);
                u32x4 vw[EPB2]; unsigned ve[EPB2]; float cs[EPB2];
#pragma unroll
                for (int i = 0; i < EPB2; ++i) {
                    const int id = __builtin_amdgcn_readlane(bt < 2 ? idA : idB, (bt & 1) * 32 + i0 + i);
                    cs[i] = __uint_as_float((unsigned)__builtin_amdgcn_readlane((int)__float_as_uint(cf[bt]), 2 * (i0 + i)));
                    vw[i] = *(const u32x4*)(PV + (size_t)id * ROWB4 + 16 * lane); ve[i] = PVE[(size_t)id * 64 + lane];
                }
#pragma unroll
                for (int i = 0; i < EPB2; ++i) {
                    const float cl = cs[i] * __uint_as_float(ve[i] << 23);
                    const f32x2 c2 = (f32x2){cl, cl};
#pragma unroll
                    for (int d = 0; d < 4; ++d) { f32x2 r[4]; const unsigned wd = vw[i][d]; fp4_unpack8(wd, r);
#pragma unroll
                        for (int z = 0; z < 4; ++z) acc[4 * d + z] = __builtin_elementwise_fma(c2, r[z], acc[4 * d + z]); }
                }
            }
        }
        float* orow = a.out + (size_t)m * D + 32 * lane;
        const float* gp = mod + b * NMOD + 5 * D + 32 * lane;
#pragma unroll
        for (int k4 = 0; k4 < 8; ++k4) {
            const f32x4 g2 = *(const f32x4*)(gp + 4 * k4);
            f32x4 xv = *(const f32x4*)(orow + 4 * k4);
#pragma unroll
            for (int k = 0; k < 4; ++k) xv[k] += g2[k] * acc[2 * k4 + (k >> 1)][k & 1];
            *(f32x4*)(orow + 4 * k4) = xv;
        }
    }
}

constexpr size_t WS_SP = WS_GATES + 128 * MiB;
constexpr size_t WS_CF = WS_U;
struct SliceMap { int NS, grp, wv, nwv; };
DI SliceMap slice_map(int blk, int wave, int G) {
    SliceMap s; s.NS = G < 8 ? G : 8; s.grp = blk % s.NS; s.wv = (blk / s.NS) * NWAVES + wave; s.nwv = ((G - s.grp + s.NS - 1) / s.NS) * NWAVES; return s;
}
template <int CTRL> DI float dppf(float x) { return __builtin_bit_cast(float, __builtin_amdgcn_mov_dpp(__builtin_bit_cast(int, x), CTRL, 0xf, 0xf, true)); }
constexpr int DPP_XOR1 = 0xB1, DPP_XOR2 = 0x4E, DPP_MIR8 = 0x141, DPP_XOR8 = 0x128;
DI void hdigits_pass(const Args& a) {
    const int tid = otid(), lane = tid & 63, wave = tid >> 6;
    const int NGW = gridDim.x * NWAVES;
    for (int ri = 0; ri < (T + NGW - 1) / NGW; ++ri) {
        const int m = affine_row(blockIdx.x, wave, ri, gridDim.x);
        if (m >= T) break;
        const bf16_t* hrow = (const bf16_t*)(a.ws + WS_H2B) + (size_t)m * D + 32 * lane;
        u32x4 t4[4]; float mx = 0.f;
#pragma unroll
        for (int q = 0; q < 4; ++q) { t4[q] = *(const u32x4*)(hrow + 8 * q);
#pragma unroll
            for (int z = 0; z < 4; ++z) mx = fmaxf(mx, fmaxf(fabsf(bflo(t4[q][z])), fabsf(bfhi(t4[q][z])))); }
        mx = fmaxf(mx, dppf<DPP_XOR1>(mx)); mx = fmaxf(mx, dppf<DPP_XOR2>(mx)); mx = fmaxf(mx, dppf<DPP_MIR8>(mx));
        const float step = mx * (1.0f / 119.0f), S = mx > 0.f ? 119.0f / mx : 0.f;
        unsigned p0[4], p1[4];
#pragma unroll
        for (int d = 0; d < 4; ++d) {
            unsigned a0 = 0u, a1 = 0u;
#pragma unroll
            for (int e = 0; e < 8; ++e) {
                const unsigned pw = t4[d][e >> 1]; const float x = (e & 1) ? bfhi(pw) : bflo(pw);
                const int q = (int)rintf(x * S), q1 = (q + 8) >> 4;
                a0 |= ((unsigned)q & 15u) << (4 * e); a1 |= ((unsigned)q1 & 15u) << (4 * e);
            }
            p0[d] = a0; p1[d] = a1;
        }
        u32x4* dst = (u32x4*)(a.ws + WS_H4) + ((size_t)m * 64 + lane) * 2;
        dst[0] = (u32x4){p0[0], p0[1], p0[2], p0[3]}; dst[1] = (u32x4){p1[0], p1[1], p1[2], p1[3]};
        if ((lane & 7) == 0) ((float*)(a.ws + WS_HS))[(size_t)m * 8 + (lane >> 3)] = step;
    }
}
DI void p10a_issue(const unsigned char* pu, LAS unsigned char* lds, int idv, int gl, unsigned lo16, unsigned lo1, u32x4 (&uw)[8], unsigned (&uc)[8]) {
#pragma unroll
    for (int j = 0; j < 8; ++j) {
        const unsigned id = (unsigned)__shfl(idv, gl | j);
        uw[j] = *(const u32x4*)(pu + ((id << 10) + lo16)); uc[j] = lds[(id << 3) + lo1];
    }
}
DI float p10a_math(const u32x4 (&uw)[8], const unsigned (&uc)[8], LAS unsigned char* lds, const u32x4& c0, const u32x4& c1, int i) {
    float o = 0.f;
    float us[8];
#pragma unroll
    for (int j = 0; j < 8; ++j) us[j] = ((LAS float*)(lds + NEXP * 8))[uc[j]];
#pragma unroll
    for (int j = 0; j < 8; ++j) {
        int acc;
        asm("v_dot8_i32_i4 %0, %1, %2, 0" : "=v"(acc) : "v"(uw[j][0]), "v"(c1[0]));
#pragma unroll
        for (int d = 1; d < 4; ++d) acc = __builtin_amdgcn_sdot8((int)uw[j][d], (int)c1[d], acc, false);
        acc <<= 4;
#pragma unroll
        for (int d = 0; d < 4; ++d) acc = __builtin_amdgcn_sdot8((int)uw[j][d], (int)c0[d], acc, false);
        float v = (float)acc * us[j];
        asm("" : "+v"(v));
        v += dppf<DPP_XOR1>(v); v += dppf<DPP_XOR2>(v); v += dppf<DPP_MIR8>(v);
        o = (i == j) ? v : o;
    }
    return o;
}
DI void phase10a_u4(const Args& a, LAS unsigned char* lds) {
    const int tid = otid(), lane = tid & 63, wave = tid >> 6;
    const SliceMap sm = slice_map(blockIdx.x, wave, gridDim.x);
    const int g = lane >> 3, i = lane & 7, gl = lane & 56;
    const unsigned lo16 = 16u * i, lo1 = (unsigned)i;
    for (int x = sm.grp; x < 8; x += sm.NS) {
        const unsigned char* pu = a.ws + WS_PU + 128 * x;
        {
            __syncthreads();
            const u32x4* s4 = (const u32x4*)(a.ws + WS_PUS4 + (size_t)x * (NEXP * 8));
            for (int q = tid; q < NEXP * 8 / 16; q += NTHREADS) *(LAS u32x4*)(lds + 16 * q) = s4[q];
            if (tid < 256) ((LAS float*)(lds + NEXP * 8))[tid] = u4_step(tid);
            __syncthreads();
        }
        bf16_t* sp = (bf16_t*)(a.ws + WS_SP) + (size_t)x * T * NSEL + 16 * g + i;
        const unsigned short* idb = (const unsigned short*)(a.ws + WS_IDS) + 16 * g + i;
        const u32x4* h4 = (const u32x4*)(a.ws + WS_H4) + (size_t)(8 * x + i) * 2;
        const float* hsb = (const float*)(a.ws + WS_HS) + x;
        int t = sm.wv;
        if (t >= T) continue;
        int idlo = idb[(size_t)t * NSEL], idhi = idb[(size_t)t * NSEL + 8];
        u32x4 hp0 = h4[(size_t)t * 128], hp1 = h4[(size_t)t * 128 + 1];
        float hs = hsb[(size_t)t * 8];
        u32x4 uwA[8], uwB[8]; unsigned usA[8], usB[8];
        p10a_issue(pu, lds, idlo, gl, lo16, lo1, uwA, usA);
#pragma unroll 1
        for (; t < T; t += sm.nwv) {
            __builtin_amdgcn_sched_barrier(0);
            const u32x4 c0 = hp0, c1 = hp1; const float chs = hs; const int cidhi = idhi;
            {   const int tn = (t + sm.nwv < T) ? t + sm.nwv : t;
                idlo = idb[(size_t)tn * NSEL]; idhi = idb[(size_t)tn * NSEL + 8];
                hp0 = h4[(size_t)tn * 128]; hp1 = h4[(size_t)tn * 128 + 1]; hs = hsb[(size_t)tn * 8];
            }
            p10a_issue(pu, lds, cidhi, gl, lo16, lo1, uwB, usB);
            __builtin_amdgcn_sched_barrier(0);
            const float olo = p10a_math(uwA, usA, lds, c0, c1, i);
            __builtin_amdgcn_sched_barrier(0);
            p10a_issue(pu, lds, idlo, gl, lo16, lo1, uwA, usA);
            __builtin_amdgcn_sched_barrier(0);
            const float ohi = p10a_math(uwB, usB, lds, c0, c1, i);
            { const unsigned pw = pk2(olo * chs, ohi * chs); sp[(size_t)t * NSEL] = (bf16_t)(pw & 0xffffu); sp[(size_t)t * NSEL + 8] = (bf16_t)(pw >> 16); }
        }
    }
}
DI void phase10a_fp4(const Args& a) {
    const int tid = otid(), lane = tid & 63, wave = tid >> 6;
    const SliceMap sm = slice_map(blockIdx.x, wave, gridDim.x);
    const int g = lane >> 3, i = lane & 7, gl = lane & 56;
    for (int x = sm.grp; x < 8; x += sm.NS) {
        const unsigned char* pu = a.ws + WS_PU + 128 * x + 16 * i; const unsigned char* pe = a.ws + WS_PUE + 8 * x + i;
        float* sp = (float*)(a.ws + WS_SP) + (size_t)x * T * NSEL + 16 * g + i;
        const int* idb = (const int*)(a.ws + WS_IDS) + 16 * g + i;
        const bf16_t* hb = (const bf16_t*)(a.ws + WS_H2B) + 256 * x + 32 * i;
        int t = sm.wv;
        if (t >= T) continue;
        int idlo = idb[(size_t)t * NSEL], idhi = idb[(size_t)t * NSEL + 8];
        u32x4 hr[4];
#pragma unroll
        for (int q = 0; q < 4; ++q) hr[q] = *(const u32x4*)(hb + (size_t)t * D + 8 * q);
#pragma unroll 1
        for (; t < T; t += sm.nwv) {
            __builtin_amdgcn_sched_barrier(0);
            u32x4 uw[16]; unsigned ue[16];
#pragma unroll
            for (int j = 0; j < 16; ++j) {
                const int id = __shfl(j < 8 ? idlo : idhi, gl | (j & 7));
                uw[j] = *(const u32x4*)(pu + (size_t)id * ROWB4); ue[j] = pe[(size_t)id * 64];
            }
            f32x2 hf[16];
#pragma unroll
            for (int q = 0; q < 4; ++q) {
#pragma unroll
                for (int z = 0; z < 4; ++z) { const unsigned pw = hr[q][z]; hf[4 * q + z] = (f32x2){bflo(pw), bfhi(pw)}; } }
            {   const int tn = (t + sm.nwv < T) ? t + sm.nwv : t;
                idlo = idb[(size_t)tn * NSEL]; idhi = idb[(size_t)tn * NSEL + 8];
#pragma unroll
                for (int q = 0; q < 4; ++q) hr[q] = *(const u32x4*)(hb + (size_t)tn * D + 8 * q);
            }
            __builtin_amdgcn_sched_barrier(0);
            float olo = 0.f, ohi = 0.f;
#pragma unroll
            for (int j = 0; j < 16; ++j) {
                f32x2 s2 = (f32x2){0.f, 0.f};
#if XTRA == 2
                f32x2 s3 = (f32x2){1.f, 1.f};
#endif
#pragma unroll
                for (int d = 0; d < 4; ++d) { f32x2 r[4]; const unsigned wd = uw[j][d]; fp4_unpack8(wd, r);
#if XTRA == 1
                    { unsigned wd2 = wd; asm volatile("" : "+v"(wd2)); f32x2 r2[4]; fp4_unpack8(wd2, r2); asm volatile("" :: "v"(r2[0]), "v"(r2[1]), "v"(r2[2]), "v"(r2[3])); }
#endif
#if XTRA == 2
#pragma unroll
                    for (int z = 0; z < 4; ++z) s3 = __builtin_elementwise_fma(hf[4 * d + z], r[z], s3);
#endif
#pragma unroll
                    for (int z = 0; z < 4; ++z) s2 = __builtin_elementwise_fma(hf[4 * d + z], r[z], s2); }
#if XTRA == 2
                asm volatile("" :: "v"(s3));
#endif
                float v = (s2[0] + s2[1]) * __uint_as_float(ue[j] << 23);
                v += __shfl_xor(v, 1); v += __shfl_xor(v, 2); v += __shfl_xor(v, 4);
                if (j < 8) olo = (i == j) ? v : olo; else ohi = (i == j - 8) ? v : ohi;
            }
            sp[(size_t)t * NSEL] = olo; sp[(size_t)t * NSEL + 8] = ohi;
        }
    }
}
DI void phase10b(const Args& a) {
    const int gt = blockIdx.x * NTHREADS + otid(), NT = gridDim.x * NTHREADS;
    const u32x2* sp = (const u32x2*)(a.ws + WS_SP); const f32x4* gw = (const f32x4*)(a.ws + WS_GW); u32x2* cf = (u32x2*)(a.ws + WS_CF);
    constexpr int N4 = T * NSEL / 4;
    for (int q = gt; q < N4; q += NT) {
        f32x4 s = (f32x4){0.f, 0.f, 0.f, 0.f};
#pragma unroll
        for (int x = 0; x < 8; ++x) { const u32x2 w = sp[(size_t)x * N4 + q]; s += (f32x4){bflo(w.x), bfhi(w.x), bflo(w.y), bfhi(w.y)}; }
        const f32x4 gg = gw[q];
        f32x4 o;
#pragma unroll
        for (int k = 0; k < 4; ++k) o[k] = geluf_(s[k]) * gg[k];
        cf[q] = (u32x2){pk2(o[0], o[1]), pk2(o[2], o[3])};
    }
}
DI void phase10c_fp4(const Args& a, LAS unsigned char* lds) {
    const int tid = otid(), lane = tid & 63, wave = tid >> 6;
    const SliceMap sm = slice_map(blockIdx.x, wave, gridDim.x);
    const int g = lane >> 3, i = lane & 7, gl = lane & 56;
    const float* mod = (const float*)(a.ws + WS_CTL) + CW_MOD;
    for (int x = sm.grp; x < 8; x += sm.NS) {
        const unsigned char* pv = a.ws + WS_PV + 128 * x;
        const unsigned lo16 = 16u * i, lo1 = (unsigned)i;
        {
            __syncthreads();
            const u32x4* s4 = (const u32x4*)(a.ws + WS_PVE + (size_t)x * (NEXP * 8));
            for (int q = tid; q < NEXP * 8 / 16; q += NTHREADS) *(LAS u32x4*)(lds + 16 * q) = s4[q];
            __syncthreads();
        }
        const unsigned short* idb = (const unsigned short*)(a.ws + WS_IDS) + 16 * g + i;
        const bf16_t* cfb = (const bf16_t*)(a.ws + WS_CF) + 16 * g + i;
        const int col = 256 * x + 32 * i + 16 * ((lane >> 5) & 1) + 8 * ((lane >> 4) & 1) + 4 * ((lane >> 3) & 1);
        int t = sm.wv;
        if (t >= T) continue;
        int idlo = idb[(size_t)t * NSEL], idhi = idb[(size_t)t * NSEL + 8];
        float clo = bf2f(cfb[(size_t)t * NSEL]), chi = bf2f(cfb[(size_t)t * NSEL + 8]);
#pragma unroll 1
        for (; t < T; t += sm.nwv) {
            __builtin_amdgcn_sched_barrier(0);
            u32x4 vw[16]; unsigned ve[16]; float cs[16];
#pragma unroll
            for (int j = 0; j < 16; ++j) {
                const unsigned id = (unsigned)__shfl(j < 8 ? idlo : idhi, gl | (j & 7));
                cs[j] = __shfl(j < 8 ? clo : chi, gl | (j & 7));
                vw[j] = *(const u32x4*)(pv + ((id << 10) + lo16)); ve[j] = lds[(id << 3) + lo1];
            }
            {   const int tn = (t + sm.nwv < T) ? t + sm.nwv : t;
                idlo = idb[(size_t)tn * NSEL]; idhi = idb[(size_t)tn * NSEL + 8];
                clo = bf2f(cfb[(size_t)tn * NSEL]); chi = bf2f(cfb[(size_t)tn * NSEL + 8]);
            }
            float* orow = a.out + (size_t)t * D + col;
            const u32x2 xw = *(const u32x2*)(x1b_row(a.ws, t) + col);
            f32x4 xv = (f32x4){bflo(xw.x), bfhi(xw.x), bflo(xw.y), bfhi(xw.y)};
            const f32x4 g2 = *(const f32x4*)(mod + (t >> 14) * NMOD + 5 * D + col);
            __builtin_amdgcn_sched_barrier(0);
            f32x2 acc[16];
#pragma unroll
            for (int k = 0; k < 16; ++k) acc[k] = (f32x2){0.f, 0.f};
#pragma unroll
            for (int j = 0; j < 16; ++j) {
                const float bs = __uint_as_float(ve[j] << 23);
                const f32x2 c2 = (f32x2){cs[j], cs[j]};
#pragma unroll
                for (int d = 0; d < 4; ++d) { f32x2 r[4]; const unsigned wd = vw[j][d];
                    r[0] = __builtin_amdgcn_cvt_scalef32_pk_f32_fp4(wd, bs, 0); r[1] = __builtin_amdgcn_cvt_scalef32_pk_f32_fp4(wd, bs, 1);
                    r[2] = __builtin_amdgcn_cvt_scalef32_pk_f32_fp4(wd, bs, 2); r[3] = __builtin_amdgcn_cvt_scalef32_pk_f32_fp4(wd, bs, 3);
#pragma unroll
                    for (int z = 0; z < 4; ++z) acc[4 * d + z] = __builtin_elementwise_fma(c2, r[z], acc[4 * d + z]); }
            }
            f32x2 q8[8], q4[4], q2[2];
#pragma unroll
            for (int k = 0; k < 8; ++k) {
#pragma unroll
                for (int c = 0; c < 2; ++c) { const auto r = __builtin_amdgcn_permlane32_swap(__float_as_uint(acc[k][c]), __float_as_uint(acc[8 + k][c]), false, false);
                    q8[k][c] = __uint_as_float(r[0]) + __uint_as_float(r[1]); } }
#pragma unroll
            for (int k = 0; k < 4; ++k) {
#pragma unroll
                for (int c = 0; c < 2; ++c) { const auto r = __builtin_amdgcn_permlane16_swap(__float_as_uint(q8[k][c]), __float_as_uint(q8[4 + k][c]), false, false);
                    q4[k][c] = __uint_as_float(r[0]) + __uint_as_float(r[1]); } }
            { const bool hi = lane & 8;
#pragma unroll
              for (int k = 0; k < 2; ++k) {
#pragma unroll
                  for (int c = 0; c < 2; ++c) { const float kp = hi ? q4[2 + k][c] : q4[k][c], sd = hi ? q4[k][c] : q4[2 + k][c]; q2[k][c] = kp + dppf<DPP_XOR8>(sd); } } }
            xv[0] += g2[0] * q2[0][0]; xv[1] += g2[1] * q2[0][1]; xv[2] += g2[2] * q2[1][0]; xv[3] += g2[3] * q2[1][1];
            *(f32x4*)orow = xv;
        }
    }
}

#if DBG
DI float naive_mod(const Args& a, int b, int n) {
    float s = a.b_ada[n];
    for (int k = 0; k < D; ++k) s += siluf_(a.c[b * D + k]) * a.w_ada[(size_t)k * NMOD + n];
    return s;
}
DI void check_p0(const Args& a) {
    unsigned* ctl = (unsigned*)(a.ws + WS_CTL);
    const int gt = blockIdx.x * NTHREADS + otid();
    const float* mod = (const float*)ctl + CW_MOD;
    if (gt < 256) { const int b = gt & 1, n = (gt * 97 + 13) % NMOD; const float ref = naive_mod(a, b, n); dbg_report(ctl, 0, relerr(mod[b * NMOD + n], ref, 0.02f)); }
    else if (gt < 1280) {
        const int i = gt - 256; const unsigned h = (unsigned)i * 2654435761u;
        {   const int n = h % NPROJ, k = (h >> 13) % D; const int nsrc = n < 3072 ? n : n + 8;
            dbg_report(ctl, 1, relerr(bf2f(((const bf16_t*)(a.ws + WS_WIN))[(size_t)n * D + k]), a.w_in[(size_t)k * INW + nsrc], 1e-3f) * 0.5f); }
        {   const int n = h % D, k = (h >> 12) % SW; dbg_report(ctl, 1, relerr(bf2f(((const bf16_t*)(a.ws + WS_WSSM))[(size_t)n * SW + k]), a.w_ssm_up[(size_t)k * D + n], 1e-3f) * 0.5f); }
        {   const int n = h % D, k = (h >> 12) % AW; dbg_report(ctl, 1, relerr(bf2f(((const bf16_t*)(a.ws + WS_WATTN))[(size_t)n * AW + k]), a.w_attn_up[(size_t)k * D + n], 1e-3f) * 0.5f); }
        {   const int n = h % D, k = (h >> 12) % D; dbg_report(ctl, 1, relerr(bf2f(((const bf16_t*)(a.ws + WS_WOUT))[(size_t)n * D + k]), a.w_out[(size_t)k * D + n], 1e-3f) * 0.5f);
            dbg_report(ctl, 1, relerr(bf2f(((const bf16_t*)(a.ws + WS_WPQ))[(size_t)n * D + k]), a.w_peer_q[(size_t)k * D + n], 1e-3f) * 0.5f); }
        {   const int n = h % SW, k = (h >> 12) % SW; dbg_report(ctl, 1, relerr(bf2f(((const bf16_t*)(a.ws + WS_WGLU))[(size_t)n * SW + k]), a.w_glu[(size_t)k * SW + n], 1e-3f) * 0.5f); }
        {   const size_t e = ((size_t)h * 8191u + i) % ((size_t)NEXP * D); const int er = (int)(e >> 11), ek = (int)(e & 2047);
#if TAB4
            dbg_report(ctl, 1, relerr(fp4_at(a.ws + WS_PU + (size_t)er * ROWB4, a.ws + WS_PUE + (size_t)er * 64, ek), a.peer_u[e], 5e-2f) * 0.012f);
            dbg_report(ctl, 1, relerr(fp4_at(a.ws + WS_PV + (size_t)er * ROWB4, a.ws + WS_PVE + (size_t)er * 64, ek), a.peer_v[e], 6e-1f) * 0.012f); }
#else
            dbg_report(ctl, 1, relerr(fp6_at(a.ws + WS_PU + (size_t)er * ROWB, ek) * ((const float*)(a.ws + WS_PUS))[er], a.peer_u[e], 5e-2f) * 0.05f);
            dbg_report(ctl, 1, relerr(fp6_at(a.ws + WS_PV + (size_t)er * ROWB, ek) * ((const float*)(a.ws + WS_PVS))[er], a.peer_v[e], 6e-1f) * 0.05f); }
#endif
        {   const size_t e = (size_t)h % (16 * 128 * 128); dbg_report(ctl, 1, relerr(bf2f(((const bf16_t*)(a.ws + WS_KEYS))[e]), a.sub_keys[e], 1e-3f) * 0.5f); }
    }
}
DI void check_p1(const Args& a) {
    unsigned* ctl = (unsigned*)(a.ws + WS_CTL);
    const int tid_ = otid(); const int lane = tid_ & 63, gw = blockIdx.x * NWAVES + (tid_ >> 6);
    if (gw >= 64) return;
    const int m = (int)(((unsigned)gw * 2654435761u) % T), b = m >> 14;
    const float* mod = (const float*)ctl + CW_MOD;
    const float* xr = a.x + (size_t)m * D;
    float ss = 0.f;
    for (int k = lane; k < D; k += 64) ss += xr[k] * xr[k];
    const float r = rsqrtf(wave_sum(ss) / D + RMS_EPS);
    float f[8] = {0, 0, 0, 0, 0, 0, 0, 0};
    const bf16_t* hb = (const bf16_t*)(a.ws + WS_HB) + (size_t)m * D;
    for (int k = lane; k < D; k += 64) {
        const float sc = mod[b * NMOD + 1 * D + k], shv = mod[b * NMOD + k];
        const float h = xr[k] * r * a.norm1_w[k] * (1.0f + sc) + shv;
        dbg_report(ctl, 2, relerr(bf2f(hb[k]), h, 0.05f));
        for (int j = 0; j < 8; ++j) f[j] += h * a.w_in[(size_t)k * INW + 3072 + j];
    }
    for (int j = 0; j < 8; ++j) {
        const float z = wave_sum(f[j]) + a.b_forget[j];
        const float ref = -log1pf(expf(-z));
        if (lane == 0) dbg_report(ctl, 3, relerr(((const float*)(a.ws + WS_LF))[(size_t)m * 8 + j], ref, 0.01f));
    }
}
DI void check_p2(const Args& a) {
    unsigned* ctl = (unsigned*)(a.ws + WS_CTL);
    const int gt = blockIdx.x * NTHREADS + otid();
    if (gt >= 4096) return;
    const unsigned h = (unsigned)gt * 2654435761u;
    const int m = (h >> 7) % T, n = (h % 977 + gt * 7) % NPROJ;
    const bf16_t* hb = (const bf16_t*)(a.ws + WS_HB) + (size_t)m * D; const bf16_t* w = (const bf16_t*)(a.ws + WS_WIN) + (size_t)n * D;
    float s = 0.f;
    for (int k = 0; k < D; ++k) s += bf2f(hb[k]) * bf2f(w[k]);
    float got;
    if (n < 3072) got = bf2f(((const bf16_t*)(a.ws + WS_QKV))[(size_t)m * 3072 + n]);
    else if (n < 3584) got = bf2f(((const bf16_t*)(a.ws + WS_U))[(size_t)m * 512 + n - 3072]);
    else { got = bf2f(((const bf16_t*)(a.ws + WS_GATES))[(size_t)m * 4096 + n - 3584]); s = sigmoidf_(s); }
    dbg_report(ctl, 4, relerr(got, s, 0.05f));
}

DI void check_p3(const Args& a) {
    unsigned* ctl = (unsigned*)(a.ws + WS_CTL);
    const int tid_ = otid(); const int lane = tid_ & 63, gw = blockIdx.x * NWAVES + (tid_ >> 6);
    if (gw >= 48) return;
    const unsigned hsh = (unsigned)(gw + 1) * 2654435761u;
    const int b = gw & 1, h = (gw >> 1) & 7, t = (gw < 16) ? (gw * 37) : (int)(hsh % SEQ);
    const bf16_t* qkv = (const bf16_t*)(a.ws + WS_QKV);
    const bf16_t* vt = (const bf16_t*)(a.ws + WS_VT) + (size_t)(b * AH + h) * HD * SEQ;
    const float* Floc = (const float*)(a.ws + WS_F) + (size_t)(b * AH + h) * SEQ; const float* segt = (const float*)(a.ws + WS_CTL) + CW_SEGT + (b * AH + h) * 8;
    auto F = [&](int i) -> float { float o_ = 0.f; for (int z = 0; z < (i >> 11); ++z) o_ += segt[z]; return Floc[i] + o_; };
    float* scr = (float*)(a.ws + WS_DBGS) + (size_t)gw * SEQ;
    const size_t mrow = (size_t)b * SEQ;
    const bf16_t* qp = qkv + (mrow + t) * 3072 + h * 128;
    float mx = -1e30f;
    for (int s = lane; s <= t; s += 64) {
        const bf16_t* kp = qkv + (mrow + s) * 3072 + 1024 + h * 128;
        float d = 0.f;
        for (int k = 0; k < HD; ++k) d += bf2f(qp[k]) * bf2f(kp[k]);
        d += F(t) - F(s);
        scr[s] = d; mx = fmaxf(mx, d);
    }
    for (int o = 1; o < 64; o <<= 1) mx = fmaxf(mx, __shfl_xor(mx, o));
    float l = 0.f;
    for (int s = lane; s <= t; s += 64) { const float p = exp2f(scr[s] - mx); scr[s] = p; l += p; }
    l = wave_sum(l);
    __builtin_amdgcn_fence(__ATOMIC_RELEASE, "agent"); __builtin_amdgcn_fence(__ATOMIC_ACQUIRE, "agent");
    const bf16_t* yo = (const bf16_t*)(a.ws + WS_YATT) + (mrow + t) * AW + h * 128;
    for (int dd = 0; dd < 2; ++dd) {
        const int d = lane + 64 * dd;
        float acc = 0.f;
        for (int s = 0; s <= t; ++s) {
            const int pos = (s & ~15) + 8 * ((s >> 2) & 1) + 4 * ((s >> 3) & 1) + (s & 3);
            acc += scr[s] * bf2f(vt[((size_t)(pos >> 6) * HD + d) * 64 + (pos & 63)]);
        }
        dbg_report(ctl, 5, relerr(bf2f(yo[d]), acc / l, 0.5f));
    }
}


DI void check_p2b(const Args& a) {
    unsigned* ctl = (unsigned*)(a.ws + WS_CTL);
    const int tid_ = otid(); const int lane = tid_ & 63, gw = blockIdx.x * NWAVES + (tid_ >> 6);
    if (gw < 32) {
        const unsigned hsh = (unsigned)(gw + 3) * 2654435761u;
        const int m = 16384 + (hsh % 16384), h = (hsh >> 20) & 7, qk = gw & 1;
        const bf16_t* hb = (const bf16_t*)(a.ws + WS_HB) + (size_t)m * D;
        float raw[2], ss = 0.f;
        for (int dd = 0; dd < 2; ++dd) {
            const int d = lane + 64 * dd;
            const bf16_t* w = (const bf16_t*)(a.ws + WS_WIN) + (size_t)(qk * 1024 + h * 128 + d) * D;
            float s = 0.f;
            for (int k = 0; k < D; ++k) s += bf2f(hb[k]) * bf2f(w[k]);
            raw[dd] = s; ss += s * s;
        }
        ss = wave_sum(ss);
        const float r = rsqrtf(ss / HD + RMS_EPS);
        for (int dd = 0; dd < 2; ++dd) {
            const int d = lane + 64 * dd;
            const float ref = raw[dd] * r * (qk ? a.k_norm_w[d] : a.q_norm_w[d] * 0.08838834764831845f * LOG2E);
            dbg_report(ctl, 6, relerr(bf2f(((const bf16_t*)(a.ws + WS_QKV))[(size_t)m * 3072 + qk * 1024 + h * 128 + d]), ref, 0.05f));
        }
    } else if (gw < 48 && lane == 0) {
        const int bh = gw - 32, b = bh >> 3, h = bh & 7;
        const float* lf = (const float*)(a.ws + WS_LF); const float* F = (const float*)(a.ws + WS_F) + (size_t)bh * SEQ;
        double c = 0.0;
        const float* segt = (const float*)(a.ws + WS_CTL) + CW_SEGT + bh * 8;
        for (int s = 0; s < 3000; ++s) { c += (double)lf[((size_t)b * SEQ + s) * 8 + h]; if (s % 499 == 0) dbg_report(ctl, 7, relerr(F[s] + (s >= 2048 ? segt[0] : 0.f), (float)(c * 1.4426950408889634), 0.01f)); }
    }
}


DI void check_p456(const Args& a, int which) {
    unsigned* ctl = (unsigned*)(a.ws + WS_CTL);
    const int gt = blockIdx.x * NTHREADS + otid();
    if (gt >= 2048) return;
    const unsigned h = (unsigned)(gt + 11) * 2654435761u;
    const int m = (h >> 7) % T;
    if (which == 0) {
        const int n = h % SW;
        const bf16_t* g = (const bf16_t*)(a.ws + WS_GY) + (size_t)m * SW; const bf16_t* w = (const bf16_t*)(a.ws + WS_WGLU) + (size_t)n * SW;
        float s = a.b_glu[n];
        for (int k = 0; k < SW; ++k) s += bf2f(g[k]) * bf2f(w[k]);
        dbg_report(ctl, 8, relerr(bf2f(((const bf16_t*)(a.ws + WS_YG))[(size_t)m * SW + n]), bf2f(g[n]) * sigmoidf_(s), 0.2f));
    } else if (which == 1) {
        const int n = h % D;
        const bf16_t* yg = (const bf16_t*)(a.ws + WS_YG) + (size_t)m * SW; const bf16_t* w1 = (const bf16_t*)(a.ws + WS_WSSM) + (size_t)n * SW;
        const bf16_t* ya = (const bf16_t*)(a.ws + WS_YATT) + (size_t)m * AW; const bf16_t* w2 = (const bf16_t*)(a.ws + WS_WATTN) + (size_t)n * AW;
        float s1 = 0.f, s2 = 0.f;
        for (int k = 0; k < SW; ++k) s1 += bf2f(yg[k]) * bf2f(w1[k]);
        for (int k = 0; k < AW; ++k) s2 += bf2f(ya[k]) * bf2f(w2[k]);
        const bf16_t* gt_ = (const bf16_t*)(a.ws + WS_GATES) + (size_t)m * 4096;
        const float ref = bf2f(gt_[n]) * s1 + bf2f(gt_[2048 + n]) * s2;
        dbg_report(ctl, 9, relerr(bf2f(((const bf16_t*)(a.ws + WS_MRG))[(size_t)m * D + n]), ref, 0.3f));
    } else {
        const int n = h % D, b = m >> 14;
        const bf16_t* mr = (const bf16_t*)(a.ws + WS_MRG) + (size_t)m * D; const bf16_t* w = (const bf16_t*)(a.ws + WS_WOUT) + (size_t)n * D;
        float s = 0.f;
        for (int k = 0; k < D; ++k) s += bf2f(mr[k]) * bf2f(w[k]);
        const float g1 = ((const float*)ctl + CW_MOD)[b * NMOD + 2 * D + n];
        dbg_report(ctl, 10, relerr(a.out[(size_t)m * D + n], a.x[(size_t)m * D + n] + g1 * s, 1.0f) * 10.f);
    }
}


DI void check_p8(const Args& a) {
    unsigned* ctl = (unsigned*)(a.ws + WS_CTL);
    const int gt = blockIdx.x * NTHREADS + otid();
    if (gt >= 2048) return;
    const unsigned h = (unsigned)(gt + 5) * 2654435761u;
    const int m = (h >> 7) % T, n = h % D;
    const bf16_t* hr = (const bf16_t*)(a.ws + WS_H2B) + (size_t)m * D; const bf16_t* w = (const bf16_t*)(a.ws + WS_WPQ) + (size_t)n * D;
    float s = 0.f;
    for (int k = 0; k < D; ++k) s += bf2f(hr[k]) * bf2f(w[k]);
    dbg_report(ctl, 11, relerr(bf2f(((const bf16_t*)(a.ws + WS_QP))[(size_t)m * D + n]), s, 0.3f));
}
DI void check_p9(const Args& a) {
    unsigned* ctl = (unsigned*)(a.ws + WS_CTL);
    const int tid_ = otid(); const int lane = tid_ & 63, gw = blockIdx.x * NWAVES + (tid_ >> 6);
    if (gw >= 64) return;
    const unsigned hsh = (unsigned)(gw + 7) * 2654435761u;
    const int m = (hsh >> 5) % T, h = gw & 7;
    const bf16_t* qp = (const bf16_t*)(a.ws + WS_QP) + (size_t)m * D + h * 256;
    const bf16_t* keys = (const bf16_t*)(a.ws + WS_KEYS) + (size_t)h * 2 * NKEYS * 128;
    float* scr = (float*)(a.ws + WS_DBGS) + (size_t)gw * 256;
    for (int r = lane; r < 256; r += 64) {
        const int p = r >> 7; float s = 0.f;
        for (int k = 0; k < 128; ++k) s += bf2f(qp[p * 128 + k]) * bf2f(keys[(size_t)r * 128 + k]);
        scr[r] = s;
    }
    __builtin_amdgcn_fence(__ATOMIC_RELEASE, "agent"); __builtin_amdgcn_fence(__ATOMIC_ACQUIRE, "agent");
    const int* ids = (const int*)(a.ws + WS_IDS) + (size_t)m * NSEL + h * 16; const float* gwp = (const float*)(a.ws + WS_GW) + (size_t)m * NSEL + h * 16;
    float tv[16]; int te[16]; unsigned long long takenlo[4] = {0, 0, 0, 0};
    for (int r = 0; r < 16; ++r) {
        float best = -1e30f; int be = -1;
        for (int c = 0; c < 256; ++c) { const int e = lane * 256 + c; if ((takenlo[c >> 6] >> (c & 63)) & 1ull) continue; const float v = scr[e >> 7] + scr[128 + (e & 127)]; if (v > best) { best = v; be = e; } }
        float wb = best; for (int o = 1; o < 64; o <<= 1) wb = fmaxf(wb, __shfl_xor(wb, o));
        const unsigned long long bal = __ballot(best == wb); const int wl = __ffsll((long long)bal) - 1;
        const int we = __shfl(be, wl);
        if (lane == wl) { const int c = we - lane * 256; takenlo[c >> 6] |= 1ull << (c & 63); }
        tv[r] = wb; te[r] = we;
    }
    float es = 0.f; for (int r = 0; r < 16; ++r) es += expf(tv[r] - tv[0]);
    float err = 0.f;
    for (int r = 0; r < 16; ++r) {
        bool found = false;
        for (int k = 0; k < 16; ++k) if (ids[k] == te[r]) { found = true; err += fabsf(gwp[k] - expf(tv[r] - tv[0]) / es); }
        if (!found) err += expf(tv[r] - tv[0]) / es;
    }
    if (lane == 0) dbg_report(ctl, 12, err);
}
DI void check_p10(const Args& a) {
    unsigned* ctl = (unsigned*)(a.ws + WS_CTL);
    const int tid_ = otid(); const int lane = tid_ & 63, gw = blockIdx.x * NWAVES + (tid_ >> 6);
    if (gw >= 32) return;
    const unsigned hsh = (unsigned)(gw + 17) * 2654435761u;
    const int m = (hsh >> 5) % T, b = m >> 14;
    const bf16_t* hrow = (const bf16_t*)(a.ws + WS_H2B) + (size_t)m * D;
    const int* ids = (const int*)(a.ws + WS_IDS) + (size_t)m * NSEL; const float* gwp = (const float*)(a.ws + WS_GW) + (size_t)m * NSEL;
    const unsigned char* PU = a.ws + WS_PU; const unsigned char* PV = a.ws + WS_PV;
    float* scr = (float*)(a.ws + WS_DBGS) + 65536 + (size_t)gw * 128;
    for (int e = 0; e < NSEL; ++e) {
        float s = 0.f;
#if TAB4
        for (int k = lane; k < D; k += 64) s += bf2f(hrow[k]) * fp4_at(PU + (size_t)ids[e] * ROWB4, a.ws + WS_PUE + (size_t)ids[e] * 64, k);
        s = wave_sum(s);
        if (lane == 0) scr[e] = geluf_(s) * gwp[e];
#else
        for (int k = lane; k < D; k += 64) s += bf2f(hrow[k]) * fp6_at(PU + (size_t)ids[e] * ROWB, k);
        s = wave_sum(s) * ((const float*)(a.ws + WS_PUS))[ids[e]];
        if (lane == 0) scr[e] = geluf_(s) * gwp[e] * ((const float*)(a.ws + WS_PVS))[ids[e]];
#endif
    }
    __builtin_amdgcn_fence(__ATOMIC_RELEASE, "agent"); __builtin_amdgcn_fence(__ATOMIC_ACQUIRE, "agent");
    const float* mod = (const float*)ctl + CW_MOD;
    for (int c = 0; c < 8; ++c) {
        const int n = (hsh >> (c + 2)) % D;
        float pe = 0.f;
#if TAB4
        for (int e = lane; e < NSEL; e += 64) pe += scr[e] * fp4_at(PV + (size_t)ids[e] * ROWB4, a.ws + WS_PVE + (size_t)ids[e] * 64, n);
#else
        for (int e = lane; e < NSEL; e += 64) pe += scr[e] * fp6_at(PV + (size_t)ids[e] * ROWB, n);
#endif
        pe = wave_sum(pe);
        const bf16_t* mr = (const bf16_t*)(a.ws + WS_MRG) + (size_t)m * D; const bf16_t* w = (const bf16_t*)(a.ws + WS_WOUT) + (size_t)n * D;
        float s = 0.f;
        for (int k = lane; k < D; k += 64) s += bf2f(mr[k]) * bf2f(w[k]);
        s = wave_sum(s);
        const float g1 = mod[b * NMOD + 2 * D + n], g2 = mod[b * NMOD + 5 * D + n];
        const float ref = a.x[(size_t)m * D + n] + g1 * s + g2 * pe;
        if (lane == 0) dbg_report(ctl, 13, relerr(a.out[(size_t)m * D + n], ref, 1.0f) * 10.f);
    }
}


DI void check_fp6(const Args& a) {
    unsigned* ctl = (unsigned*)(a.ws + WS_CTL);
    if (blockIdx.x != 0 || otid() >= 64) return;
    bool ok = true;
#pragma unroll 1
    for (int rnd = 0; rnd < 2; ++rnd) {
        float e[32];
#pragma unroll
        for (int i = 0; i < 32; ++i) { const int c = (i * 7 + 3) & 31;
            const float mag = c < 16 ? 0.125f * c : (c < 24 ? 2.0f + 0.25f * (c - 16) : 4.0f + 0.5f * (c - 24));
            e[i] = (rnd ^ (i & 1)) ? -mag : mag; }
        const v6u w = fp6_pack_sw(e);
        const v32f r = fp6_unpack_f32(w);
#pragma unroll
        for (int i = 0; i < 32; ++i) ok = ok && (r[i] == e[i]);
    }
    dbg_report(ctl, 14, ok ? 1.f : 2.f);
}

__constant__ float dbg_tol[16] = {1e-3f, 4e-3f, 1e-2f, 1e-3f, 2e-2f, 2e-2f, 2e-2f, 2e-2f, 2e-2f, 2e-2f, 2e-2f, 2e-2f, 1e-1f, 2e-2f, 2e-2f, 2e-2f};
#endif


#define XB_TMO      128
#define XB_XCNT(j)  (256  + 64 * (j))
#define XB_XSUB(j)  (1280 + 64 * (j))
#define XB_XGEN(j)  (2304 + 64 * (j))
#define XB_TOP      3328
#define XB_TOPGEN   3392
#define XCD_BAR_WORDS 3456
#define XB_SPIN_CAP (1u << 18)
constexpr int CW_BAR = 4096;
DI unsigned xb_ld(unsigned* p)              { return __hip_atomic_load(p, __ATOMIC_RELAXED, __HIP_MEMORY_SCOPE_AGENT); }
DI unsigned xb_add(unsigned* p, unsigned v) { return __hip_atomic_fetch_add(p, v, __ATOMIC_RELAXED, __HIP_MEMORY_SCOPE_AGENT); }
DI unsigned xb_xcc_id() { return (unsigned)__builtin_amdgcn_s_getreg((3 << 11) | 20) & 0xFu; }
#define XB_SPIN(cond, bar) do { unsigned _sp = 0; while (cond) { __builtin_amdgcn_s_sleep(1); \
    if ((++_sp & 255u) == 0u) { if (xb_ld(&(bar)[XB_TMO])) break; if (_sp > XB_SPIN_CAP) { atomicAdd(&(bar)[XB_TMO], 1u); break; } } } } while (0)
struct XcdBarrier { unsigned* bar; unsigned x; volatile LAS unsigned* st; };
DI XcdBarrier xcd_barrier_post(unsigned* bar, volatile LAS unsigned* st) {
    XcdBarrier b; b.bar = bar; b.x = xb_xcc_id(); b.st = st;
    if (threadIdx.x == 0) (void)xb_add(&bar[XB_XCNT(b.x)], 1u);
    return b;
}
DI void xcd_barrier_complete(unsigned* bar, unsigned x, unsigned& nloc, unsigned& nx) {
    const unsigned G = gridDim.x * gridDim.y * gridDim.z;
    unsigned sum, cnt, mine, sp = 0u;
    for (;;) {
        sum = 0u; cnt = 0u; mine = 0u;
#pragma unroll
        for (unsigned j = 0; j < 16; ++j) { const unsigned c = xb_ld(&bar[XB_XCNT(j)]); sum += c; cnt += (c > 0u) ? 1u : 0u; mine = (j == x) ? c : mine; }
        if (sum == G) break;
        __builtin_amdgcn_s_sleep(1);
        if ((++sp & 255u) == 0u) { if (xb_ld(&bar[XB_TMO])) break; if (sp > XB_SPIN_CAP) { atomicAdd(&bar[XB_TMO], 1u); break; } }
    }
    nloc = mine > 0u ? mine : 1u; nx = cnt > 0u ? cnt : 1u;
}
#ifndef BAR_SCOPE
#define BAR_SCOPE ""
#endif
DI void xcd_barrier(const XcdBarrier& b) {
    asm volatile("s_waitcnt vmcnt(0)" ::: "memory");
    __syncthreads();
    if (threadIdx.x == 0) {
        unsigned* bar = b.bar;
        __builtin_amdgcn_s_waitcnt(0);
        unsigned nloc = b.st[0], nx = b.st[1];
        if (nloc == 0u) { xcd_barrier_complete(bar, b.x, nloc, nx); b.st[0] = nloc; b.st[1] = nx; }
        const unsigned old = xb_add(&bar[XB_XSUB(b.x)], 1u);
        const unsigned gen = old / nloc;
        if (old + 1u == (gen + 1u) * nloc) {
            __builtin_amdgcn_fence(__ATOMIC_RELEASE, BAR_SCOPE);
            asm volatile("s_waitcnt vmcnt(0)" ::: "memory");
            const unsigned og = xb_add(&bar[XB_TOP], 1u);
            const unsigned tg = og / nx;
            if (og + 1u == (tg + 1u) * nx) xb_add(&bar[XB_TOPGEN], 1u);
            else XB_SPIN(xb_ld(&bar[XB_TOPGEN]) == tg, bar);
            __builtin_amdgcn_fence(__ATOMIC_ACQUIRE, BAR_SCOPE);
            xb_add(&bar[XB_XGEN(b.x)], 1u);
            asm volatile("s_waitcnt vmcnt(0)" ::: "memory");
        } else {
            XB_SPIN(xb_ld(&bar[XB_XGEN(b.x)]) == gen, bar);
            __builtin_amdgcn_fence(__ATOMIC_ACQUIRE, BAR_SCOPE);
            asm volatile("s_waitcnt vmcnt(0)" ::: "memory");
        }
    }
    __syncthreads();
}


#ifndef TUNIT
#define TUNIT 50000
#endif
#ifndef TIMING
#define TIMING 0
#endif
__global__ void __launch_bounds__(NTHREADS, 2) mk_fwd(Args a) {
    extern __shared__ __attribute__((aligned(16))) unsigned char lds_raw[];
    LAS unsigned char* lds = (LAS unsigned char*)lds_raw;
    cg::grid_group grid = cg::this_grid();
    const int G = gridDim.x, blk = blockIdx.x;
    unsigned char* ws = a.ws;
    unsigned* ctl = (unsigned*)(ws + WS_CTL);
    unsigned long long* ts = (unsigned long long*)(ctl + 512);
#define STAMP(k) do { if (TIMING && blk == 0 && threadIdx.x == 0) ts[k] = __builtin_amdgcn_s_memrealtime(); } while (0)
#ifndef USE_XB
#define USE_XB 1
#endif
#define SYNC(k) do { if (USE_XB && (k) != 1) xcd_barrier(xbar); else { grid.sync(); if (threadIdx.x == 0) { __builtin_amdgcn_fence(__ATOMIC_ACQUIRE, BAR_SCOPE); asm volatile("s_waitcnt vmcnt(0)" ::: "memory"); } __syncthreads(); } STAMP(k); } while (0)
#if DBG
#define CHECK(stop, call) do { if (DBG_STOP > (stop)) call; grid.sync(); } while (0)
#else
#define CHECK(stop, call) do { } while (0)
#endif
    volatile LAS unsigned* xst = (volatile LAS unsigned*)(lds + LDS_BYTES - 64);
    if (threadIdx.x < 2) xst[threadIdx.x] = 0u;
    __syncthreads();
    XcdBarrier xbar = xcd_barrier_post(ctl + CW_BAR, xst);
    STAMP(0);
    phase0(a, lds);
    s5_tables_p0(a);
    SYNC(1);
#if DUP == 1
    phase0(a, lds); s5_tables_p0(a); SYNC(15);
#endif
    CHECK(0, check_p0(a));
    CHECK(0, check_fp6(a));
    if (DBG_STOP > 1) { s5_tables_p1(a); row_pass<true>(a, lds, a.x, a.norm1_w, 0, 1, (bf16_t*)(ws + WS_HB)); }
    SYNC(2);
#if DUP == 2
    s5_tables_p1(a); row_pass<true>(a, lds, a.x, a.norm1_w, 0, 1, (bf16_t*)(ws + WS_HB)); SYNC(15);
#endif
    CHECK(1, check_p1(a));
    if (DBG_STOP > 2) {
        pg8::Gemm g{(const bf16_t*)(ws + WS_HB), (const bf16_t*)(ws + WS_WIN), T, NPROJ, D};
        pg8::StaticOrder S; S.init(T, NPROJ, G, blk);
        EpiProj E{(bf16_t*)(ws + WS_QKV), (bf16_t*)(ws + WS_U), ws + WS_GATES};
        pg8::gemm_phase<EpiProj, pg8::StaticOrder, G_ALIGN, G_SP2>(lds, g, S, E);
    }
    SYNC(3);
    CHECK(2, check_p2(a));
    if (DBG_STOP > 3) phase2b(a, lds);
    SYNC(4);
    CHECK(3, check_p2b(a));
    if (DBG_STOP > 4) phase3(a, lds);
    SYNC(5);
    CHECK(4, check_p3(a));
    if (DBG_STOP > 5) {
        pg8::Gemm g{(const bf16_t*)(ws + WS_GY), (const bf16_t*)(ws + WS_WGLU), T, SW, SW};
        pg8::StaticOrder S; S.init(T, SW, G, blk);
        EpiGlu E{(const bf16_t*)(ws + WS_GY), a.b_glu, (bf16_t*)(ws + WS_YG)};
        pg8::gemm_phase<EpiGlu, pg8::StaticOrder, G_ALIGN, G_SP2>(lds, g, S, E);
    }
    SYNC(6);
    CHECK(5, check_p456(a, 0));
    for (int dup = 0; dup < (DUP == 5 ? 2 : 1); ++dup) {
        if (dup) SYNC(15);
        { pg8::Gemm g{(const bf16_t*)(ws + WS_YG), (const bf16_t*)(ws + WS_WSSM), T, D, SW};
          pg8::StaticOrder S; S.init(T, D, G, blk);
          EpiSsmUp E{ws + WS_GATES, (bf16_t*)(ws + WS_MRG)};
          pg8::gemm_phase<EpiSsmUp, pg8::StaticOrder, G_ALIGN, G_SP2>(lds, g, S, E); }
        { pg8::Gemm g{(const bf16_t*)(ws + WS_YATT), (const bf16_t*)(ws + WS_WATTN), T, D, AW};
          pg8::StaticOrder S; S.init(T, D, G, blk);
          EpiAttnUp E{ws + WS_GATES, (bf16_t*)(ws + WS_MRG)};
          pg8::gemm_phase<EpiAttnUp, pg8::StaticOrder, G_ALIGN, G_SP2>(lds, g, S, E); }
    }
    SYNC(7);
    CHECK(6, check_p456(a, 1));
    if (DBG_STOP > 7) {
        pg8::Gemm g{(const bf16_t*)(ws + WS_MRG), (const bf16_t*)(ws + WS_WOUT), T, D, D};
        pg8::StaticOrder S; S.init(T, D, G, blk);
        EpiOut E{a.x, (const float*)ctl + CW_MOD, a.b_ada, ws};
        pg8::gemm_phase<EpiOut, pg8::StaticOrder, G_ALIGN, G_SP2>(lds, g, S, E);
    }
    SYNC(8);
    CHECK(7, check_p456(a, 2));
    if (DBG_STOP > 8) row_pass<false, true>(a, lds, nullptr, a.norm2_w, 3, 4, (bf16_t*)(ws + WS_H2B));
    SYNC(9);
    if (DBG_STOP > 9) {
        pg8::Gemm g{(const bf16_t*)(ws + WS_H2B), (const bf16_t*)(ws + WS_WPQ), T, D, D};
        pg8::StaticOrder S; S.init(T, D, G, blk);
        EpiPlain E{(bf16_t*)(ws + WS_QP), D};
        pg8::gemm_phase<EpiPlain, pg8::StaticOrder, G_ALIGN, G_SP2>(lds, g, S, E);
    }
    SYNC(10);
    CHECK(9, check_p8(a));
    for (int dup = 0; dup < (DUP == 9 ? 2 : 1); ++dup) { if (dup) SYNC(15); phase9(a, lds);
#if TAB4 && P10_SLICED && U4
        hdigits_pass(a);
#endif
    }
    SYNC(11);
    CHECK(10, check_p9(a));
#if PROBE == 14
#elif TAB4 && P10_SLICED
#if U4
    if (DBG_STOP > 11) { phase10a_u4(a, lds); SYNC(13);
#if DUP == 10
        phase10a_u4(a, lds); SYNC(15);
#endif
        phase10b(a); SYNC(14);
#if DUP == 11
        phase10b(a); SYNC(15);
#endif
        phase10c_fp4(a, lds); }
#else
    if (DBG_STOP > 11) { phase10a_fp4(a); SYNC(13); phase10b(a); SYNC(14); phase10c_fp4(a, lds); }
#endif
#elif TAB4
    if (DBG_STOP > 11) phase10_fp4(a);
#else
    if (DBG_STOP > 11) phase10(a);
#endif
#if DBG || TIMING
    SYNC(12);
#endif
    CHECK(11, check_p10(a));
#if DBG
    if (DBG_STOP <= 7) {
        const f32x4* x4 = (const f32x4*)a.x; f32x4* o4 = (f32x4*)a.out;
        const size_t n4 = (size_t)T * D / 4;
        for (size_t i = (size_t)blk * NTHREADS + threadIdx.x; i < n4; i += (size_t)G * NTHREADS) o4[i] = x4[i];
    }
    grid.sync();
    {
        int code = 0;
        for (int i = 15; i >= 0; --i) { const float e = __uint_as_float(__hip_atomic_load(ctl + CW_DBG + i, __ATOMIC_RELAXED, __HIP_MEMORY_SCOPE_AGENT));
            if (e > dbg_tol[i]) { if (i >= DBG_LO && i < DBG_LO + 4) code |= 1 << (i - DBG_LO); else if (i < DBG_LO) code = 20 + i; } }
#ifdef DBG_MAG
        code = 1;
#endif
        if (code) {
#ifdef DBG_MAG
            const float s = 1.0f + fminf(__uint_as_float(__hip_atomic_load(ctl + CW_DBG + DBG_MAG, __ATOMIC_RELAXED, __HIP_MEMORY_SCOPE_AGENT)), 1000.f);
#else
            const float s = 1.0f + (float)code;
#endif
            f32x4* o4 = (f32x4*)a.out; const size_t n4 = (size_t)T * D / 4;
            for (size_t i = (size_t)blk * NTHREADS + threadIdx.x; i < n4; i += (size_t)G * NTHREADS) o4[i] = o4[i] * s;
        }
    }
#endif
#ifndef PROBE
#define PROBE 0
#endif
#if PROBE
    {
        SYNC(17);
        float* o = a.out; const size_t n = (size_t)T * D;
        for (size_t i = (size_t)blk * NTHREADS + threadIdx.x; i < n; i += (size_t)G * NTHREADS) {
            float v = 0.f;
            if (PROBE == 1) { if (i < (size_t)T * NSEL) v = ((const float*)(ws + WS_GW))[i]; }
            if (PROBE == 2) { if (i < (size_t)T * NSEL) v = (float)((const int*)(ws + WS_IDS))[i]; }
            if (PROBE == 3) { v = bf2f(((const bf16_t*)(ws + WS_H2B))[i]); }
            if (PROBE == 5) { v = bf2f(((const bf16_t*)(ws + WS_QP))[i]); }
            if (PROBE == 7) { v = bf2f(((const bf16_t*)(ws + WS_MRG))[i]); }
            if (PROBE == 8) { if (i < (size_t)T * SW) v = bf2f(((const bf16_t*)(ws + WS_GY))[i]); else if (i < (size_t)T * SW + (size_t)T * AW) v = bf2f(((const bf16_t*)(ws + WS_YATT))[i - (size_t)T * SW]); }
            if (PROBE == 9) { if (i < (size_t)T * SW) v = bf2f(((const bf16_t*)(ws + WS_YG))[i]); }
            if (PROBE == 15) { if (i < (size_t)NEXP * ROWB4 / 4) v = (float)(((const unsigned*)(ws + WS_PU))[i] >> 8); else if (i < (size_t)NEXP * ROWB4 / 2) v = (float)(((const unsigned*)(ws + WS_PV))[i - (size_t)NEXP * ROWB4 / 4] >> 8); }
            if (PROBE != 14) o[i] = v;
        }
    }
#endif
#if TIMING
    {
        const unsigned long long t0 = __hip_atomic_load(ts + 0, __ATOMIC_RELAXED, __HIP_MEMORY_SCOPE_AGENT), t1 = __hip_atomic_load(ts + 12, __ATOMIC_RELAXED, __HIP_MEMORY_SCOPE_AGENT);
        const unsigned long long ta = __hip_atomic_load(ts + TIMING - 1, __ATOMIC_RELAXED, __HIP_MEMORY_SCOPE_AGENT), tb = __hip_atomic_load(ts + TIMING, __ATOMIC_RELAXED, __HIP_MEMORY_SCOPE_AGENT);
        (void)t0; (void)t1;
        const float s = 1.0f + floorf((float)(tb - ta) / (float)TUNIT + 0.5f);
        f32x4* o4 = (f32x4*)a.out; const size_t n4 = (size_t)T * D / 4;
        for (size_t i = (size_t)blk * NTHREADS + threadIdx.x; i < n4; i += (size_t)G * NTHREADS) o4[i] = o4[i] * s;
    }
#endif
}

extern "C" void kernel_launch(void* const* d_in, const int* in_sizes, int n_in, void* d_out, int out_size,
                              void* d_ws, size_t ws_size, hipStream_t stream) {
    static int grid = 0;
    if (grid == 0) {
        int dev = 0, cus = 0, per_cu = 0;
        (void)hipGetDevice(&dev);
        (void)hipDeviceGetAttribute(&cus, hipDeviceAttributeMultiprocessorCount, dev);
        (void)hipFuncSetAttribute((const void*)mk_fwd, hipFuncAttributeMaxDynamicSharedMemorySize, LDS_BYTES);
        (void)hipOccupancyMaxActiveBlocksPerMultiprocessor(&per_cu, (const void*)mk_fwd, NTHREADS, LDS_BYTES);
        if (per_cu < 1) per_cu = 1;
        grid = cus * per_cu;
        if (n_in != 27 || ws_size < WS_END) { fprintf(stderr, "kernel_launch: unexpected n_in %d / ws_size %zu\n", n_in, ws_size); }
    }
    (void)hipMemsetAsync((char*)d_ws + WS_CTL, 0, CTL_ZERO_BYTES, stream);
    Args a{};
    const float** ap = (const float**)&a;
    for (int i = 0; i < 27; ++i) ap[i] = (const float*)d_in[i];
    a.out = (float*)d_out; a.ws = (unsigned char*)d_ws;
    void* args[] = {&a};
    hipError_t e = hipLaunchCooperativeKernel((const void*)mk_fwd, dim3(grid), dim3(NTHREADS), args, LDS_BYTES, stream);
    if (e != hipSuccess) fprintf(stderr, "cooperative launch failed: %s (grid %d)\n", hipGetErrorString(e), grid);
}
```
